# Optimizing an MI355X kernel written in HIP

```python
import math
import jax, jax.numpy as jnp
from jax import lax
import numpy as np

D_MODEL = 2048
BATCH = 1
SEQ = 16384
DEPTH = 4

N_MIXERS = 2
N_META = 16
BLOCK = 128
WINDOW = 128
A_HEAD_DIM = 64
A_Q_HEADS = D_MODEL // A_HEAD_DIM
A_KV_HEADS = A_Q_HEADS // 8
A_GROUP = A_Q_HEADS // A_KV_HEADS
A_WIDTH = A_Q_HEADS * A_HEAD_DIM
A_KV_WIDTH = A_KV_HEADS * A_HEAD_DIM
A_IN = 2 * A_WIDTH + 2 * A_KV_WIDTH
B_HEAD_DIM = 128
B_HEADS = D_MODEL // B_HEAD_DIM
B_WIDTH = B_HEADS * B_HEAD_DIM
B_IN = 4 * B_WIDTH
B_PAD = BLOCK - N_META
N_BUCKETS = 32
MAX_DISTANCE = 128
N_A_LAYERS = (DEPTH + 1) // 2
N_B_LAYERS = DEPTH // 2
DEEPNORM_ALPHA = (2.0 * DEPTH) ** 0.25
DEEPNORM_BETA = (8.0 * DEPTH) ** -0.25
LN_EPS = 1e-5
NEG = -1e30

kernel_name = "hybrid_swa_sink_stickbreak_deepnorm"


def layer_norm(x, g, b):
    xf = x.astype(jnp.float32)
    mu = jnp.mean(xf, axis=-1, keepdims=True)
    var = jnp.mean(jnp.square(xf - mu), axis=-1, keepdims=True)
    y = (xf - mu) * lax.rsqrt(var + LN_EPS) * g.astype(jnp.float32) + b.astype(jnp.float32)
    return y.astype(x.dtype)


def t5_bucket(dist):
    max_exact = N_BUCKETS // 2
    d = jnp.maximum(dist, 0)
    df = jnp.maximum(d, 1).astype(jnp.float32)
    large = max_exact + (jnp.log(df / max_exact) / math.log(MAX_DISTANCE / max_exact)
                         * (N_BUCKETS - max_exact)).astype(jnp.int32)
    large = jnp.minimum(large, N_BUCKETS - 1)
    return jnp.where(d < max_exact, d, large)


def head_bias(rel_bias, dist):
    return rel_bias[t5_bucket(dist)].astype(jnp.float32)


def sliding_window_sink_attention(q, k, v, sinks, rel_bias):
    f32 = jnp.float32
    b, L = q.shape[0], q.shape[1]
    n_blk = (L - N_META) // BLOCK
    q = q.reshape(b, L, A_KV_HEADS, A_GROUP, A_HEAD_DIM).astype(f32) * (A_HEAD_DIM ** -0.5)
    k = k.reshape(b, L, A_KV_HEADS, A_HEAD_DIM).astype(f32)
    v = v.reshape(b, L, A_KV_HEADS, A_HEAD_DIM).astype(f32)
    qm, km, vm = q[:, :N_META], k[:, :N_META], v[:, :N_META]
    qb = q[:, N_META:].reshape(b, n_blk, BLOCK, A_KV_HEADS, A_GROUP, A_HEAD_DIM)
    kb = k[:, N_META:].reshape(b, n_blk, BLOCK, A_KV_HEADS, A_HEAD_DIM)
    vb = v[:, N_META:].reshape(b, n_blk, BLOCK, A_KV_HEADS, A_HEAD_DIM)
    pad = ((0, 0), (1, 0), (0, 0), (0, 0), (0, 0))
    kl = jnp.concatenate([jnp.pad(kb, pad)[:, :-1], kb], axis=2)
    vl = jnp.concatenate([jnp.pad(vb, pad)[:, :-1], vb], axis=2)

    i = jnp.arange(BLOCK)
    c = jnp.arange(2 * BLOCK)
    d_loc = i[:, None] + BLOCK - c[None, :]
    ok_loc = (d_loc >= 0) & (d_loc < WINDOW)
    no_prev = (jnp.arange(n_blk)[:, None, None] == 0) & (c[None, None, :] < BLOCK)
    ok_loc = ok_loc[None] & ~no_prev
    bias_loc = jnp.moveaxis(head_bias(rel_bias, d_loc), -1, 0).reshape(
        A_KV_HEADS, A_GROUP, BLOCK, 2 * BLOCK)
    s_loc = jnp.einsum('bnqhgd,bnshd->bnhgqs', qb, kl) + bias_loc
    s_loc = jnp.where(ok_loc[:, None, None], s_loc, NEG)

    qpos = N_META + jnp.arange(n_blk)[:, None] * BLOCK + i[None, :]
    d_meta = qpos[..., None] - jnp.arange(N_META)
    bias_meta = head_bias(rel_bias, d_meta).reshape(
        n_blk, BLOCK, N_META, A_KV_HEADS, A_GROUP).transpose(0, 3, 4, 1, 2)
    s_meta = jnp.einsum('bnqhgd,bshd->bnhgqs', qb, km) + bias_meta

    sink_logit = sinks.astype(f32).reshape(A_KV_HEADS, A_GROUP, 1, 1)
    sink = jnp.broadcast_to(sink_logit, s_meta.shape[:-1] + (1,))
    p = jax.nn.softmax(jnp.concatenate([s_meta, s_loc, sink], axis=-1), axis=-1)
    o = (jnp.einsum('bnhgqs,bshd->bnqhgd', p[..., :N_META], vm)
         + jnp.einsum('bnhgqs,bnshd->bnqhgd', p[..., N_META:N_META + 2 * BLOCK], vl))
    o = o.reshape(b, n_blk * BLOCK, A_WIDTH)

    d_mm = jnp.arange(N_META)[:, None] - jnp.arange(N_META)[None, :]
    bias_mm = jnp.moveaxis(head_bias(rel_bias, d_mm), -1, 0).reshape(
        A_KV_HEADS, A_GROUP, N_META, N_META)
    s_mm = jnp.einsum('bqhgd,bshd->bhgqs', qm, km) + bias_mm
    s_mm = jnp.where(d_mm >= 0, s_mm, NEG)
    sink_m = jnp.broadcast_to(sink_logit, s_mm.shape[:-1] + (1,))
    p_mm = jax.nn.softmax(jnp.concatenate([s_mm, sink_m], axis=-1), axis=-1)
    o_m = jnp.einsum('bhgqs,bshd->bqhgd', p_mm[..., :N_META], vm).reshape(b, N_META, A_WIDTH)
    return jnp.concatenate([o_m, o], axis=1)


def stick_breaking_attention(q, k, v):
    f32 = jnp.float32
    b, L = q.shape[0], q.shape[1]
    n_blk = (L - N_META) // BLOCK
    q = q.reshape(b, L, B_HEADS, B_HEAD_DIM).astype(f32) * (B_HEAD_DIM ** -0.5)
    k = k.reshape(b, L, B_HEADS, B_HEAD_DIM).astype(f32)
    v = v.reshape(b, L, B_HEADS, B_HEAD_DIM).astype(f32)
    kpad = ((0, 0), (B_PAD, 0), (0, 0), (0, 0))
    kp = jnp.pad(k, kpad)
    vp = jnp.pad(v, kpad)
    kpos = jnp.arange((n_blk + 1) * BLOCK) - B_PAD
    upper = (jnp.arange(BLOCK)[:, None] >= jnp.arange(BLOCK)[None, :]).astype(f32)

    def block_out(qblk, qpos, n_kb):
        nq = qblk.shape[1]
        kk = kp[:, :n_kb * BLOCK]
        vv = vp[:, :n_kb * BLOCK]
        pos = kpos[:n_kb * BLOCK]
        z = jnp.einsum('bqhd,bshd->bhqs', qblk, kk)
        visible = (pos[None, :] >= 0) & (pos[None, :] < qpos[:, None])
        sp = jnp.where(visible, jax.nn.softplus(z), 0.0).reshape(b, B_HEADS, nq, n_kb, BLOCK)
        tw = jnp.einsum('bhqks,sj->bhqkj', sp, upper, precision=lax.Precision.HIGHEST)
        tot = tw[..., 0]
        later = lax.cumsum(tot, axis=3, reverse=True) - tot
        tail = (tw + later[..., None]).reshape(b, B_HEADS, nq, n_kb * BLOCK)
        w = jnp.exp(jnp.where(visible, z - tail, -jnp.inf))
        return jnp.einsum('bhqs,bshd->bqhd', w, vv)

    outs = [block_out(q[:, :N_META], jnp.arange(N_META), 1)]
    for n in range(n_blk):
        start = N_META + n * BLOCK
        qpos = start + jnp.arange(BLOCK)
        outs.append(block_out(q[:, start:start + BLOCK], qpos, n + 2))
    return jnp.concatenate(outs, axis=1).reshape(b, L, B_WIDTH)


def branch_a(h, w_in, sinks, w_out, rel_bias):
    z = h @ w_in
    q, k, v, gate = jnp.split(
        z, [A_WIDTH, A_WIDTH + A_KV_WIDTH, A_WIDTH + 2 * A_KV_WIDTH], axis=-1)
    o = sliding_window_sink_attention(q, k, v, sinks, rel_bias).astype(h.dtype)
    return (o * jax.nn.silu(gate)) @ w_out


def branch_b(h, w_in, w_out):
    z = h @ w_in
    q, k, v, gate = jnp.split(z, [B_WIDTH, 2 * B_WIDTH, 3 * B_WIDTH], axis=-1)
    o = stick_breaking_attention(q, k, v).astype(h.dtype)
    return (o * jax.nn.silu(gate)) @ w_out


def setup_inputs(seed: int = 0) -> dict:
    key = jax.random.key(seed)
    ks = jax.random.split(key, 10)
    f32 = jnp.float32
    nrm = jax.random.normal
    x = nrm(ks[0], (BATCH, SEQ, D_MODEL), f32)
    meta_tokens = nrm(ks[1], (N_META, D_MODEL), f32)
    rel_bias = 0.5 * nrm(ks[2], (N_BUCKETS, A_Q_HEADS), f32)
    w_in_a = nrm(ks[3], (N_A_LAYERS, D_MODEL, A_IN), f32) * D_MODEL ** -0.5
    sinks_a = 0.5 * nrm(ks[4], (N_A_LAYERS, A_Q_HEADS), f32)
    w_out_a = nrm(ks[5], (N_A_LAYERS, A_WIDTH, D_MODEL), f32) * (A_WIDTH ** -0.5 * DEEPNORM_BETA)
    w_in_b = nrm(ks[6], (N_B_LAYERS, D_MODEL, B_IN), f32) * D_MODEL ** -0.5
    w_out_b = nrm(ks[7], (N_B_LAYERS, B_WIDTH, D_MODEL), f32) * (B_WIDTH ** -0.5 * DEEPNORM_BETA)
    ln_g = 1.0 + 0.02 * nrm(ks[8], (DEPTH, D_MODEL), f32)
    ln_b = 0.02 * nrm(ks[9], (DEPTH, D_MODEL), f32)
    return {"x": x, "meta_tokens": meta_tokens, "rel_bias": rel_bias,
            "w_in_a": w_in_a, "sinks_a": sinks_a, "w_out_a": w_out_a,
            "w_in_b": w_in_b, "w_out_b": w_out_b, "ln_g": ln_g, "ln_b": ln_b}


def reference(x, meta_tokens, rel_bias, w_in_a, sinks_a, w_out_a, w_in_b, w_out_b, ln_g, ln_b):
    b = x.shape[0]
    meta = jnp.broadcast_to(meta_tokens.astype(x.dtype)[None], (b, N_META, D_MODEL))
    h = jnp.concatenate([meta, x], axis=1)
    for i in range(DEPTH):
        j = i // N_MIXERS
        if i % N_MIXERS == 0:
            y = branch_a(h, w_in_a[j], sinks_a[j], w_out_a[j], rel_bias)
        else:
            y = branch_b(h, w_in_b[j], w_out_b[j])
        h = layer_norm(DEEPNORM_ALPHA * h + y, ln_g[i], ln_b[i])
    return h[:, N_META:]
```

```cpp
#include <hip/hip_runtime.h>
#include <hip/hip_cooperative_groups.h>
#include <cstdio>
namespace cg = cooperative_groups;

#define LAS __attribute__((address_space(3)))
#define DI __device__ __forceinline__
typedef unsigned short bf16_t;
typedef short bf16x8 __attribute__((ext_vector_type(8)));
typedef float f32x2 __attribute__((ext_vector_type(2)));
typedef float f32x4 __attribute__((ext_vector_type(4)));
typedef float f32x16 __attribute__((ext_vector_type(16)));
typedef unsigned u32x2 __attribute__((ext_vector_type(2)));
typedef unsigned u32x4 __attribute__((ext_vector_type(4)));
typedef __bf16 bf16v2 __attribute__((ext_vector_type(2)));

constexpr int D = 2048, SEQ = 16384, NMETA = 16, LTOK = SEQ + NMETA, MPAD = SEQ + 256;
constexpr int NA = 4608, NB = 8192, DEPTH = 4;
constexpr int NTHREADS = 512, NWAVES = 8;
constexpr int LDS_MAIN = 147456, LDS_BYTES = LDS_MAIN + 16;
constexpr float LN_EPS = 1e-5f;
constexpr float DN_ALPHA = 1.6817928305074290f;

constexpr size_t WS_W = 0;
constexpr size_t WPAIR = (size_t)(NA + D + NB + D) * D * 2;
constexpr size_t WO_INA = 0, WO_OUTA = (size_t)NA * D * 2, WO_INB = WO_OUTA + (size_t)D * D * 2, WO_OUTB = WO_INB + (size_t)NB * D * 2;
constexpr size_t WS_HB = WS_W + 2 * WPAIR;
constexpr size_t WS_Z = WS_HB + (size_t)MPAD * D * 2;
constexpr size_t WS_BAR = WS_Z + (size_t)MPAD * NB * 2;
static_assert((size_t)LTOK * D * 2 <= WPAIR, "the fp16 residual stream must fit in the first layer pair's weight region");
constexpr size_t WS_Q = WS_BAR + 16384;
constexpr size_t WS_END = WS_Q + 4 * 8 * 256;

DI unsigned pk2(float a, float b) { f32x2 v = {a, b}; bf16v2 r = __builtin_convertvector(v, bf16v2); return __builtin_bit_cast(unsigned, r); }
typedef _Float16 h16v2 __attribute__((ext_vector_type(2)));
DI unsigned pkh2(float a, float b) { f32x2 v = {a, b}; h16v2 r = __builtin_convertvector(v, h16v2); return __builtin_bit_cast(unsigned, r); }
DI float h_lo(unsigned u) { return (float)__builtin_bit_cast(h16v2, u)[0]; }
DI float h_hi(unsigned u) { return (float)__builtin_bit_cast(h16v2, u)[1]; }
DI float bf_lo(unsigned u) { return __uint_as_float(u << 16); }
DI float bf_hi(unsigned u) { return __uint_as_float(u & 0xffff0000u); }
DI float shflx(float v, int mask, int lane) { return __int_as_float(__builtin_amdgcn_ds_bpermute((lane ^ mask) << 2, __float_as_int(v))); }
DI int lane_id_fresh() { unsigned zero; asm volatile("v_mov_b32 %0, 0" : "=v"(zero)); return (int)__builtin_amdgcn_mbcnt_hi(~0u, __builtin_amdgcn_mbcnt_lo(~0u, zero)); }
DI float wave_sum(float v, int lane) {
#pragma unroll
    for (int o = 1; o < 64; o <<= 1) v += shflx(v, o, lane);
    return v;
}


DI size_t zrowU(int row0, int NT) { return ((size_t)((row0 >> 8) * NT) << 16) + (size_t)((((row0 >> 7) & 1) << 15) | (((row0 >> 5) & 1) << 14) | (((row0 >> 6) & 1) << 11)); }
DI unsigned zlaneRC(int r5, int col) { return (unsigned)(((col >> 8) << 16) | ((r5 >> 4) << 13) | (((col >> 7) & 1) << 12) | (((col >> 5) & 3) << 9) | (((col >> 3) & 3) << 7) | ((r5 & 15) << 3) | (col & 7)); }

namespace pg8 {
constexpr int BM = 256, BK = 64, HALF = 128, HTB = HALF * BK * 2, NXCD = 8, WGM = 8;
DI int lds_byte(int r, int c) { const int st = (r >> 4) * 2 + (c >> 5), rr = r & 15, cc = c & 31, ob = rr * 64 + cc * 2; return st * 1024 + (ob ^ (((ob >> 9) & 1) << 5)); }
DI void stage_rc(int b, int& R, int& C) { const int st = b / 1024, sb = b % 1024, swz = sb ^ (((sb >> 9) & 1) << 5); R = (st >> 1) * 16 + swz / 64; C = (st & 1) * 32 + (swz % 64) / 2; }
DI int perm32(int rho) { const int n = rho >> 4, i = rho & 15; return 8 * (i >> 2) + 4 * n + (i & 3); }

struct Unit { int pm, pn; };
struct Gemm { const bf16_t* A; const bf16_t* Bt; int M, N, K, lda; int ant; };

struct StaticOrder {
    int nM, nN, nwg, G, c;
    DI void init(int M, int N, int G_, int c_) { nM = M / BM; nN = N / BM; nwg = nM * nN; G = G_; c = c_; }
    DI bool next(int i, Unit& u) const {
        const long L = (long)i * G + c; if (L >= nwg) return false;
        int wgid = (int)L; { const int q = nwg / NXCD, r = nwg % NXCD, xcd = wgid % NXCD, off = wgid / NXCD; wgid = (xcd < r ? xcd * (q + 1) : r * (q + 1) + (xcd - r) * q) + off; }
        const int nig = WGM * nN, gid = wgid / nig, fm = gid * WGM, gsz = (nM - fm) < WGM ? (nM - fm) : WGM;
        u.pm = fm + ((wgid % nig) % gsz); u.pn = (wgid % nig) / gsz; return true;
    }
};

struct EpiBf16 {
    static constexpr bool PERM = true;
    bf16_t* O; int ldc; int nt;
    DI void operator()(const f32x4 (&acc)[2][2][4][2], const Unit& u, int wr, int wc, int fr, int fq) const {
        if (nt) {
            unsigned char* tb = (unsigned char*)O + ((size_t)(u.pm * nt + u.pn) << 17) + (wr * 4 + wc) * 1024 + (fq * 16 + fr) * 16;
#pragma unroll
            for (int ai = 0; ai < 2; ++ai)
#pragma unroll
                for (int m = 0; m < 4; ++m)
#pragma unroll
                    for (int bj = 0; bj < 2; ++bj) { const f32x4 v0 = acc[ai][bj][m][0], v1 = acc[ai][bj][m][1];
                        u32x4 w; w.x = pk2(v0[0], v0[1]); w.y = pk2(v0[2], v0[3]); w.z = pk2(v1[0], v1[1]); w.w = pk2(v1[2], v1[3]);
                        *(u32x4*)(tb + ((ai * 4 + m) * 2 + bj) * 8192) = w; }
            return;
        }
        const int row0 = u.pm * BM + wr * 64 + fr; const int col0 = u.pn * BM + wc * 32 + 8 * fq;
#pragma unroll
        for (int ai = 0; ai < 2; ++ai)
#pragma unroll
            for (int m = 0; m < 4; ++m) { bf16_t* rowp = O + (size_t)(row0 + ai * HALF + m * 16) * ldc + col0;
#pragma unroll
                for (int bj = 0; bj < 2; ++bj) { const f32x4 v0 = acc[ai][bj][m][0], v1 = acc[ai][bj][m][1];
                    u32x4 w; w.x = pk2(v0[0], v0[1]); w.y = pk2(v0[2], v0[3]); w.z = pk2(v1[0], v1[1]); w.w = pk2(v1[2], v1[3]);
                    *(u32x4*)(rowp + bj * HALF) = w; } }
    }
};

template <class Epi>
DI void gemm_phase(LAS unsigned char* lds, const Gemm g, const StaticOrder& S, const Epi& E, const int tid) {
    const int wid = __builtin_amdgcn_readfirstlane(tid >> 6), lane = tid & 63, wr = wid >> 2, wc = wid & 3, fr = lane & 15, fq = lane >> 4;
    const int K = g.K, nt = K / BK, lda = g.lda;
    unsigned voffA[2], voffB[2];
#pragma unroll
    for (int i = 0; i < 2; ++i) { int R, C; stage_rc(tid * 16 + i * 8192, R, C); const int Rb = Epi::PERM ? ((R & ~31) + perm32(R & 31)) : R;
        voffA[i] = g.ant ? (unsigned)((((R >> 4) & 3) << 14) | (((R >> 6) & 1) << 12) | (((C >> 5) & 1) << 10) | (((C >> 3) & 3) << 8) | ((R & 15) << 4)) : (unsigned)(R * lda + C) * 2u;
        voffB[i] = (unsigned)(Rb * K + C) * 2u; }
    const size_t kstep = (size_t)(BK * 2);
    const size_t hstepA = g.ant ? (size_t)65536 : (size_t)HALF * lda * 2, hstepB = (size_t)HALF * K * 2;
    const size_t tstepA = g.ant ? (size_t)g.ant * 131072 : 2 * hstepA, tstepB = 2 * hstepB;
#define PG8_KTA(t) (g.ant ? ((size_t)((t) >> 2) * 131072 + (size_t)((((t) >> 1) & 1) * 8192 + ((t) & 1) * 2048)) : (size_t)(t) * kstep)
    const unsigned ldsw = (unsigned)wid * 1024u;
    const int aoff = lds_byte(wr * 64 + fr, fq * 8), boff = lds_byte(wc * 32 + fr, fq * 8);
#define PG8_SA(b, h) (((b) * 2 + (h)) * HTB)
#define PG8_SB(b, h) ((4 + (b) * 2 + (h)) * HTB)
#define PG8_STAGE(bufoff, gbase, voff) do { _Pragma("unroll") for (int _i = 0; _i < 2; ++_i) \
        __builtin_amdgcn_global_load_lds((const unsigned*)((const char*)(gbase) + (voff)[_i]), (LAS unsigned*)(lds + (bufoff) + ldsw + _i * 8192), 16, 0, 0); } while (0)
#define PG8_LDA(dst, b, h) do { _Pragma("unroll") for (int m = 0; m < 4; ++m) _Pragma("unroll") for (int k = 0; k < 2; ++k) dst[m][k] = *(const LAS bf16x8*)(lds + PG8_SA(b, h) + aoff + m * 2048 + k * 1024); } while (0)
#define PG8_LDB(dst, b, h) do { _Pragma("unroll") for (int n = 0; n < 2; ++n) _Pragma("unroll") for (int k = 0; k < 2; ++k) dst[n][k] = *(const LAS bf16x8*)(lds + PG8_SB(b, h) + boff + n * 2048 + k * 1024); } while (0)
#define PG8_MMA(ai, bj, At, Bt) do { __builtin_amdgcn_s_setprio(1); _Pragma("unroll") for (int m = 0; m < 4; ++m) _Pragma("unroll") for (int n = 0; n < 2; ++n) _Pragma("unroll") for (int k = 0; k < 2; ++k) \
        acc[ai][bj][m][n] = __builtin_amdgcn_mfma_f32_16x16x32_bf16(Bt[n][k], At[m][k], acc[ai][bj][m][n], 0, 0, 0); __builtin_amdgcn_s_setprio(0); } while (0)
#define PG8_WAIT_V(n) asm volatile("s_waitcnt vmcnt(" #n ")" ::: "memory")
#define PG8_WAIT_L(n) asm volatile("s_waitcnt lgkmcnt(" #n ")" ::: "memory")
#define PG8_BAR __builtin_amdgcn_s_barrier()
#define PG8_SCHED __builtin_amdgcn_sched_barrier(0)
    Unit cur, nxt; int ui = 0;
    if (!S.next(0, cur)) return;
    f32x4 acc[2][2][4][2];
#pragma unroll
    for (int a = 0; a < 2; ++a)
#pragma unroll
        for (int b = 0; b < 2; ++b)
#pragma unroll
            for (int m = 0; m < 4; ++m)
#pragma unroll
                for (int n = 0; n < 2; ++n) acc[a][b][m][n] = (f32x4){0.f, 0.f, 0.f, 0.f};
    bf16x8 At[4][2], B0[2][2], B1[2][2];
    const char* cA = (const char*)g.A + (size_t)cur.pm * tstepA; const char* cB = (const char*)g.Bt + (size_t)cur.pn * tstepB;
    PG8_STAGE(PG8_SB(0, 0), cB, voffB); PG8_STAGE(PG8_SA(0, 0), cA, voffA); PG8_STAGE(PG8_SB(0, 1), cB + hstepB, voffB); PG8_STAGE(PG8_SA(0, 1), cA + hstepA, voffA);
    if (wr == 1) PG8_BAR;
    PG8_WAIT_V(4); PG8_BAR;
    PG8_STAGE(PG8_SB(1, 0), cB + kstep, voffB); PG8_STAGE(PG8_SA(1, 0), cA + PG8_KTA(1), voffA); PG8_STAGE(PG8_SB(1, 1), cB + hstepB + kstep, voffB);
    PG8_WAIT_V(6); PG8_BAR;
    for (;;) {
        const bool has_next = S.next(ui + 1, nxt);
        const char* nA = has_next ? (const char*)g.A + (size_t)nxt.pm * tstepA : cA; const char* nB = has_next ? (const char*)g.Bt + (size_t)nxt.pn * tstepB : cB;
        for (int t = 0; t < nt; t += 2) {
            const bool last = (t == nt - 2);
            const char* a1 = cA + PG8_KTA(t + 1);
            const char* a2 = last ? nA : cA + PG8_KTA(t + 2); const char* b2 = last ? nB : cB + (size_t)(t + 2) * kstep;
            const char* a3 = last ? nA + PG8_KTA(1) : cA + PG8_KTA(t + 3); const char* b3 = b2 + kstep;
            PG8_LDB(B0, 0, 0); PG8_SCHED; PG8_LDA(At, 0, 0); PG8_STAGE(PG8_SA(1, 1), a1 + hstepA, voffA);
            PG8_WAIT_L(8); PG8_BAR; PG8_WAIT_L(0); PG8_MMA(0, 0, At, B0); PG8_BAR; PG8_SCHED;
            PG8_LDB(B1, 0, 1); PG8_STAGE(PG8_SB(0, 0), b2, voffB);
            PG8_BAR; PG8_WAIT_L(0); PG8_MMA(0, 1, At, B1); PG8_BAR;
            PG8_LDA(At, 0, 1); PG8_STAGE(PG8_SA(0, 0), a2, voffA);
            PG8_BAR; PG8_WAIT_L(0); PG8_MMA(1, 0, At, B0); PG8_BAR; PG8_SCHED;
            PG8_STAGE(PG8_SB(0, 1), b2 + hstepB, voffB);
            PG8_WAIT_V(6); PG8_BAR; PG8_MMA(1, 1, At, B1); PG8_BAR;
            PG8_LDB(B0, 1, 0); PG8_SCHED; PG8_LDA(At, 1, 0); PG8_STAGE(PG8_SA(0, 1), a2 + hstepA, voffA);
            PG8_WAIT_L(8); PG8_BAR; PG8_WAIT_L(0); PG8_MMA(0, 0, At, B0); PG8_BAR; PG8_SCHED;
            PG8_LDB(B1, 1, 1); PG8_STAGE(PG8_SB(1, 0), b3, voffB);
            PG8_BAR; PG8_WAIT_L(0); PG8_MMA(0, 1, At, B1); PG8_BAR;
            PG8_LDA(At, 1, 1); PG8_STAGE(PG8_SA(1, 0), a3, voffA);
            PG8_BAR; PG8_WAIT_L(0); PG8_MMA(1, 0, At, B0); PG8_BAR; PG8_SCHED;
            PG8_STAGE(PG8_SB(1, 1), b3 + hstepB, voffB);
            PG8_WAIT_V(6); PG8_BAR; PG8_MMA(1, 1, At, B1); PG8_BAR;
        }
        E(acc, cur, wr, wc, fr, fq);
        if (!has_next) break;
#pragma unroll
        for (int a = 0; a < 2; ++a)
#pragma unroll
            for (int b = 0; b < 2; ++b)
#pragma unroll
                for (int m = 0; m < 4; ++m)
#pragma unroll
                    for (int n = 0; n < 2; ++n) acc[a][b][m][n] = (f32x4){0.f, 0.f, 0.f, 0.f};
        cur = nxt; cA = nA; cB = nB; ++ui;
    }
    PG8_WAIT_V(0);
    if (wr == 0) PG8_BAR;
    PG8_BAR;
#undef PG8_KTA
#undef PG8_SA
#undef PG8_SB
#undef PG8_STAGE
#undef PG8_LDA
#undef PG8_LDB
#undef PG8_MMA
#undef PG8_WAIT_V
#undef PG8_WAIT_L
#undef PG8_BAR
#undef PG8_SCHED
}
}


#define XB_TMO      128
#define XB_XCNT(j)  (256  + 64 * (j))
#define XB_XSUB(j)  (1280 + 64 * (j))
#define XB_XGEN(j)  (2304 + 64 * (j))
#define XB_TOP      3328
#define XB_TOPGEN   3392
#define XCD_BAR_WORDS 3456
#define XB_SPIN_CAP (1u << 22)
DI unsigned xb_ld(unsigned* p)              { return __hip_atomic_load(p, __ATOMIC_RELAXED, __HIP_MEMORY_SCOPE_AGENT); }
DI unsigned xb_add(unsigned* p, unsigned v) { return __hip_atomic_fetch_add(p, v, __ATOMIC_RELAXED, __HIP_MEMORY_SCOPE_AGENT); }
DI unsigned xb_xcc_id() { return (unsigned)__builtin_amdgcn_s_getreg((3 << 11) | 20) & 0xFu; }
#define XB_SPIN(cond, bar) do { unsigned _sp = 0; while (cond) { __builtin_amdgcn_s_sleep(1); \
    if ((++_sp & 255u) == 0u) { if (xb_ld(&(bar)[XB_TMO])) break; if (_sp > XB_SPIN_CAP) { atomicAdd(&(bar)[XB_TMO], 1u); break; } } } } while (0)
struct XcdBarrier { unsigned* bar; unsigned x; volatile LAS unsigned* st; };
DI XcdBarrier xcd_barrier_post(unsigned* bar, volatile LAS unsigned* st) {
    XcdBarrier b; b.bar = bar; b.x = xb_xcc_id(); b.st = st;
    if (threadIdx.x == 0) (void)xb_add(&bar[XB_XCNT(b.x)], 1u);
    return b;
}
DI void xcd_barrier_complete(unsigned* bar, unsigned x, unsigned& nloc, unsigned& nx) {
    const unsigned G = gridDim.x;
    unsigned sum, cnt, mine, sp = 0u;
    for (;;) {
        sum = 0u; cnt = 0u; mine = 0u;
#pragma unroll
        for (unsigned j = 0; j < 16; ++j) { const unsigned c = xb_ld(&bar[XB_XCNT(j)]); sum += c; cnt += (c > 0u) ? 1u : 0u; mine = (j == x) ? c : mine; }
        if (sum == G) break;
        __builtin_amdgcn_s_sleep(1);
        if ((++sp & 255u) == 0u) { if (xb_ld(&bar[XB_TMO])) break; if (sp > XB_SPIN_CAP) { atomicAdd(&bar[XB_TMO], 1u); break; } }
    }
    nloc = mine > 0u ? mine : 1u; nx = cnt > 0u ? cnt : 1u;
}
DI void xcd_barrier(const XcdBarrier& b, int wave_s) {
    asm volatile("s_waitcnt vmcnt(0)" ::: "memory");
    __syncthreads();
    if (wave_s == 0 && lane_id_fresh() == 0) {
        unsigned* bar = b.bar;
        __builtin_amdgcn_s_waitcnt(0);
        unsigned nloc = b.st[0], nx = b.st[1];
        if (nloc == 0u) { xcd_barrier_complete(bar, b.x, nloc, nx); b.st[0] = nloc; b.st[1] = nx; }
        const unsigned old = xb_add(&bar[XB_XSUB(b.x)], 1u);
        const unsigned gen = old / nloc;
        if (old + 1u == (gen + 1u) * nloc) {
            __builtin_amdgcn_fence(__ATOMIC_RELEASE, "agent");
            asm volatile("s_waitcnt vmcnt(0)" ::: "memory");
            const unsigned og = xb_add(&bar[XB_TOP], 1u);
            const unsigned tg = og / nx;
            if (og + 1u == (tg + 1u) * nx) xb_add(&bar[XB_TOPGEN], 1u);
            else XB_SPIN(xb_ld(&bar[XB_TOPGEN]) == tg, bar);
            __builtin_amdgcn_fence(__ATOMIC_ACQUIRE, "agent");
            xb_add(&bar[XB_XGEN(b.x)], 1u);
            asm volatile("s_waitcnt vmcnt(0)" ::: "memory");
        } else {
            XB_SPIN(xb_ld(&bar[XB_XGEN(b.x)]) == gen, bar);
            __builtin_amdgcn_fence(__ATOMIC_ACQUIRE, "agent");
            asm volatile("s_waitcnt vmcnt(0)" ::: "memory");
        }
    }
    __syncthreads();
}

template <bool TILED_IN>
DI void meta_gemm(const bf16_t* am, int lda, const bf16_t* Wt, int N, bf16_t* zo, int ldzo, int nt, LAS unsigned char* lds, int bid, int G, int wave, int lane) {
    const int ntasks = N / 16, r = lane & 15, q = lane >> 4, kq = wave & 3;
    LAS f32x4* part = (LAS f32x4*)lds;
    for (int t0 = 2 * (G - 1 - bid); t0 < ntasks; t0 += 2 * G) {
        const int task = t0 + (wave >> 2), n0 = task * 16;
        const bf16_t* ap = Wt + (size_t)(n0 + r) * D + 8 * q + 512 * kq;
        const bf16_t* bp = TILED_IN ? am + zrowU(SEQ, nt) + zlaneRC(r, 512 * kq + 8 * q) : am + (size_t)r * lda + 8 * q + 512 * kq;
        f32x4 acc = {0.f, 0.f, 0.f, 0.f};
        if (task < ntasks) {
#pragma unroll
            for (int k = 0; k < 16; ++k) { const bf16x8 a = *(const bf16x8*)(ap + 32 * k);
                const bf16x8 b = *(const bf16x8*)(bp + (TILED_IN ? (((k >> 3) << 16) | (((k >> 2) & 1) << 12) | ((k & 3) << 9)) : 32 * k));
                acc = __builtin_amdgcn_mfma_f32_16x16x32_bf16(a, b, acc, 0, 0, 0); }
        }
        part[wave * 64 + lane] = acc;
        __syncthreads();
        if (kq == 0 && task < ntasks) {
            const f32x4 t = (part[wave * 64 + lane] + part[(wave + 1) * 64 + lane]) + (part[(wave + 2) * 64 + lane] + part[(wave + 3) * 64 + lane]);
            u32x2 w; w.x = pk2(t[0], t[1]); w.y = pk2(t[2], t[3]);
            if (TILED_IN) *(u32x2*)(zo + (size_t)(SEQ + r) * ldzo + n0 + 4 * q) = w;
            else *(u32x2*)(zo + zrowU(SEQ, nt) + zlaneRC(r, n0 + 4 * q)) = w;
        }
        __syncthreads();
    }
}

DI void p0_transpose_item(const float* W, int K, int N, bf16_t* WT, LAS float* scr, int item, int lane) {
    const int nblk = N / 32, kb = item / nblk, nb = item % nblk, k0 = 64 * kb, n0 = 32 * nb;
    const int n4 = lane & 7, kr = lane >> 3;
    f32x4 v[8];
#pragma unroll
    for (int i = 0; i < 8; ++i) v[i] = __builtin_nontemporal_load((const f32x4*)(W + (size_t)(k0 + kr + 8 * i) * N + n0 + 4 * n4));
#pragma unroll
    for (int i = 0; i < 8; ++i) { LAS float* d = scr + (kr + 8 * i) * 33 + 4 * n4; d[0] = v[i][0]; d[1] = v[i][1]; d[2] = v[i][2]; d[3] = v[i][3]; }
    asm volatile("s_waitcnt lgkmcnt(0)" ::: "memory");
    const int c = lane & 7;
#pragma unroll
    for (int j = 0; j < 4; ++j) { const int n = (lane >> 3) + 8 * j; const LAS float* s = scr + (8 * c) * 33 + n;
        u32x4 o; o.x = pk2(s[0 * 33], s[1 * 33]); o.y = pk2(s[2 * 33], s[3 * 33]); o.z = pk2(s[4 * 33], s[5 * 33]); o.w = pk2(s[6 * 33], s[7 * 33]);
        *(u32x4*)(WT + (size_t)(n0 + n) * K + k0 + 8 * c) = o; }
    asm volatile("s_waitcnt lgkmcnt(0)" ::: "memory");
}

struct Params {
    const float* x; const float* meta; const float* rel_bias; const float* w_in_a; const float* sinks_a; const float* w_out_a;
    const float* w_in_b; const float* w_out_b; const float* ln_g; const float* ln_b;
    float* out; unsigned char* ws; int probe; int pad;
};


DI void phase_p0(const Params& p, LAS unsigned char* lds, int gw, int NGW, int wave, int lane) {
    LAS float* scr = (LAS float*)(lds + wave * 8448);
    constexpr int I_INA = (D / 64) * (NA / 32), I_OUT = (D / 64) * (D / 32), I_INB = (D / 64) * (NB / 32);
    constexpr int NITEMS = 2 * (I_INA + I_OUT + I_INB + I_OUT);
    for (int it = gw; it < NITEMS; it += NGW) {
        int r = it;
        if (r < 2 * I_INA) { const int j = r / I_INA; p0_transpose_item(p.w_in_a + (size_t)j * D * NA, D, NA, (bf16_t*)(p.ws + WS_W + j * WPAIR + WO_INA), scr, r % I_INA, lane); continue; } r -= 2 * I_INA;
        if (r < 2 * I_OUT) { const int j = r / I_OUT; p0_transpose_item(p.w_out_a + (size_t)j * D * D, D, D, (bf16_t*)(p.ws + WS_W + j * WPAIR + WO_OUTA), scr, r % I_OUT, lane); continue; } r -= 2 * I_OUT;
        if (r < 2 * I_INB) { const int j = r / I_INB; p0_transpose_item(p.w_in_b + (size_t)j * D * NB, D, NB, (bf16_t*)(p.ws + WS_W + j * WPAIR + WO_INB), scr, r % I_INB, lane); continue; } r -= 2 * I_INB;
        { const int j = r / I_OUT; p0_transpose_item(p.w_out_b + (size_t)j * D * D, D, D, (bf16_t*)(p.ws + WS_W + j * WPAIR + WO_OUTB), scr, r % I_OUT, lane); }
    }
    bf16_t* hb = (bf16_t*)(p.ws + WS_HB);
    { unsigned char* zb = p.ws + WS_Z;
      for (size_t i = (size_t)(gw * 64 + lane) * 16; i < (size_t)(18 + 32) << 17; i += (size_t)NGW * 64 * 16) {
          unsigned char* dst = i < ((size_t)18 << 17) ? zb + ((size_t)(64 * 18) << 17) + i : zb + ((size_t)(64 * 32) << 17) + (i - ((size_t)18 << 17));
          *(u32x4*)dst = (u32x4){0u, 0u, 0u, 0u}; } }
    for (int r0 = gw; r0 < LTOK; r0 += 2 * NGW) {
        f32x4 v[2][8];
#pragma unroll
        for (int q = 0; q < 2; ++q) { const int r = r0 + q * NGW < LTOK ? r0 + q * NGW : r0;
            const f32x4* src = (const f32x4*)(r < SEQ ? p.x + (size_t)r * D : p.meta + (size_t)(r - SEQ) * D) + 2 * lane;
#pragma unroll
            for (int j = 0; j < 4; ++j) { v[q][2 * j] = __builtin_nontemporal_load(src + 128 * j); v[q][2 * j + 1] = __builtin_nontemporal_load(src + 128 * j + 1); } }
#pragma unroll
        for (int q = 0; q < 2; ++q) { const int r = r0 + q * NGW; if (r >= LTOK) break;
            u32x4* ob = (u32x4*)(hb + (size_t)r * D) + lane;
#pragma unroll
            for (int j = 0; j < 4; ++j) { const f32x4 a0 = v[q][2 * j], a1 = v[q][2 * j + 1]; u32x4 w; w.x = pk2(a0[0], a0[1]); w.y = pk2(a0[2], a0[3]); w.z = pk2(a1[0], a1[1]); w.w = pk2(a1[2], a1[3]); ob[64 * j] = w; } }
    }
}

DI void phase_ln(const Params& p, int layer, int gw, int NGW, int lane) {
    const float* g = p.ln_g + (size_t)layer * D; const float* b = p.ln_b + (size_t)layer * D;
    bf16_t* hb = (bf16_t*)(p.ws + WS_HB);
    const bool last = layer == DEPTH - 1;
    const int nrows = last ? SEQ : LTOK;
    const unsigned short* h16in = layer == DEPTH - 1 ? (const unsigned short*)(p.ws + WS_W) : (const unsigned short*)p.out;
    unsigned short* h16out = layer == DEPTH - 2 ? (unsigned short*)(p.ws + WS_W) : (unsigned short*)p.out;
    constexpr int R = 2;
    for (int r0 = gw; r0 < nrows; r0 += R * NGW) {
        int rr[R]; bool ok[R];
#pragma unroll
        for (int q = 0; q < R; ++q) { ok[q] = r0 + q * NGW < nrows; rr[q] = ok[q] ? r0 + q * NGW : r0; }
        float v[R][32]; float s1[R], s2[R];
#pragma unroll
        for (int q = 0; q < R; ++q) {
            const u32x4* yb = (const u32x4*)(hb + (size_t)rr[q] * D) + lane;
            u32x4 yv[4];
#pragma unroll
            for (int j = 0; j < 4; ++j) yv[j] = yb[64 * j];
            if (layer == 0) {
                const f32x4* src32 = (const f32x4*)(rr[q] < SEQ ? p.x + (size_t)rr[q] * D : p.meta + (size_t)(rr[q] - SEQ) * D) + 2 * lane;
#pragma unroll
                for (int j = 0; j < 4; ++j) { const f32x4 a0 = src32[128 * j], a1 = src32[128 * j + 1];
                    v[q][8 * j + 0] = a0[0]; v[q][8 * j + 1] = a0[1]; v[q][8 * j + 2] = a0[2]; v[q][8 * j + 3] = a0[3];
                    v[q][8 * j + 4] = a1[0]; v[q][8 * j + 5] = a1[1]; v[q][8 * j + 6] = a1[2]; v[q][8 * j + 7] = a1[3]; }
            } else {
                const u32x4* src16 = (const u32x4*)(h16in + (size_t)rr[q] * D) + lane;
#pragma unroll
                for (int j = 0; j < 4; ++j) { const u32x4 hh = src16[64 * j];
                    v[q][8 * j + 0] = h_lo(hh.x); v[q][8 * j + 1] = h_hi(hh.x); v[q][8 * j + 2] = h_lo(hh.y); v[q][8 * j + 3] = h_hi(hh.y);
                    v[q][8 * j + 4] = h_lo(hh.z); v[q][8 * j + 5] = h_hi(hh.z); v[q][8 * j + 6] = h_lo(hh.w); v[q][8 * j + 7] = h_hi(hh.w); }
            }
            float a1 = 0.f, a2 = 0.f;
#pragma unroll
            for (int j = 0; j < 4; ++j) { const unsigned yw[4] = {yv[j].x, yv[j].y, yv[j].z, yv[j].w};
#pragma unroll
                for (int e = 0; e < 4; ++e) { const float u0 = v[q][8 * j + 2 * e] * DN_ALPHA + bf_lo(yw[e]), u1 = v[q][8 * j + 2 * e + 1] * DN_ALPHA + bf_hi(yw[e]);
                    v[q][8 * j + 2 * e] = u0; v[q][8 * j + 2 * e + 1] = u1; a1 += u0 + u1; a2 += u0 * u0 + u1 * u1; } }
            s1[q] = a1; s2[q] = a2;
        }
#pragma unroll
        for (int o = 1; o < 64; o <<= 1)
#pragma unroll
            for (int q = 0; q < R; ++q) { s1[q] += shflx(s1[q], o, lane); s2[q] += shflx(s2[q], o, lane); }
        float mean[R], rstd[R];
#pragma unroll
        for (int q = 0; q < R; ++q) { mean[q] = s1[q] * (1.f / D); const float var = fmaxf(s2[q] * (1.f / D) - mean[q] * mean[q], 0.f); rstd[q] = 1.0f / sqrtf(var + LN_EPS); }
#pragma unroll
        for (int j = 0; j < 4; ++j) {
            const f32x4 g0 = ((const f32x4*)g)[128 * j + 2 * lane], g1 = ((const f32x4*)g)[128 * j + 2 * lane + 1], b0 = ((const f32x4*)b)[128 * j + 2 * lane], b1 = ((const f32x4*)b)[128 * j + 2 * lane + 1];
            const float gg[8] = {g0[0], g0[1], g0[2], g0[3], g1[0], g1[1], g1[2], g1[3]}, bb[8] = {b0[0], b0[1], b0[2], b0[3], b1[0], b1[1], b1[2], b1[3]};
#pragma unroll
            for (int q = 0; q < R; ++q) { if (!ok[q]) continue;
                float y[8];
#pragma unroll
                for (int e = 0; e < 8; ++e) y[e] = (v[q][8 * j + e] - mean[q]) * rstd[q] * gg[e] + bb[e];
                if (last) { f32x4* o = (f32x4*)(p.out + (size_t)rr[q] * D) + 128 * j + 2 * lane; o[0] = (f32x4){y[0], y[1], y[2], y[3]}; o[1] = (f32x4){y[4], y[5], y[6], y[7]}; }
                else { u32x4 hw; hw.x = pkh2(y[0], y[1]); hw.y = pkh2(y[2], y[3]); hw.z = pkh2(y[4], y[5]); hw.w = pkh2(y[6], y[7]);
                       ((u32x4*)(h16out + (size_t)rr[q] * D) + lane)[64 * j] = hw;
                       u32x4 w; w.x = pk2(y[0], y[1]); w.y = pk2(y[2], y[3]); w.z = pk2(y[4], y[5]); w.w = pk2(y[6], y[7]);
                       ((u32x4*)(hb + (size_t)rr[q] * D) + lane)[64 * j] = w; } }
        }
    }
}

#define MFMA32(a, b, c) __builtin_amdgcn_mfma_f32_32x32x16_bf16((a), (b), (c), 0, 0, 0)
DI float silu_mul(float o, float g) { return o * g / (1.0f + __expf(-g)); }

typedef short s16x4 __attribute__((ext_vector_type(4)));
DI bf16x8 tr_frag(const LAS bf16_t* lo, const LAS bf16_t* hi) {
    const s16x4 a = __builtin_amdgcn_ds_read_tr16_b64_v4i16((LAS s16x4*)lo), b = __builtin_amdgcn_ds_read_tr16_b64_v4i16((LAS s16x4*)hi);
    return __builtin_shufflevector(a, b, 0, 1, 2, 3, 4, 5, 6, 7);
}
constexpr int PB = 160, PA = 96;
constexpr int VS_BYTES = 32 * PB * 2;

template <bool MASKED>
DI void attnB_tile_math(const f32x16& S, int kpos0, int kvalid, int qpos, int h, int lane, float& later, unsigned (&pw)[8]) {
    const float scale2 = 0.08838834764831845f * 1.4426950408889634f;
    float x2[16], sp[16];
#pragma unroll
    for (int r = 0; r < 16; ++r) {
        const float x = S[r] * scale2; x2[r] = x;
        const float e = __builtin_amdgcn_exp2f(-fabsf(x));
        const float v = fmaxf(x, 0.f) + __builtin_amdgcn_logf(1.0f + e);
        if (MASKED) { const int row = (r & 3) + 8 * (r >> 2) + 4 * h; const bool vis = (row < kvalid) && (kpos0 + row < qpos); sp[r] = vis ? v : 0.f; }
        else sp[r] = v;
    }
    float G[4], P[4];
#pragma unroll
    for (int g = 0; g < 4; ++g) { G[g] = (sp[4 * g] + sp[4 * g + 1]) + (sp[4 * g + 2] + sp[4 * g + 3]); P[g] = shflx(G[g], 32, lane); }
    float R[4]; R[3] = 0.f; R[2] = G[3] + P[3]; R[1] = R[2] + (G[2] + P[2]); R[0] = R[1] + (G[1] + P[1]);
    const float total = R[0] + (G[0] + P[0]);
#pragma unroll
    for (int g = 0; g < 4; ++g) {
        float sfx = later + R[g] + (h == 0 ? P[g] : 0.f); float wv[4];
#pragma unroll
        for (int i = 3; i >= 0; --i) {
            const int r = 4 * g + i;
            sfx += sp[r];
            float t = __builtin_amdgcn_exp2f(x2[r] - sfx);
            if (MASKED) { const int row = (r & 3) + 8 * (r >> 2) + 4 * h; const bool vis = (row < kvalid) && (kpos0 + row < qpos); t = vis ? t : 0.f; }
            wv[i] = t;
        }
        pw[2 * g] = pk2(wv[0], wv[1]); pw[2 * g + 1] = pk2(wv[2], wv[3]);
    }
    later += total;
}

DI void attnB_item(bf16_t* z, int hh, int qs, LAS bf16_t* vs, int lane) {
    const int c = lane & 31, h = lane >> 5;
    const bool metaq = qs < 0;
    const int qrow = metaq ? SEQ + c : 32 * qs + c;
    const int qpos = metaq ? (c < NMETA ? c : 0) : NMETA + 32 * qs + c;
    const int trb = (4 * h + ((lane & 15) >> 2)) * PB + 16 * ((lane >> 4) & 1) + 4 * (lane & 3);
    const int qrow0 = metaq ? SEQ : 32 * qs;
    LAS bf16x8* qs_lds = (LAS bf16x8*)(vs + 32 * PB) + lane;
    { const bf16_t* qp = z + zrowU(qrow0, 32) + zlaneRC(c, hh * 128 + 8 * h);
      bf16x8 qf[8];
#pragma unroll
      for (int s = 0; s < 8; ++s) qf[s] = *(const bf16x8*)(qp + (((s >> 1) << 9) | ((s & 1) << 8)));
      asm volatile("s_waitcnt lgkmcnt(0)" ::: "memory");
#pragma unroll
      for (int s = 0; s < 8; ++s) qs_lds[64 * s] = qf[s]; }
    f32x16 acc[4];
#pragma unroll
    for (int dt = 0; dt < 4; ++dt)
#pragma unroll
        for (int i = 0; i < 16; ++i) acc[dt][i] = 0.f;
    float later = 0.f;
    int t = metaq ? -1 : qs;
    const int tfirst = t;
    const bf16_t* kbase = z + zlaneRC(c, 2048 + hh * 128 + 8 * h);
    const bf16_t* vbase = z + zlaneRC(lane & 15, 4096 + hh * 128 + 8 * (lane >> 4));
    bf16x8 kf[8]; u32x4 vv[8];
    { const size_t ro = zrowU(t < 0 ? SEQ : 32 * t, 32);
#pragma unroll
      for (int s = 0; s < 8; ++s) kf[s] = *(const bf16x8*)(kbase + ro + (((s >> 1) << 9) | ((s & 1) << 8)));
#pragma unroll
      for (int i = 0; i < 8; ++i) vv[i] = *(const u32x4*)(vbase + ro + (((i >> 2) << 13) | ((i & 3) << 9))); }
    for (;;) {
        const int kpos0 = t < 0 ? 0 : NMETA + 32 * t, kvalid = t < 0 ? NMETA : 32;
        const int tn = t <= 0 ? -1 : t - 1;
        const size_t ron = zrowU(tn < 0 ? SEQ : 32 * tn, 32);
        f32x16 S; bf16x8 qf[8];
#pragma unroll
        for (int i = 0; i < 16; ++i) S[i] = 0.f;
#pragma unroll
        for (int s = 0; s < 8; ++s) qf[s] = qs_lds[64 * s];
        asm volatile("s_waitcnt lgkmcnt(0)" ::: "memory"); __builtin_amdgcn_sched_barrier(0);
#pragma unroll
        for (int s = 0; s < 8; ++s) S = MFMA32(kf[s], qf[s], S);
#pragma unroll
        for (int s = 0; s < 8; ++s) kf[s] = *(const bf16x8*)(kbase + ron + (((s >> 1) << 9) | ((s & 1) << 8)));
        unsigned pw[8];
        if (t == tfirst || t < 0) attnB_tile_math<true>(S, kpos0, kvalid, qpos, h, lane, later, pw); else attnB_tile_math<false>(S, kpos0, kvalid, qpos, h, lane, later, pw);
        asm volatile("s_waitcnt lgkmcnt(0)" ::: "memory");
#pragma unroll
        for (int i = 0; i < 8; ++i) *(LAS u32x4*)(vs + (16 * (i >> 2) + (lane & 15)) * PB + 32 * (i & 3) + 8 * (lane >> 4)) = vv[i];
#pragma unroll
        for (int i = 0; i < 8; ++i) vv[i] = *(const u32x4*)(vbase + ron + (((i >> 2) << 13) | ((i & 3) << 9)));
        asm volatile("s_waitcnt lgkmcnt(0)" ::: "memory");
        bf16x8 af[2][4];
#pragma unroll
        for (int s = 0; s < 2; ++s)
#pragma unroll
            for (int dt = 0; dt < 4; ++dt) { const LAS bf16_t* lo = vs + trb + 16 * s * PB + 32 * dt; af[s][dt] = tr_frag(lo, lo + 8 * PB); }
        asm volatile("s_waitcnt lgkmcnt(0)" ::: "memory"); __builtin_amdgcn_sched_barrier(0);
#pragma unroll
        for (int s = 0; s < 2; ++s) {
            const u32x4 pwv = {pw[4 * s], pw[4 * s + 1], pw[4 * s + 2], pw[4 * s + 3]};
            const bf16x8 bfrag = __builtin_bit_cast(bf16x8, pwv);
#pragma unroll
            for (int dt = 0; dt < 4; ++dt) acc[dt] = MFMA32(af[s][dt], bfrag, acc[dt]);
        }
        if (t < 0) break;
        if (__all(later > 150.1f)) break;
        t = tn;
    }
    if (!metaq || c < NMETA) {
        bf16_t* orow = z + zrowU(qrow0, 32) + zlaneRC(c, hh * 128 + 4 * h);
        const bf16_t* grow = z + zrowU(qrow0, 32) + zlaneRC(c, 6144 + hh * 128 + 4 * h);
#pragma unroll
        for (int dt = 0; dt < 4; ++dt)
#pragma unroll
            for (int g = 0; g < 4; ++g) {
                const int d0 = (dt << 9) | (g << 7);
                const u32x2 gv = *(const u32x2*)(grow + d0);
                u32x2 o; o.x = pk2(silu_mul(acc[dt][4 * g], bf_lo(gv.x)), silu_mul(acc[dt][4 * g + 1], bf_hi(gv.x)));
                o.y = pk2(silu_mul(acc[dt][4 * g + 2], bf_lo(gv.y)), silu_mul(acc[dt][4 * g + 3], bf_hi(gv.y)));
                *(u32x2*)(orow + d0) = o;
            }
    }
}

template <bool MASKED>
DI void attnA_tile_math(const f32x16& Su, const LAS float* bt, int qpos, int kpos0, int kvalid, bool meta_tile, int h, int lane, float& m, float& l, float& corr, bf16x8 (&bfrag)[2]) {
    float sc[16]; float tmax = -1e30f;
#pragma unroll
    for (int r = 0; r < 16; ++r) {
        const int row = (r & 3) + 8 * (r >> 2) + 4 * h;
        const int dist = qpos - (kpos0 + row);
        if (MASKED) {
            const bool vis = (row < kvalid) && (dist >= 0) && (meta_tile || dist < 128);
            const int di = dist < 0 ? 0 : (dist > 128 ? 128 : dist);
            const float v = Su[r] * (0.125f * 1.4426950408889634f) + bt[di];
            sc[r] = vis ? v : -1e30f;
        } else sc[r] = Su[r] * (0.125f * 1.4426950408889634f) + bt[dist];
        tmax = fmaxf(tmax, sc[r]);
    }
    tmax = fmaxf(tmax, shflx(tmax, 32, lane));
    const float mnew = fmaxf(m, tmax);
    corr = __builtin_amdgcn_exp2f(m - mnew);
    float pr[16]; float psum = 0.f;
#pragma unroll
    for (int r = 0; r < 16; ++r) { pr[r] = __builtin_amdgcn_exp2f(sc[r] - mnew); psum += pr[r]; }
    psum += shflx(psum, 32, lane);
    l = l * corr + psum; m = mnew;
#pragma unroll
    for (int s = 0; s < 2; ++s) {
        u32x4 pw; pw.x = pk2(pr[8 * s], pr[8 * s + 1]); pw.y = pk2(pr[8 * s + 2], pr[8 * s + 3]); pw.z = pk2(pr[8 * s + 4], pr[8 * s + 5]); pw.w = pk2(pr[8 * s + 6], pr[8 * s + 7]);
        bfrag[s] = __builtin_bit_cast(bf16x8, pw);
    }
}

DI void attnA_item(bf16_t* z, const float* sinks, int hp, int qs, LAS bf16_t* vs, const LAS float* btab, int lane) {
    const int c = lane & 31, h = lane >> 5, kvh = hp >> 2;
    const bool metaq = qs < 0;
    const int qrow = metaq ? SEQ + c : 32 * qs + c;
    const int qpos = metaq ? (c < NMETA ? c : 0) : NMETA + 32 * qs + c;
    const int trb = (4 * h + ((lane & 15) >> 2)) * PA + 16 * ((lane >> 4) & 1) + 4 * (lane & 3);
    const int qrow0 = metaq ? SEQ : 32 * qs;
    LAS bf16x8* qs_lds = (LAS bf16x8*)(vs + 32 * PA) + lane;
    { bf16x8 qf[2][4];
#pragma unroll
      for (int u = 0; u < 2; ++u) { const bf16_t* qp = z + zrowU(qrow0, 18) + zlaneRC(c, (2 * hp + u) * 64 + 8 * h);
#pragma unroll
        for (int s = 0; s < 4; ++s) qf[u][s] = *(const bf16x8*)(qp + (((s >> 1) << 9) | ((s & 1) << 8))); }
      asm volatile("s_waitcnt lgkmcnt(0)" ::: "memory");
#pragma unroll
      for (int u = 0; u < 2; ++u)
#pragma unroll
        for (int s = 0; s < 4; ++s) qs_lds[64 * (4 * u + s)] = qf[u][s]; }
    f32x16 acc[2][2];
#pragma unroll
    for (int u = 0; u < 2; ++u)
#pragma unroll
        for (int dt = 0; dt < 2; ++dt)
#pragma unroll
            for (int i = 0; i < 16; ++i) acc[u][dt][i] = 0.f;
    float m[2] = {sinks[2 * hp] * 1.4426950408889634f, sinks[2 * hp + 1] * 1.4426950408889634f}, l[2] = {1.0f, 1.0f};
    const int tlo = metaq ? 0 : (qs - 4 > 0 ? qs - 4 : 0), thi = metaq ? -1 : qs;
    const bf16_t* kbase = z + zlaneRC(c, 2048 + kvh * 64 + 8 * h);
    const bf16_t* vbase = z + zlaneRC(lane & 15, 2304 + kvh * 64 + 8 * (lane >> 4));
    bf16x8 kf[4]; u32x4 vv[4];
    int t = -1;
    { const size_t ro = zrowU(SEQ, 18);
#pragma unroll
      for (int s = 0; s < 4; ++s) kf[s] = *(const bf16x8*)(kbase + ro + (((s >> 1) << 9) | ((s & 1) << 8)));
#pragma unroll
      for (int i = 0; i < 4; ++i) vv[i] = *(const u32x4*)(vbase + ro + (((i >> 1) << 13) | ((i & 1) << 9))); }
    for (;;) {
        const int kpos0 = t < 0 ? 0 : NMETA + 32 * t, kvalid = t < 0 ? NMETA : 32;
        const bool lastt = metaq || t == thi;
        const bool interior = !metaq && t >= 0 && t > qs - 4 && t < qs;
        const int tn = lastt ? t : (t < 0 ? tlo : t + 1);
        const size_t ron = zrowU(tn < 0 ? SEQ : 32 * tn, 18);
        bf16x8 bfrag[2][2];
#pragma unroll
        for (int u = 0; u < 2; ++u) {
            f32x16 Su; bf16x8 qf[4];
#pragma unroll
            for (int i = 0; i < 16; ++i) Su[i] = 0.f;
#pragma unroll
            for (int s = 0; s < 4; ++s) qf[s] = qs_lds[64 * (4 * u + s)];
            asm volatile("s_waitcnt lgkmcnt(0)" ::: "memory"); __builtin_amdgcn_sched_barrier(0);
#pragma unroll
            for (int s = 0; s < 4; ++s) Su = MFMA32(kf[s], qf[s], Su);
            if (u == 1) {
#pragma unroll
                for (int s = 0; s < 4; ++s) kf[s] = *(const bf16x8*)(kbase + ron + (((s >> 1) << 9) | ((s & 1) << 8)));
            }
            const LAS float* bt = btab + (2 * hp + u) * 129;
            float corr;
            if (interior) attnA_tile_math<false>(Su, bt, qpos, kpos0, kvalid, t < 0, h, lane, m[u], l[u], corr, bfrag[u]);
            else attnA_tile_math<true>(Su, bt, qpos, kpos0, kvalid, t < 0, h, lane, m[u], l[u], corr, bfrag[u]);
#pragma unroll
            for (int dt = 0; dt < 2; ++dt)
#pragma unroll
                for (int i = 0; i < 16; ++i) acc[u][dt][i] *= corr;
        }
        asm volatile("s_waitcnt lgkmcnt(0)" ::: "memory");
#pragma unroll
        for (int i = 0; i < 4; ++i) *(LAS u32x4*)(vs + (16 * (i >> 1) + (lane & 15)) * PA + 32 * (i & 1) + 8 * (lane >> 4)) = vv[i];
#pragma unroll
        for (int i = 0; i < 4; ++i) vv[i] = *(const u32x4*)(vbase + ron + (((i >> 1) << 13) | ((i & 1) << 9)));
        asm volatile("s_waitcnt lgkmcnt(0)" ::: "memory");
        bf16x8 af[2][2];
#pragma unroll
        for (int s = 0; s < 2; ++s)
#pragma unroll
            for (int dt = 0; dt < 2; ++dt) { const LAS bf16_t* lo = vs + trb + 16 * s * PA + 32 * dt; af[s][dt] = tr_frag(lo, lo + 8 * PA); }
        asm volatile("s_waitcnt lgkmcnt(0)" ::: "memory"); __builtin_amdgcn_sched_barrier(0);
#pragma unroll
        for (int s = 0; s < 2; ++s)
#pragma unroll
            for (int dt = 0; dt < 2; ++dt) {
                acc[0][dt] = MFMA32(af[s][dt], bfrag[0][s], acc[0][dt]);
                acc[1][dt] = MFMA32(af[s][dt], bfrag[1][s], acc[1][dt]);
            }
        if (lastt) break;
        t = tn;
    }
    if (!metaq || c < NMETA) {
#pragma unroll
        for (int u = 0; u < 2; ++u) {
            const float inv = 1.0f / l[u];
            bf16_t* orow = z + zrowU(qrow0, 18) + zlaneRC(c, (2 * hp + u) * 64 + 4 * h);
            const bf16_t* grow = z + zrowU(qrow0, 18) + zlaneRC(c, 2560 + (2 * hp + u) * 64 + 4 * h);
#pragma unroll
            for (int dt = 0; dt < 2; ++dt)
#pragma unroll
                for (int g = 0; g < 4; ++g) {
                    const int d0 = (dt << 9) | (g << 7);
                    const u32x2 gv = *(const u32x2*)(grow + d0);
                    u32x2 o; o.x = pk2(silu_mul(acc[u][dt][4 * g] * inv, bf_lo(gv.x)), silu_mul(acc[u][dt][4 * g + 1] * inv, bf_hi(gv.x)));
                    o.y = pk2(silu_mul(acc[u][dt][4 * g + 2] * inv, bf_lo(gv.y)), silu_mul(acc[u][dt][4 * g + 3] * inv, bf_hi(gv.y)));
                    *(u32x2*)(orow + d0) = o;
                }
        }
    }
}

constexpr int NQS = SEQ / 32;

struct AttnQueue { unsigned* heads; int x; int cur; };
DI bool attn_next(AttnQueue& q, int lane0, int& qs, int& hd) {
    for (;;) {
        if (q.cur >= 8) return false;
        const int xq = (q.x + q.cur) & 7;
        const int nqs = NQS / 8 + (xq == 7 ? 1 : 0);
        unsigned n = 0;
        if (lane0) n = __hip_atomic_fetch_add(q.heads + 64 * xq, 1u, __ATOMIC_RELAXED, __HIP_MEMORY_SCOPE_AGENT);
        n = (unsigned)__builtin_amdgcn_readfirstlane((int)n);
        if (n < (unsigned)(nqs * 16)) { qs = (NQS / 8) * xq + (int)(n >> 4); hd = (int)(n & 15u); return true; }
        ++q.cur;
    }
}


__global__ void __launch_bounds__(NTHREADS) hybrid_fwd(Params p) {
    extern __shared__ __attribute__((aligned(16))) unsigned char lds_raw[];
    LAS unsigned char* lds = (LAS unsigned char*)lds_raw;
    cg::grid_group grid = cg::this_grid();
    bf16_t* hb = (bf16_t*)(p.ws + WS_HB);
    bf16_t* z = (bf16_t*)(p.ws + WS_Z);
    unsigned* barw = (unsigned*)(p.ws + WS_BAR);
    volatile LAS unsigned* bst = (volatile LAS unsigned*)(lds + LDS_MAIN);
    {
        const int tid = threadIdx.x, lane = tid & 63, wave = __builtin_amdgcn_readfirstlane(tid >> 6);
        const int G = gridDim.x, gw = blockIdx.x * NWAVES + wave, NGW = G * NWAVES;
        if (tid < 2) bst[tid] = 0u;
        if (blockIdx.x == 0) { for (int i = tid; i < XCD_BAR_WORDS; i += NTHREADS) barw[i] = 0u; for (int i = tid; i < 4 * 8 * 64; i += NTHREADS) ((unsigned*)(p.ws + WS_Q))[i] = 0u; }
        phase_p0(p, lds, gw, NGW, wave, lane);
    }
    grid.sync();
    const int wave_s = __builtin_amdgcn_readfirstlane(threadIdx.x >> 6);
    const XcdBarrier xb = xcd_barrier_post(barw, bst);
#define GSYNC() xcd_barrier(xb, wave_s)

#define PHASE_IDS() int lane = lane_id_fresh(); int wave = wave_s; asm volatile("" : "+s"(wave)); \
        int bid = blockIdx.x; asm volatile("" : "+s"(bid)); int G = gridDim.x; asm volatile("" : "+s"(G)); \
        const int tid = wave * 64 + lane, gw = bid * NWAVES + wave, NGW = G * NWAVES; (void)tid; (void)gw; (void)NGW
#pragma unroll 1
    for (int layer = 0; layer < DEPTH; ++layer) {
        const int j = layer >> 1;
        const bool isA = (layer & 1) == 0;
        {
            PHASE_IDS();
            const int N = isA ? NA : NB;
            const bf16_t* wt = isA ? (const bf16_t*)(p.ws + WS_W + j * WPAIR + WO_INA) : (const bf16_t*)(p.ws + WS_W + j * WPAIR + WO_INB);
            pg8::StaticOrder S; S.init(SEQ, N, G, bid);
            pg8::Gemm g{hb, wt, SEQ, N, D, D, 0};
            pg8::EpiBf16 E{z, 0, N / 256}; pg8::gemm_phase<pg8::EpiBf16>(lds, g, S, E, tid);
            meta_gemm<false>(hb + (size_t)SEQ * D, D, wt, N, z, 0, N / 256, lds, bid, G, wave, lane);
        }
        GSYNC();
        if (isA) {
            PHASE_IDS();
            LAS float* btab = (LAS float*)(lds + 8 * 14336);
            for (int idx = tid; idx < 32 * 129; idx += NTHREADS) {
                const int hd = idx / 129, d = idx % 129;
                int bucket = d;
                if (d >= 16) { bucket = 16 + (int)(logf((float)d * (1.0f / 16.0f)) / 2.0794415416798357f * 16.0f); bucket = bucket > 31 ? 31 : bucket; }
                btab[idx] = p.rel_bias[bucket * 32 + hd] * 1.4426950408889634f;
            }
            __syncthreads();
            LAS bf16_t* vs = (LAS bf16_t*)(lds + wave * 14336);
            const float* sinks = p.sinks_a + j * 32;
            AttnQueue aq{(unsigned*)(p.ws + WS_Q) + layer * 8 * 64, (int)(xb.x & 7u), 0}; int qs, hd;
            while (attn_next(aq, lane_id_fresh() == 0, qs, hd)) attnA_item(z, sinks, hd, qs == NQS ? -1 : qs, vs, btab, lane_id_fresh());
        } else {
            PHASE_IDS();
            LAS bf16_t* vs = (LAS bf16_t*)(lds + wave * (VS_BYTES + 8192));
            AttnQueue aq{(unsigned*)(p.ws + WS_Q) + layer * 8 * 64, (int)(xb.x & 7u), 0}; int qs, hd;
            while (attn_next(aq, lane_id_fresh() == 0, qs, hd)) attnB_item(z, hd, qs == NQS ? -1 : qs, vs, lane_id_fresh());
        }
        GSYNC();
        {
            PHASE_IDS();
            const int znt = isA ? NA / 256 : NB / 256;
            pg8::StaticOrder S; S.init(SEQ, D, G, bid);
            const bf16_t* wt = isA ? (const bf16_t*)(p.ws + WS_W + j * WPAIR + WO_OUTA) : (const bf16_t*)(p.ws + WS_W + j * WPAIR + WO_OUTB);
            pg8::Gemm g{z, wt, SEQ, D, D, 0, znt};
            pg8::EpiBf16 E{hb, D, 0}; pg8::gemm_phase<pg8::EpiBf16>(lds, g, S, E, tid);
            if (layer != DEPTH - 1) meta_gemm<true>(z, 0, wt, D, hb, D, znt, lds, bid, G, wave, lane);
        }
        GSYNC();
        {
            PHASE_IDS();
            phase_ln(p, layer, gw, NGW, lane);
        }
        if (layer != DEPTH - 1) GSYNC();
    }
}

extern "C" void kernel_launch(void* const* d_in, const int* in_sizes, int n_in, void* d_out, int out_size, void* d_ws, size_t ws_size, hipStream_t stream) {
    static int grid = 0;
    if (grid == 0) {
        if (n_in != 10 || out_size != SEQ * D || ws_size < WS_END) { fprintf(stderr, "kernel_launch: unexpected shapes (n_in %d out %d ws %zu, need %zu)\n", n_in, out_size, ws_size, (size_t)WS_END); grid = -1; return; }
        int dev = 0, cus = 0, per_cu = 0;
        hipGetDevice(&dev);
        hipDeviceGetAttribute(&cus, hipDeviceAttributeMultiprocessorCount, dev);
        if (hipFuncSetAttribute((const void*)hybrid_fwd, hipFuncAttributeMaxDynamicSharedMemorySize, LDS_BYTES) != hipSuccess) { fprintf(stderr, "kernel_launch: hipFuncSetAttribute failed\n"); grid = -1; return; }
        if (hipOccupancyMaxActiveBlocksPerMultiprocessor(&per_cu, (const void*)hybrid_fwd, NTHREADS, LDS_BYTES) != hipSuccess || per_cu < 1) { fprintf(stderr, "kernel_launch: occupancy query failed (%d)\n", per_cu); (void)hipGetLastError(); per_cu = 1; }
        grid = cus * 1;
    }
    if (grid < 0) return;
    Params p{};
    p.x = (const float*)d_in[0]; p.meta = (const float*)d_in[1]; p.rel_bias = (const float*)d_in[2]; p.w_in_a = (const float*)d_in[3]; p.sinks_a = (const float*)d_in[4];
    p.w_out_a = (const float*)d_in[5]; p.w_in_b = (const float*)d_in[6]; p.w_out_b = (const float*)d_in[7]; p.ln_g = (const float*)d_in[8]; p.ln_b = (const float*)d_in[9];
    p.out = (float*)d_out; p.ws = (unsigned char*)d_ws; p.probe = 1;
    void* args[] = {&p};
    hipError_t e = hipLaunchCooperativeKernel((const void*)hybrid_fwd, dim3(grid), dim3(NTHREADS), args, LDS_BYTES, stream);
    if (e != hipSuccess) fprintf(stderr, "kernel_launch: cooperative launch failed: %s (grid %d)\n", hipGetErrorString(e), grid);
}
```

```cpp
#include <hip/hip_runtime.h>
#include <hip/hip_cooperative_groups.h>
#include <cstdio>
namespace cg = cooperative_groups;

#define LAS __attribute__((address_space(3)))
#define DI __device__ __forceinline__
typedef unsigned short bf16_t;
typedef short bf16x8 __attribute__((ext_vector_type(8)));
typedef float f32x2 __attribute__((ext_vector_type(2)));
typedef float f32x4 __attribute__((ext_vector_type(4)));
typedef float f32x16 __attribute__((ext_vector_type(16)));
typedef unsigned u32x2 __attribute__((ext_vector_type(2)));
typedef unsigned u32x4 __attribute__((ext_vector_type(4)));
typedef __bf16 bf16v2 __attribute__((ext_vector_type(2)));

constexpr int D = 2048, SEQ = 16384, NMETA = 16, LTOK = SEQ + NMETA, MPAD = SEQ + 256;
constexpr int NA = 4608, NB = 8192, DEPTH = 4;
constexpr int NTHREADS = 512, NWAVES = 8;
constexpr int LDS_MAIN = 147456, LDS_BYTES = LDS_MAIN + 16;
constexpr float LN_EPS = 1e-5f;
constexpr float DN_ALPHA = 1.6817928305074290f;

constexpr size_t WS_W = 0;
constexpr size_t WPAIR = (size_t)(NA + D + NB + D) * D * 2;
constexpr size_t WO_INA = 0, WO_OUTA = (size_t)NA * D * 2, WO_INB = WO_OUTA + (size_t)D * D * 2, WO_OUTB = WO_INB + (size_t)NB * D * 2;
constexpr size_t WS_HB = WS_W + 2 * WPAIR;
constexpr size_t WS_Z = WS_HB + (size_t)MPAD * D * 2;
constexpr size_t WS_BAR = WS_Z + (size_t)MPAD * NB * 2;
static_assert((size_t)LTOK * D * 2 <= WPAIR, "the fp16 residual stream must fit in the first layer pair's weight region");
constexpr size_t WS_Q = WS_BAR + 16384;
constexpr size_t WS_END = WS_Q + 4 * 8 * 256;

DI unsigned pk2(float a, float b) { f32x2 v = {a, b}; bf16v2 r = __builtin_convertvector(v, bf16v2); return __builtin_bit_cast(unsigned, r); }
typedef _Float16 h16v2 __attribute__((ext_vector_type(2)));
DI unsigned pkh2(float a, float b) { f32x2 v = {a, b}; h16v2 r = __builtin_convertvector(v, h16v2); return __builtin_bit_cast(unsigned, r); }
DI float h_lo(unsigned u) { return (float)__builtin_bit_cast(h16v2, u)[0]; }
DI float h_hi(unsigned u) { return (float)__builtin_bit_cast(h16v2, u)[1]; }
DI float bf_lo(unsigned u) { return __uint_as_float(u << 16); }
DI float bf_hi(unsigned u) { return __uint_as_float(u & 0xffff0000u); }
DI float shflx(float v, int mask, int lane) { return __int_as_float(__builtin_amdgcn_ds_bpermute((lane ^ mask) << 2, __float_as_int(v))); }
DI int lane_id_fresh() { unsigned zero; asm volatile("v_mov_b32 %0, 0" : "=v"(zero)); return (int)__builtin_amdgcn_mbcnt_hi(~0u, __builtin_amdgcn_mbcnt_lo(~0u, zero)); }
DI float wave_sum(float v, int lane) {
#pragma unroll
    for (int o = 1; o < 64; o <<= 1) v += shflx(v, o, lane);
    return v;
}


DI size_t zrowU(int row0, int NT) { return ((size_t)((row0 >> 8) * NT) << 16) + (size_t)((((row0 >> 7) & 1) << 15) | (((row0 >> 5) & 1) << 14) | (((row0 >> 6) & 1) << 11)); }
DI unsigned zlaneRC(int r5, int col) { return (unsigned)(((col >> 8) << 16) | ((r5 >> 4) << 13) | (((col >> 7) & 1) << 12) | (((col >> 5) & 3) << 9) | (((col >> 3) & 3) << 7) | ((r5 & 15) << 3) | (col & 7)); }

namespace pg8 {
constexpr int BM = 256, BK = 64, HALF = 128, HTB = HALF * BK * 2, NXCD = 8, WGM = 8;
DI int lds_byte(int r, int c) { const int st = (r >> 4) * 2 + (c >> 5), rr = r & 15, cc = c & 31, ob = rr * 64 + cc * 2; return st * 1024 + (ob ^ (((ob >> 9) & 1) << 5)); }
DI void stage_rc(int b, int& R, int& C) { const int st = b / 1024, sb = b % 1024, swz = sb ^ (((sb >> 9) & 1) << 5); R = (st >> 1) * 16 + swz / 64; C = (st & 1) * 32 + (swz % 64) / 2; }
DI int perm32(int rho) { const int n = rho >> 4, i = rho & 15; return 8 * (i >> 2) + 4 * n + (i & 3); }

struct Unit { int pm, pn; };
struct Gemm { const bf16_t* A; const bf16_t* Bt; int M, N, K, lda; int ant; };

struct StaticOrder {
    int nM, nN, nwg, G, c;
    DI void init(int M, int N, int G_, int c_) { nM = M / BM; nN = N / BM; nwg = nM * nN; G = G_; c = c_; }
    DI bool next(int i, Unit& u) const {
        const long L = (long)i * G + c; if (L >= nwg) return false;
        int wgid = (int)L; { const int q = nwg / NXCD, r = nwg % NXCD, xcd = wgid % NXCD, off = wgid / NXCD; wgid = (xcd < r ? xcd * (q + 1) : r * (q + 1) + (xcd - r) * q) + off; }
        const int nig = WGM * nN, gid = wgid / nig, fm = gid * WGM, gsz = (nM - fm) < WGM ? (nM - fm) : WGM;
        u.pm = fm + ((wgid % nig) % gsz); u.pn = (wgid % nig) / gsz; return true;
    }
};

struct EpiBf16 {
    static constexpr bool PERM = true;
    bf16_t* O; int ldc; int nt;
    DI void operator()(const f32x4 (&acc)[2][2][4][2], const Unit& u, int wr, int wc, int fr, int fq) const {
        if (nt) {
            unsigned char* tb = (unsigned char*)O + ((size_t)(u.pm * nt + u.pn) << 17) + (wr * 4 + wc) * 1024 + (fq * 16 + fr) * 16;
#pragma unroll
            for (int ai = 0; ai < 2; ++ai)
#pragma unroll
                for (int m = 0; m < 4; ++m)
#pragma unroll
                    for (int bj = 0; bj < 2; ++bj) { const f32x4 v0 = acc[ai][bj][m][0], v1 = acc[ai][bj][m][1];
                        u32x4 w; w.x = pk2(v0[0], v0[1]); w.y = pk2(v0[2], v0[3]); w.z = pk2(v1[0], v1[1]); w.w = pk2(v1[2], v1[3]);
                        *(u32x4*)(tb + ((ai * 4 + m) * 2 + bj) * 8192) = w; }
            return;
        }
        const int row0 = u.pm * BM + wr * 64 + fr; const int col0 = u.pn * BM + wc * 32 + 8 * fq;
#pragma unroll
        for (int ai = 0; ai < 2; ++ai)
#pragma unroll
            for (int m = 0; m < 4; ++m) { bf16_t* rowp = O + (size_t)(row0 + ai * HALF + m * 16) * ldc + col0;
#pragma unroll
                for (int bj = 0; bj < 2; ++bj) { const f32x4 v0 = acc[ai][bj][m][0], v1 = acc[ai][bj][m][1];
                    u32x4 w; w.x = pk2(v0[0], v0[1]); w.y = pk2(v0[2], v0[3]); w.z = pk2(v1[0], v1[1]); w.w = pk2(v1[2], v1[3]);
                    *(u32x4*)(rowp + bj * HALF) = w; } }
    }
};

template <class Epi>
DI void gemm_phase(LAS unsigned char* lds, const Gemm g, const StaticOrder& S, const Epi& E, const int tid) {
    const int wid = __builtin_amdgcn_readfirstlane(tid >> 6), lane = tid & 63, wr = wid >> 2, wc = wid & 3, fr = lane & 15, fq = lane >> 4;
    const int K = g.K, nt = K / BK, lda = g.lda;
    unsigned voffA[2], voffB[2];
#pragma unroll
    for (int i = 0; i < 2; ++i) { int R, C; stage_rc(tid * 16 + i * 8192, R, C); const int Rb = Epi::PERM ? ((R & ~31) + perm32(R & 31)) : R;
        voffA[i] = g.ant ? (unsigned)((((R >> 4) & 3) << 14) | (((R >> 6) & 1) << 12) | (((C >> 5) & 1) << 10) | (((C >> 3) & 3) << 8) | ((R & 15) << 4)) : (unsigned)(R * lda + C) * 2u;
        voffB[i] = (unsigned)(Rb * K + C) * 2u; }
    const size_t kstep = (size_t)(BK * 2);
    const size_t hstepA = g.ant ? (size_t)65536 : (size_t)HALF * lda * 2, hstepB = (size_t)HALF * K * 2;
    const size_t tstepA = g.ant ? (size_t)g.ant * 131072 : 2 * hstepA, tstepB = 2 * hstepB;
#define PG8_KTA(t) (g.ant ? ((size_t)((t) >> 2) * 131072 + (size_t)((((t) >> 1) & 1) * 8192 + ((t) & 1) * 2048)) : (size_t)(t) * kstep)
    const unsigned ldsw = (unsigned)wid * 1024u;
    const int aoff = lds_byte(wr * 64 + fr, fq * 8), boff = lds_byte(wc * 32 + fr, fq * 8);
#define PG8_SA(b, h) (((b) * 2 + (h)) * HTB)
#define PG8_SB(b, h) ((4 + (b) * 2 + (h)) * HTB)
#define PG8_STAGE(bufoff, gbase, voff) do { _Pragma("unroll") for (int _i = 0; _i < 2; ++_i) \
        __builtin_amdgcn_global_load_lds((const unsigned*)((const char*)(gbase) + (voff)[_i]), (LAS unsigned*)(lds + (bufoff) + ldsw + _i * 8192), 16, 0, 0); } while (0)
#define PG8_LDA(dst, b, h) do { _Pragma("unroll") for (int m = 0; m < 4; ++m) _Pragma("unroll") for (int k = 0; k < 2; ++k) dst[m][k] = *(const LAS bf16x8*)(lds + PG8_SA(b, h) + aoff + m * 2048 + k * 1024); } while (0)
#define PG8_LDB(dst, b, h) do { _Pragma("unroll") for (int n = 0; n < 2; ++n) _Pragma("unroll") for (int k = 0; k < 2; ++k) dst[n][k] = *(const LAS bf16x8*)(lds + PG8_SB(b, h) + boff + n * 2048 + k * 1024); } while (0)
#define PG8_MMA(ai, bj, At, Bt) do { __builtin_amdgcn_s_setprio(1); _Pragma("unroll") for (int m = 0; m < 4; ++m) _Pragma("unroll") for (int n = 0; n < 2; ++n) _Pragma("unroll") for (int k = 0; k < 2; ++k) \
        acc[ai][bj][m][n] = __builtin_amdgcn_mfma_f32_16x16x32_bf16(Bt[n][k], At[m][k], acc[ai][bj][m][n], 0, 0, 0); __builtin_amdgcn_s_setprio(0); } while (0)
#define PG8_WAIT_V(n) asm volatile("s_waitcnt vmcnt(" #n ")" ::: "memory")
#define PG8_WAIT_L(n) asm volatile("s_waitcnt lgkmcnt(" #n ")" ::: "memory")
#define PG8_BAR __builtin_amdgcn_s_barrier()
#define PG8_SCHED __builtin_amdgcn_sched_barrier(0)
    Unit cur, nxt; int ui = 0;
    if (!S.next(0, cur)) return;
    f32x4 acc[2][2][4][2];
#pragma unroll
    for (int a = 0; a < 2; ++a)
#pragma unroll
        for (int b = 0; b < 2; ++b)
#pragma unroll
            for (int m = 0; m < 4; ++m)
#pragma unroll
                for (int n = 0; n < 2; ++n) acc[a][b][m][n] = (f32x4){0.f, 0.f, 0.f, 0.f};
    bf16x8 At[4][2], B0[2][2], B1[2][2];
    const char* cA = (const char*)g.A + (size_t)cur.pm * tstepA; const char* cB = (const char*)g.Bt + (size_t)cur.pn * tstepB;
    PG8_STAGE(PG8_SB(0, 0), cB, voffB); PG8_STAGE(PG8_SA(0, 0), cA, voffA); PG8_STAGE(PG8_SB(0, 1), cB + hstepB, voffB); PG8_STAGE(PG8_SA(0, 1), cA + hstepA, voffA);
    if (wr == 1) PG8_BAR;
    PG8_WAIT_V(4); PG8_BAR;
    PG8_STAGE(PG8_SB(1, 0), cB + kstep, voffB); PG8_STAGE(PG8_SA(1, 0), cA + PG8_KTA(1), voffA); PG8_STAGE(PG8_SB(1, 1), cB + hstepB + kstep, voffB);
    PG8_WAIT_V(6); PG8_BAR;
    for (;;) {
        const bool has_next = S.next(ui + 1, nxt);
        const char* nA = has_next ? (const char*)g.A + (size_t)nxt.pm * tstepA : cA; const char* nB = has_next ? (const char*)g.Bt + (size_t)nxt.pn * tstepB : cB;
        for (int t = 0; t < nt; t += 2) {
            const bool last = (t == nt - 2);
            const char* a1 = cA + PG8_KTA(t + 1);
            const char* a2 = last ? nA : cA + PG8_KTA(t + 2); const char* b2 = last ? nB : cB + (size_t)(t + 2) * kstep;
            const char* a3 = last ? nA + PG8_KTA(1) : cA + PG8_KTA(t + 3); const char* b3 = b2 + kstep;
            PG8_LDB(B0, 0, 0); PG8_SCHED; PG8_LDA(At, 0, 0); PG8_STAGE(PG8_SA(1, 1), a1 + hstepA, voffA);
            PG8_WAIT_L(8); PG8_BAR; PG8_WAIT_L(0); PG8_MMA(0, 0, At, B0); PG8_BAR; PG8_SCHED;
            PG8_LDB(B1, 0, 1); PG8_STAGE(PG8_SB(0, 0), b2, voffB);
            PG8_BAR; PG8_WAIT_L(0); PG8_MMA(0, 1, At, B1); PG8_BAR;
            PG8_LDA(At, 0, 1); PG8_STAGE(PG8_SA(0, 0), a2, voffA);
            PG8_BAR; PG8_WAIT_L(0); PG8_MMA(1, 0, At, B0); PG8_BAR; PG8_SCHED;
            PG8_STAGE(PG8_SB(0, 1), b2 + hstepB, voffB);
            PG8_WAIT_V(6); PG8_BAR; PG8_MMA(1, 1, At, B1); PG8_BAR;
            PG8_LDB(B0, 1, 0); PG8_SCHED; PG8_LDA(At, 1, 0); PG8_STAGE(PG8_SA(0, 1), a2 + hstepA, voffA);
            PG8_WAIT_L(8); PG8_BAR; PG8_WAIT_L(0); PG8_MMA(0, 0, At, B0); PG8_BAR; PG8_SCHED;
            PG8_LDB(B1, 1, 1); PG8_STAGE(PG8_SB(1, 0), b3, voffB);
            PG8_BAR; PG8_WAIT_L(0); PG8_MMA(0, 1, At, B1); PG8_BAR;
            PG8_LDA(At, 1, 1); PG8_STAGE(PG8_SA(1, 0), a3, voffA);
            PG8_BAR; PG8_WAIT_L(0); PG8_MMA(1, 0, At, B0); PG8_BAR; PG8_SCHED;
            PG8_STAGE(PG8_SB(1, 1), b3 + hstepB, voffB);
            PG8_WAIT_V(6); PG8_BAR; PG8_MMA(1, 1, At, B1); PG8_BAR;
        }
        E(acc, cur, wr, wc, fr, fq);
        if (!has_next) break;
#pragma unroll
        for (int a = 0; a < 2; ++a)
#pragma unroll
            for (int b = 0; b < 2; ++b)
#pragma unroll
                for (int m = 0; m < 4; ++m)
#pragma unroll
                    for (int n = 0; n < 2; ++n) acc[a][b][m][n] = (f32x4){0.f, 0.f, 0.f, 0.f};
        cur = nxt; cA = nA; cB = nB; ++ui;
    }
    PG8_WAIT_V(0);
    if (wr == 0) PG8_BAR;
    PG8_BAR;
#undef PG8_KTA
#undef PG8_SA
#undef PG8_SB
#undef PG8_STAGE
#undef PG8_LDA
#undef PG8_LDB
#undef PG8_MMA
#undef PG8_WAIT_V
#undef PG8_WAIT_L
#undef PG8_BAR
#undef PG8_SCHED
}
}


#define XB_TMO      128
#define XB_XCNT(j)  (256  + 64 * (j))
#define XB_XSUB(j)  (1280 + 64 * (j))
#define XB_XGEN(j)  (2304 + 64 * (j))
#define XB_TOP      3328
#define XB_TOPGEN   3392
#define XCD_BAR_WORDS 3456
#define XB_SPIN_CAP (1u << 22)
DI unsigned xb_ld(unsigned* p)              { return __hip_atomic_load(p, __ATOMIC_RELAXED, __HIP_MEMORY_SCOPE_AGENT); }
DI unsigned xb_add(unsigned* p, unsigned v) { return __hip_atomic_fetch_add(p, v, __ATOMIC_RELAXED, __HIP_MEMORY_SCOPE_AGENT); }
DI unsigned xb_xcc_id() { return (unsigned)__builtin_amdgcn_s_getreg((3 << 11) | 20) & 0xFu; }
#define XB_SPIN(cond, bar) do { unsigned _sp = 0; while (cond) { __builtin_amdgcn_s_sleep(1); \
    if ((++_sp & 255u) == 0u) { if (xb_ld(&(bar)[XB_TMO])) break; if (_sp > XB_SPIN_CAP) { atomicAdd(&(bar)[XB_TMO], 1u); break; } } } } while (0)
struct XcdBarrier { unsigned* bar; unsigned x; volatile LAS unsigned* st; };
DI XcdBarrier xcd_barrier_post(unsigned* bar, volatile LAS unsigned* st) {
    XcdBarrier b; b.bar = bar; b.x = xb_xcc_id(); b.st = st;
    if (threadIdx.x == 0) (void)xb_add(&bar[XB_XCNT(b.x)], 1u);
    return b;
}
DI void xcd_barrier_complete(unsigned* bar, unsigned x, unsigned& nloc, unsigned& nx) {
    const unsigned G = gridDim.x;
    unsigned sum, cnt, mine, sp = 0u;
    for (;;) {
        sum = 0u; cnt = 0u; mine = 0u;
#pragma unroll
        for (unsigned j = 0; j < 16; ++j) { const unsigned c = xb_ld(&bar[XB_XCNT(j)]); sum += c; cnt += (c > 0u) ? 1u : 0u; mine = (j == x) ? c : mine; }
        if (sum == G) break;
        __builtin_amdgcn_s_sleep(1);
        if ((++sp & 255u) == 0u) { if (xb_ld(&bar[XB_TMO])) break; if (sp > XB_SPIN_CAP) { atomicAdd(&bar[XB_TMO], 1u); break; } }
    }
    nloc = mine > 0u ? mine : 1u; nx = cnt > 0u ? cnt : 1u;
}
DI void xcd_barrier(const XcdBarrier& b, int wave_s) {
    asm volatile("s_waitcnt vmcnt(0)" ::: "memory");
    __syncthreads();
    if (wave_s == 0 && lane_id_fresh() == 0) {
        unsigned* bar = b.bar;
        __builtin_amdgcn_s_waitcnt(0);
        unsigned nloc = b.st[0], nx = b.st[1];
        if (nloc == 0u) { xcd_barrier_complete(bar, b.x, nloc, nx); b.st[0] = nloc; b.st[1] = nx; }
        const unsigned old = xb_add(&bar[XB_XSUB(b.x)], 1u);
        const unsigned gen = old / nloc;
        if (old + 1u == (gen + 1u) * nloc) {
            __builtin_amdgcn_fence(__ATOMIC_RELEASE, "agent");
            asm volatile("s_waitcnt vmcnt(0)" ::: "memory");
            const unsigned og = xb_add(&bar[XB_TOP], 1u);
            const unsigned tg = og / nx;
            if (og + 1u == (tg + 1u) * nx) xb_add(&bar[XB_TOPGEN], 1u);
            else XB_SPIN(xb_ld(&bar[XB_TOPGEN]) == tg, bar);
            __builtin_amdgcn_fence(__ATOMIC_ACQUIRE, "agent");
            xb_add(&bar[XB_XGEN(b.x)], 1u);
            asm volatile("s_waitcnt vmcnt(0)" ::: "memory");
        } else {
            XB_SPIN(xb_ld(&bar[XB_XGEN(b.x)]) == gen, bar);
            __builtin_amdgcn_fence(__ATOMIC_ACQUIRE, "agent");
            asm volatile("s_waitcnt vmcnt(0)" ::: "memory");
        }
    }
    __syncthreads();
}

template <bool TILED_IN>
DI void meta_gemm(const bf16_t* am, int lda, const bf16_t* Wt, int N, bf16_t* zo, int ldzo, int nt, LAS unsigned char* lds, int bid, int G, int wave, int lane) {
    const int ntasks = N / 16, r = lane & 15, q = lane >> 4, kq = wave & 3;
    LAS f32x4* part = (LAS f32x4*)lds;
    for (int t0 = 2 * (G - 1 - bid); t0 < ntasks; t0 += 2 * G) {
        const int task = t0 + (wave >> 2), n0 = task * 16;
        const bf16_t* ap = Wt + (size_t)(n0 + r) * D + 8 * q + 512 * kq;
        const bf16_t* bp = TILED_IN ? am + zrowU(SEQ, nt) + zlaneRC(r, 512 * kq + 8 * q) : am + (size_t)r * lda + 8 * q + 512 * kq;
        f32x4 acc = {0.f, 0.f, 0.f, 0.f};
        if (task < ntasks) {
#pragma unroll
            for (int k = 0; k < 16; ++k) { const bf16x8 a = *(const bf16x8*)(ap + 32 * k);
                const bf16x8 b = *(const bf16x8*)(bp + (TILED_IN ? (((k >> 3) << 16) | (((k >> 2) & 1) << 12) | ((k & 3) << 9)) : 32 * k));
                acc = __builtin_amdgcn_mfma_f32_16x16x32_bf16(a, b, acc, 0, 0, 0); }
        }
        part[wave * 64 + lane] = acc;
        __syncthreads();
        if (kq == 0 && task < ntasks) {
            const f32x4 t = (part[wave * 64 + lane] + part[(wave + 1) * 64 + lane]) + (part[(wave + 2) * 64 + lane] + part[(wave + 3) * 64 + lane]);
            u32x2 w; w.x = pk2(t[0], t[1]); w.y = pk2(t[2], t[3]);
            if (TILED_IN) *(u32x2*)(zo + (size_t)(SEQ + r) * ldzo + n0 + 4 * q) = w;
            else *(u32x2*)(zo + zrowU(SEQ, nt) + zlaneRC(r, n0 + 4 * q)) = w;
        }
        __syncthreads();
    }
}

DI void p0_transpose_item(const float* W, int K, int N, bf16_t* WT, LAS float* scr, int item, int lane) {
    const int nblk = N / 32, kb = item / nblk, nb = item % nblk, k0 = 64 * kb, n0 = 32 * nb;
    const int n4 = lane & 7, kr = lane >> 3;
    f32x4 v[8];
#pragma unroll
    for (int i = 0; i < 8; ++i) v[i] = *(const f32x4*)(W + (size_t)(k0 + kr + 8 * i) * N + n0 + 4 * n4);
#pragma unroll
    for (int i = 0; i < 8; ++i) { LAS float* d = scr + (kr + 8 * i) * 33 + 4 * n4; d[0] = v[i][0]; d[1] = v[i][1]; d[2] = v[i][2]; d[3] = v[i][3]; }
    asm volatile("s_waitcnt lgkmcnt(0)" ::: "memory");
    const int c = lane & 7;
#pragma unroll
    for (int j = 0; j < 4; ++j) { const int n = (lane >> 3) + 8 * j; const LAS float* s = scr + (8 * c) * 33 + n;
        u32x4 o; o.x = pk2(s[0 * 33], s[1 * 33]); o.y = pk2(s[2 * 33], s[3 * 33]); o.z = pk2(s[4 * 33], s[5 * 33]); o.w = pk2(s[6 * 33], s[7 * 33]);
        *(u32x4*)(WT + (size_t)(n0 + n) * K + k0 + 8 * c) = o; }
    asm volatile("s_waitcnt lgkmcnt(0)" ::: "memory");
}

struct Params {
    const float* x; const float* meta; const float* rel_bias; const float* w_in_a; const float* sinks_a; const float* w_out_a;
    const float* w_in_b; const float* w_out_b; const float* ln_g; const float* ln_b;
    float* out; unsigned char* ws; int probe; int pad;
};


DI void phase_p0(const Params& p, LAS unsigned char* lds, int gw, int NGW, int wave, int lane) {
    LAS float* scr = (LAS float*)(lds + wave * 8448);
    constexpr int I_INA = (D / 64) * (NA / 32), I_OUT = (D / 64) * (D / 32), I_INB = (D / 64) * (NB / 32);
    constexpr int NITEMS = 2 * (I_INA + I_OUT + I_INB + I_OUT);
    for (int it = gw; it < NITEMS; it += NGW) {
        int r = it;
        if (r < 2 * I_INA) { const int j = r / I_INA; p0_transpose_item(p.w_in_a + (size_t)j * D * NA, D, NA, (bf16_t*)(p.ws + WS_W + j * WPAIR + WO_INA), scr, r % I_INA, lane); continue; } r -= 2 * I_INA;
        if (r < 2 * I_OUT) { const int j = r / I_OUT; p0_transpose_item(p.w_out_a + (size_t)j * D * D, D, D, (bf16_t*)(p.ws + WS_W + j * WPAIR + WO_OUTA), scr, r % I_OUT, lane); continue; } r -= 2 * I_OUT;
        if (r < 2 * I_INB) { const int j = r / I_INB; p0_transpose_item(p.w_in_b + (size_t)j * D * NB, D, NB, (bf16_t*)(p.ws + WS_W + j * WPAIR + WO_INB), scr, r % I_INB, lane); continue; } r -= 2 * I_INB;
        { const int j = r / I_OUT; p0_transpose_item(p.w_out_b + (size_t)j * D * D, D, D, (bf16_t*)(p.ws + WS_W + j * WPAIR + WO_OUTB), scr, r % I_OUT, lane); }
    }
    bf16_t* hb = (bf16_t*)(p.ws + WS_HB);
    { unsigned char* zb = p.ws + WS_Z;
      for (size_t i = (size_t)(gw * 64 + lane) * 16; i < (size_t)(18 + 32) << 17; i += (size_t)NGW * 64 * 16) {
          unsigned char* dst = i < ((size_t)18 << 17) ? zb + ((size_t)(64 * 18) << 17) + i : zb + ((size_t)(64 * 32) << 17) + (i - ((size_t)18 << 17));
          *(u32x4*)dst = (u32x4){0u, 0u, 0u, 0u}; } }
    for (int r0 = gw; r0 < LTOK; r0 += 2 * NGW) {
        f32x4 v[2][8];
#pragma unroll
        for (int q = 0; q < 2; ++q) { const int r = r0 + q * NGW < LTOK ? r0 + q * NGW : r0;
            const f32x4* src = (const f32x4*)(r < SEQ ? p.x + (size_t)r * D : p.meta + (size_t)(r - SEQ) * D) + 2 * lane;
#pragma unroll
            for (int j = 0; j < 4; ++j) { v[q][2 * j] = src[128 * j]; v[q][2 * j + 1] = src[128 * j + 1]; } }
#pragma unroll
        for (int q = 0; q < 2; ++q) { const int r = r0 + q * NGW; if (r >= LTOK) break;
            u32x4* ob = (u32x4*)(hb + (size_t)r * D) + lane;
#pragma unroll
            for (int j = 0; j < 4; ++j) { const f32x4 a0 = v[q][2 * j], a1 = v[q][2 * j + 1]; u32x4 w; w.x = pk2(a0[0], a0[1]); w.y = pk2(a0[2], a0[3]); w.z = pk2(a1[0], a1[1]); w.w = pk2(a1[2], a1[3]); ob[64 * j] = w; } }
    }
}

DI void phase_ln(const Params& p, int layer, int gw, int NGW, int lane) {
    const float* g = p.ln_g + (size_t)layer * D; const float* b = p.ln_b + (size_t)layer * D;
    bf16_t* hb = (bf16_t*)(p.ws + WS_HB);
    const bool last = layer == DEPTH - 1;
    const int nrows = last ? SEQ : LTOK;
    const unsigned short* h16in = layer == DEPTH - 1 ? (const unsigned short*)(p.ws + WS_W) : (const unsigned short*)p.out;
    unsigned short* h16out = layer == DEPTH - 2 ? (unsigned short*)(p.ws + WS_W) : (unsigned short*)p.out;
    constexpr int R = 2;
    for (int r0 = gw; r0 < nrows; r0 += R * NGW) {
        int rr[R]; bool ok[R];
#pragma unroll
        for (int q = 0; q < R; ++q) { ok[q] = r0 + q * NGW < nrows; rr[q] = ok[q] ? r0 + q * NGW : r0; }
        float v[R][32]; float s1[R], s2[R];
#pragma unroll
        for (int q = 0; q < R; ++q) {
            const u32x4* yb = (const u32x4*)(hb + (size_t)rr[q] * D) + lane;
            u32x4 yv[4];
#pragma unroll
            for (int j = 0; j < 4; ++j) yv[j] = yb[64 * j];
            if (layer == 0) {
                const f32x4* src32 = (const f32x4*)(rr[q] < SEQ ? p.x + (size_t)rr[q] * D : p.meta + (size_t)(rr[q] - SEQ) * D) + 2 * lane;
#pragma unroll
                for (int j = 0; j < 4; ++j) { const f32x4 a0 = src32[128 * j], a1 = src32[128 * j + 1];
                    v[q][8 * j + 0] = a0[0]; v[q][8 * j + 1] = a0[1]; v[q][8 * j + 2] = a0[2]; v[q][8 * j + 3] = a0[3];
                    v[q][8 * j + 4] = a1[0]; v[q][8 * j + 5] = a1[1]; v[q][8 * j + 6] = a1[2]; v[q][8 * j + 7] = a1[3]; }
            } else {
                const u32x4* src16 = (const u32x4*)(h16in + (size_t)rr[q] * D) + lane;
#pragma unroll
                for (int j = 0; j < 4; ++j) { const u32x4 hh = src16[64 * j];
                    v[q][8 * j + 0] = h_lo(hh.x); v[q][8 * j + 1] = h_hi(hh.x); v[q][8 * j + 2] = h_lo(hh.y); v[q][8 * j + 3] = h_hi(hh.y);
                    v[q][8 * j + 4] = h_lo(hh.z); v[q][8 * j + 5] = h_hi(hh.z); v[q][8 * j + 6] = h_lo(hh.w); v[q][8 * j + 7] = h_hi(hh.w); }
            }
            float a1 = 0.f, a2 = 0.f;
#pragma unroll
            for (int j = 0; j < 4; ++j) { const unsigned yw[4] = {yv[j].x, yv[j].y, yv[j].z, yv[j].w};
#pragma unroll
                for (int e = 0; e < 4; ++e) { const float u0 = v[q][8 * j + 2 * e] * DN_ALPHA + bf_lo(yw[e]), u1 = v[q][8 * j + 2 * e + 1] * DN_ALPHA + bf_hi(yw[e]);
                    v[q][8 * j + 2 * e] = u0; v[q][8 * j + 2 * e + 1] = u1; a1 += u0 + u1; a2 += u0 * u0 + u1 * u1; } }
            s1[q] = a1; s2[q] = a2;
        }
#pragma unroll
        for (int o = 1; o < 64; o <<= 1)
#pragma unroll
            for (int q = 0; q < R; ++q) { s1[q] += shflx(s1[q], o, lane); s2[q] += shflx(s2[q], o, lane); }
        float mean[R], rstd[R];
#pragma unroll
        for (int q = 0; q < R; ++q) { mean[q] = s1[q] * (1.f / D); const float var = fmaxf(s2[q] * (1.f / D) - mean[q] * mean[q], 0.f); rstd[q] = 1.0f / sqrtf(var + LN_EPS); }
#pragma unroll
        for (int j = 0; j < 4; ++j) {
            const f32x4 g0 = ((const f32x4*)g)[128 * j + 2 * lane], g1 = ((const f32x4*)g)[128 * j + 2 * lane + 1], b0 = ((const f32x4*)b)[128 * j + 2 * lane], b1 = ((const f32x4*)b)[128 * j + 2 * lane + 1];
            const float gg[8] = {g0[0], g0[1], g0[2], g0[3], g1[0], g1[1], g1[2], g1[3]}, bb[8] = {b0[0], b0[1], b0[2], b0[3], b1[0], b1[1], b1[2], b1[3]};
#pragma unroll
            for (int q = 0; q < R; ++q) { if (!ok[q]) continue;
                float y[8];
#pragma unroll
                for (int e = 0; e < 8; ++e) y[e] = (v[q][8 * j + e] - mean[q]) * rstd[q] * gg[e] + bb[e];
                if (last) { f32x4* o = (f32x4*)(p.out + (size_t)rr[q] * D) + 128 * j + 2 * lane; o[0] = (f32x4){y[0], y[1], y[2], y[3]}; o[1] = (f32x4){y[4], y[5], y[6], y[7]}; }
                else { u32x4 hw; hw.x = pkh2(y[0], y[1]); hw.y = pkh2(y[2], y[3]); hw.z = pkh2(y[4], y[5]); hw.w = pkh2(y[6], y[7]);
                       ((u32x4*)(h16out + (size_t)rr[q] * D) + lane)[64 * j] = hw;
                       u32x4 w; w.x = pk2(y[0], y[1]); w.y = pk2(y[2], y[3]); w.z = pk2(y[4], y[5]); w.w = pk2(y[6], y[7]);
                       ((u32x4*)(hb + (size_t)rr[q] * D) + lane)[64 * j] = w; } }
        }
    }
}

#define MFMA32(a, b, c) __builtin_amdgcn_mfma_f32_32x32x16_bf16((a), (b), (c), 0, 0, 0)
DI float silu_mul(float o, float g) { return o * g * __builtin_amdgcn_rcpf(1.0f + __builtin_amdgcn_exp2f(g * -1.4426950408889634f)); }

typedef short s16x4 __attribute__((ext_vector_type(4)));
DI bf16x8 tr_frag(const LAS bf16_t* lo, const LAS bf16_t* hi) {
    const s16x4 a = __builtin_amdgcn_ds_read_tr16_b64_v4i16((LAS s16x4*)lo), b = __builtin_amdgcn_ds_read_tr16_b64_v4i16((LAS s16x4*)hi);
    return __builtin_shufflevector(a, b, 0, 1, 2, 3, 4, 5, 6, 7);
}
constexpr int PB = 160, PA = 96;
constexpr int VS_BYTES = 32 * PB * 2;

template <bool MASKED>
DI void attnB_tile_math(const f32x16& S, int kpos0, int kvalid, int qpos, int h, int lane, float& later, unsigned (&pw)[8]) {
    const float scale2 = 0.08838834764831845f * 1.4426950408889634f;
    float x2[16], sp[16];
#pragma unroll
    for (int r = 0; r < 16; ++r) {
        const float x = S[r] * scale2; x2[r] = x;
        const float e = __builtin_amdgcn_exp2f(-fabsf(x));
        const float v = fmaxf(x, 0.f) + __builtin_amdgcn_logf(1.0f + e);
        if (MASKED) { const int row = (r & 3) + 8 * (r >> 2) + 4 * h; const bool vis = (row < kvalid) && (kpos0 + row < qpos); sp[r] = vis ? v : 0.f; }
        else sp[r] = v;
    }
    float G[4], P[4];
#pragma unroll
    for (int g = 0; g < 4; ++g) { G[g] = (sp[4 * g] + sp[4 * g + 1]) + (sp[4 * g + 2] + sp[4 * g + 3]); P[g] = shflx(G[g], 32, lane); }
    float R[4]; R[3] = 0.f; R[2] = G[3] + P[3]; R[1] = R[2] + (G[2] + P[2]); R[0] = R[1] + (G[1] + P[1]);
    const float total = R[0] + (G[0] + P[0]);
#pragma unroll
    for (int g = 0; g < 4; ++g) {
        float sfx = later + R[g] + (h == 0 ? P[g] : 0.f); float wv[4];
#pragma unroll
        for (int i = 3; i >= 0; --i) {
            const int r = 4 * g + i;
            sfx += sp[r];
            float t = __builtin_amdgcn_exp2f(x2[r] - sfx);
            if (MASKED) { const int row = (r & 3) + 8 * (r >> 2) + 4 * h; const bool vis = (row < kvalid) && (kpos0 + row < qpos); t = vis ? t : 0.f; }
            wv[i] = t;
        }
        pw[2 * g] = pk2(wv[0], wv[1]); pw[2 * g + 1] = pk2(wv[2], wv[3]);
    }
    later += total;
}

DI void attnB_item(bf16_t* z, int hh, int qs, LAS bf16_t* vs, int lane) {
    const int c = lane & 31, h = lane >> 5;
    const bool metaq = qs < 0;
    const int qrow = metaq ? SEQ + c : 32 * qs + c;
    const int qpos = metaq ? (c < NMETA ? c : 0) : NMETA + 32 * qs + c;
    const int trb = (4 * h + ((lane & 15) >> 2)) * PB + 16 * ((lane >> 4) & 1) + 4 * (lane & 3);
    const int qrow0 = metaq ? SEQ : 32 * qs;
    LAS bf16x8* qs_lds = (LAS bf16x8*)(vs + 32 * PB) + lane;
    { const bf16_t* qp = z + zrowU(qrow0, 32) + zlaneRC(c, hh * 128 + 8 * h);
      bf16x8 qf[8];
#pragma unroll
      for (int s = 0; s < 8; ++s) qf[s] = *(const bf16x8*)(qp + (((s >> 1) << 9) | ((s & 1) << 8)));
      asm volatile("s_waitcnt lgkmcnt(0)" ::: "memory");
#pragma unroll
      for (int s = 0; s < 8; ++s) qs_lds[64 * s] = qf[s]; }
    f32x16 acc[4];
#pragma unroll
    for (int dt = 0; dt < 4; ++dt)
#pragma unroll
        for (int i = 0; i < 16; ++i) acc[dt][i] = 0.f;
    float later = 0.f;
    int t = metaq ? -1 : qs;
    const int tfirst = t;
    const bf16_t* kbase = z + zlaneRC(c, 2048 + hh * 128 + 8 * h);
    const bf16_t* vbase = z + zlaneRC(lane & 15, 4096 + hh * 128 + 8 * (lane >> 4));
    bf16x8 kf[8]; u32x4 vv[8];
    { const size_t ro = zrowU(t < 0 ? SEQ : 32 * t, 32);
#pragma unroll
      for (int s = 0; s < 8; ++s) kf[s] = *(const bf16x8*)(kbase + ro + (((s >> 1) << 9) | ((s & 1) << 8)));
#pragma unroll
      for (int i = 0; i < 8; ++i) vv[i] = *(const u32x4*)(vbase + ro + (((i >> 2) << 13) | ((i & 3) << 9))); }
    for (;;) {
        const int kpos0 = t < 0 ? 0 : NMETA + 32 * t, kvalid = t < 0 ? NMETA : 32;
        const int tn = t <= 0 ? -1 : t - 1;
        const size_t ron = zrowU(tn < 0 ? SEQ : 32 * tn, 32);
        f32x16 S; bf16x8 qf[8];
#pragma unroll
        for (int i = 0; i < 16; ++i) S[i] = 0.f;
#pragma unroll
        for (int s = 0; s < 8; ++s) qf[s] = qs_lds[64 * s];
        asm volatile("s_waitcnt lgkmcnt(0)" ::: "memory"); __builtin_amdgcn_sched_barrier(0);
#pragma unroll
        for (int s = 0; s < 8; ++s) S = MFMA32(kf[s], qf[s], S);
#pragma unroll
        for (int s = 0; s < 8; ++s) kf[s] = *(const bf16x8*)(kbase + ron + (((s >> 1) << 9) | ((s & 1) << 8)));
        unsigned pw[8];
        if (t == tfirst || t < 0) attnB_tile_math<true>(S, kpos0, kvalid, qpos, h, lane, later, pw); else attnB_tile_math<false>(S, kpos0, kvalid, qpos, h, lane, later, pw);
        asm volatile("s_waitcnt lgkmcnt(0)" ::: "memory");
#pragma unroll
        for (int i = 0; i < 8; ++i) *(LAS u32x4*)(vs + (16 * (i >> 2) + (lane & 15)) * PB + 32 * (i & 3) + 8 * (lane >> 4)) = vv[i];
#pragma unroll
        for (int i = 0; i < 8; ++i) vv[i] = *(const u32x4*)(vbase + ron + (((i >> 2) << 13) | ((i & 3) << 9)));
        asm volatile("s_waitcnt lgkmcnt(0)" ::: "memory");
        bf16x8 af[2][4];
#pragma unroll
        for (int s = 0; s < 2; ++s)
#pragma unroll
            for (int dt = 0; dt < 4; ++dt) { const LAS bf16_t* lo = vs + trb + 16 * s * PB + 32 * dt; af[s][dt] = tr_frag(lo, lo + 8 * PB); }
        asm volatile("s_waitcnt lgkmcnt(0)" ::: "memory"); __builtin_amdgcn_sched_barrier(0);
#pragma unroll
        for (int s = 0; s < 2; ++s) {
            const u32x4 pwv = {pw[4 * s], pw[4 * s + 1], pw[4 * s + 2], pw[4 * s + 3]};
            const bf16x8 bfrag = __builtin_bit_cast(bf16x8, pwv);
#pragma unroll
            for (int dt = 0; dt < 4; ++dt) acc[dt] = MFMA32(af[s][dt], bfrag, acc[dt]);
        }
        if (t < 0) break;
        if (__all(later > 150.1f)) break;
        t = tn;
    }
    if (!metaq || c < NMETA) {
        bf16_t* orow = z + zrowU(qrow0, 32) + zlaneRC(c, hh * 128 + 4 * h);
        const bf16_t* grow = z + zrowU(qrow0, 32) + zlaneRC(c, 6144 + hh * 128 + 4 * h);
#pragma unroll
        for (int dt = 0; dt < 4; ++dt)
#pragma unroll
            for (int g = 0; g < 4; ++g) {
                const int d0 = (dt << 9) | (g << 7);
                const u32x2 gv = *(const u32x2*)(grow + d0);
                u32x2 o; o.x = pk2(silu_mul(acc[dt][4 * g], bf_lo(gv.x)), silu_mul(acc[dt][4 * g + 1], bf_hi(gv.x)));
                o.y = pk2(silu_mul(acc[dt][4 * g + 2], bf_lo(gv.y)), silu_mul(acc[dt][4 * g + 3], bf_hi(gv.y)));
                *(u32x2*)(orow + d0) = o;
            }
    }
}

template <bool MASKED>
DI void attnA_tile_math(const f32x16& Su, const LAS float* bt, int qpos, int kpos0, int kvalid, bool meta_tile, int h, int lane, float& m, float& l, float& corr, bf16x8 (&bfrag)[2]) {
    float sc[16]; float tmax = -1e30f;
#pragma unroll
    for (int r = 0; r < 16; ++r) {
        const int row = (r & 3) + 8 * (r >> 2) + 4 * h;
        const int dist = qpos - (kpos0 + row);
        if (MASKED) {
            const bool vis = (row < kvalid) && (dist >= 0) && (meta_tile || dist < 128);
            const int di = dist < 0 ? 0 : (dist > 128 ? 128 : dist);
            const float v = Su[r] * (0.125f * 1.4426950408889634f) + bt[di];
            sc[r] = vis ? v : -1e30f;
        } else sc[r] = Su[r] * (0.125f * 1.4426950408889634f) + bt[dist];
        tmax = fmaxf(tmax, sc[r]);
    }
    tmax = fmaxf(tmax, shflx(tmax, 32, lane));
    const float mnew = fmaxf(m, tmax);
    corr = __builtin_amdgcn_exp2f(m - mnew);
    float pr[16]; float psum = 0.f;
#pragma unroll
    for (int r = 0; r < 16; ++r) { pr[r] = __builtin_amdgcn_exp2f(sc[r] - mnew); psum += pr[r]; }
    psum += shflx(psum, 32, lane);
    l = l * corr + psum; m = mnew;
#pragma unroll
    for (int s = 0; s < 2; ++s) {
        u32x4 pw; pw.x = pk2(pr[8 * s], pr[8 * s + 1]); pw.y = pk2(pr[8 * s + 2], pr[8 * s + 3]); pw.z = pk2(pr[8 * s + 4], pr[8 * s + 5]); pw.w = pk2(pr[8 * s + 6], pr[8 * s + 7]);
        bfrag[s] = __builtin_bit_cast(bf16x8, pw);
    }
}

DI void attnA_item(bf16_t* z, const float* sinks, int hp, int qs, LAS bf16_t* vs, const LAS float* btab, int lane) {
    const int c = lane & 31, h = lane >> 5, kvh = hp >> 2;
    const bool metaq = qs < 0;
    const int qrow = metaq ? SEQ + c : 32 * qs + c;
    const int qpos = metaq ? (c < NMETA ? c : 0) : NMETA + 32 * qs + c;
    const int trb = (4 * h + ((lane & 15) >> 2)) * PA + 16 * ((lane >> 4) & 1) + 4 * (lane & 3);
    const int qrow0 = metaq ? SEQ : 32 * qs;
    LAS bf16x8* qs_lds = (LAS bf16x8*)(vs + 32 * PA) + lane;
    { bf16x8 qf[2][4];
#pragma unroll
      for (int u = 0; u < 2; ++u) { const bf16_t* qp = z + zrowU(qrow0, 18) + zlaneRC(c, (2 * hp + u) * 64 + 8 * h);
#pragma unroll
        for (int s = 0; s < 4; ++s) qf[u][s] = *(const bf16x8*)(qp + (((s >> 1) << 9) | ((s & 1) << 8))); }
      asm volatile("s_waitcnt lgkmcnt(0)" ::: "memory");
#pragma unroll
      for (int u = 0; u < 2; ++u)
#pragma unroll
        for (int s = 0; s < 4; ++s) qs_lds[64 * (4 * u + s)] = qf[u][s]; }
    f32x16 acc[2][2];
#pragma unroll
    for (int u = 0; u < 2; ++u)
#pragma unroll
        for (int dt = 0; dt < 2; ++dt)
#pragma unroll
            for (int i = 0; i < 16; ++i) acc[u][dt][i] = 0.f;
    float m[2] = {sinks[2 * hp] * 1.4426950408889634f, sinks[2 * hp + 1] * 1.4426950408889634f}, l[2] = {1.0f, 1.0f};
    const int tlo = metaq ? 0 : (qs - 4 > 0 ? qs - 4 : 0), thi = metaq ? -1 : qs;
    const bf16_t* kbase = z + zlaneRC(c, 2048 + kvh * 64 + 8 * h);
    const bf16_t* vbase = z + zlaneRC(lane & 15, 2304 + kvh * 64 + 8 * (lane >> 4));
    bf16x8 kf[4]; u32x4 vv[4];
    int t = -1;
    { const size_t ro = zrowU(SEQ, 18);
#pragma unroll
      for (int s = 0; s < 4; ++s) kf[s] = *(const bf16x8*)(kbase + ro + (((s >> 1) << 9) | ((s & 1) << 8)));
#pragma unroll
      for (int i = 0; i < 4; ++i) vv[i] = *(const u32x4*)(vbase + ro + (((i >> 1) << 13) | ((i & 1) << 9))); }
    for (;;) {
        const int kpos0 = t < 0 ? 0 : NMETA + 32 * t, kvalid = t < 0 ? NMETA : 32;
        const bool lastt = metaq || t == thi;
        const bool interior = !metaq && t >= 0 && t > qs - 4 && t < qs;
        const int tn = lastt ? t : (t < 0 ? tlo : t + 1);
        const size_t ron = zrowU(tn < 0 ? SEQ : 32 * tn, 18);
        bf16x8 bfrag[2][2];
#pragma unroll
        for (int u = 0; u < 2; ++u) {
            f32x16 Su; bf16x8 qf[4];
#pragma unroll
            for (int i = 0; i < 16; ++i) Su[i] = 0.f;
#pragma unroll
            for (int s = 0; s < 4; ++s) qf[s] = qs_lds[64 * (4 * u + s)];
            asm volatile("s_waitcnt lgkmcnt(0)" ::: "memory"); __builtin_amdgcn_sched_barrier(0);
#pragma unroll
            for (int s = 0; s < 4; ++s) Su = MFMA32(kf[s], qf[s], Su);
            if (u == 1) {
#pragma unroll
                for (int s = 0; s < 4; ++s) kf[s] = *(const bf16x8*)(kbase + ron + (((s >> 1) << 9) | ((s & 1) << 8)));
            }
            const LAS float* bt = btab + (2 * hp + u) * 129;
            float corr;
            if (interior) attnA_tile_math<false>(Su, bt, qpos, kpos0, kvalid, t < 0, h, lane, m[u], l[u], corr, bfrag[u]);
            else attnA_tile_math<true>(Su, bt, qpos, kpos0, kvalid, t < 0, h, lane, m[u], l[u], corr, bfrag[u]);
#pragma unroll
            for (int dt = 0; dt < 2; ++dt)
#pragma unroll
                for (int i = 0; i < 16; ++i) acc[u][dt][i] *= corr;
        }
        asm volatile("s_waitcnt lgkmcnt(0)" ::: "memory");
#pragma unroll
        for (int i = 0; i < 4; ++i) *(LAS u32x4*)(vs + (16 * (i >> 1) + (lane & 15)) * PA + 32 * (i & 1) + 8 * (lane >> 4)) = vv[i];
#pragma unroll
        for (int i = 0; i < 4; ++i) vv[i] = *(const u32x4*)(vbase + ron + (((i >> 1) << 13) | ((i & 1) << 9)));
        asm volatile("s_waitcnt lgkmcnt(0)" ::: "memory");
        bf16x8 af[2][2];
#pragma unroll
        for (int s = 0; s < 2; ++s)
#pragma unroll
            for (int dt = 0; dt < 2; ++dt) { const LAS bf16_t* lo = vs + trb + 16 * s * PA + 32 * dt; af[s][dt] = tr_frag(lo, lo + 8 * PA); }
        asm volatile("s_waitcnt lgkmcnt(0)" ::: "memory"); __builtin_amdgcn_sched_barrier(0);
#pragma unroll
        for (int s = 0; s < 2; ++s)
#pragma unroll
            for (int dt = 0; dt < 2; ++dt) {
                acc[0][dt] = MFMA32(af[s][dt], bfrag[0][s], acc[0][dt]);
                acc[1][dt] = MFMA32(af[s][dt], bfrag[1][s], acc[1][dt]);
            }
        if (lastt) break;
        t = tn;
    }
    if (!metaq || c < NMETA) {
#pragma unroll
        for (int u = 0; u < 2; ++u) {
            const float inv = 1.0f / l[u];
            bf16_t* orow = z + zrowU(qrow0, 18) + zlaneRC(c, (2 * hp + u) * 64 + 4 * h);
            const bf16_t* grow = z + zrowU(qrow0, 18) + zlaneRC(c, 2560 + (2 * hp + u) * 64 + 4 * h);
#pragma unroll
            for (int dt = 0; dt < 2; ++dt)
#pragma unroll
                for (int g = 0; g < 4; ++g) {
                    const int d0 = (dt << 9) | (g << 7);
                    const u32x2 gv = *(const u32x2*)(grow + d0);
                    u32x2 o; o.x = pk2(silu_mul(acc[u][dt][4 * g] * inv, bf_lo(gv.x)), silu_mul(acc[u][dt][4 * g + 1] * inv, bf_hi(gv.x)));
                    o.y = pk2(silu_mul(acc[u][dt][4 * g + 2] * inv, bf_lo(gv.y)), silu_mul(acc[u][dt][4 * g + 3] * inv, bf_hi(gv.y)));
                    *(u32x2*)(orow + d0) = o;
                }
        }
    }
}

constexpr int NQS = SEQ / 32;

struct AttnQueue { unsigned* heads; int x; int cur; };
DI bool attn_next(AttnQueue& q, int lane0, int& qs, int& hd) {
    for (;;) {
        if (q.cur >= 8) return false;
        const int xq = (q.x + q.cur) & 7;
        const int nqs = NQS / 8 + (xq == 7 ? 1 : 0);
        unsigned n = 0;
        if (lane0) n = __hip_atomic_fetch_add(q.heads + 64 * xq, 1u, __ATOMIC_RELAXED, __HIP_MEMORY_SCOPE_AGENT);
        n = (unsigned)__builtin_amdgcn_readfirstlane((int)n);
        if (n < (unsigned)(nqs * 16)) { qs = (NQS / 8) * xq + (int)(n >> 4); hd = (int)(n & 15u); return true; }
        ++q.cur;
    }
}


__global__ void __launch_bounds__(NTHREADS) hybrid_fwd(Params p) {
    extern __shared__ __attribute__((aligned(16))) unsigned char lds_raw[];
    LAS unsigned char* lds = (LAS unsigned char*)lds_raw;
    cg::grid_group grid = cg::this_grid();
    bf16_t* hb = (bf16_t*)(p.ws + WS_HB);
    bf16_t* z = (bf16_t*)(p.ws + WS_Z);
    unsigned* barw = (unsigned*)(p.ws + WS_BAR);
    volatile LAS unsigned* bst = (volatile LAS unsigned*)(lds + LDS_MAIN);
    {
        const int tid = threadIdx.x, lane = tid & 63, wave = __builtin_amdgcn_readfirstlane(tid >> 6);
        const int G = gridDim.x, gw = blockIdx.x * NWAVES + wave, NGW = G * NWAVES;
        if (tid < 2) bst[tid] = 0u;
        if (blockIdx.x == 0) { for (int i = tid; i < XCD_BAR_WORDS; i += NTHREADS) barw[i] = 0u; for (int i = tid; i < 4 * 8 * 64; i += NTHREADS) ((unsigned*)(p.ws + WS_Q))[i] = 0u; }
        phase_p0(p, lds, gw, NGW, wave, lane);
    }
    grid.sync();
    const int wave_s = __builtin_amdgcn_readfirstlane(threadIdx.x >> 6);
    const XcdBarrier xb = xcd_barrier_post(barw, bst);
#define GSYNC() xcd_barrier(xb, wave_s)

#define PHASE_IDS() int lane = lane_id_fresh(); int wave = wave_s; asm volatile("" : "+s"(wave)); \
        int bid = blockIdx.x; asm volatile("" : "+s"(bid)); int G = gridDim.x; asm volatile("" : "+s"(G)); \
        const int tid = wave * 64 + lane, gw = bid * NWAVES + wave, NGW = G * NWAVES; (void)tid; (void)gw; (void)NGW
#pragma unroll 1
    for (int layer = 0; layer < DEPTH; ++layer) {
        const int j = layer >> 1;
        const bool isA = (layer & 1) == 0;
        {
            PHASE_IDS();
            const int N = isA ? NA : NB;
            const bf16_t* wt = isA ? (const bf16_t*)(p.ws + WS_W + j * WPAIR + WO_INA) : (const bf16_t*)(p.ws + WS_W + j * WPAIR + WO_INB);
            pg8::StaticOrder S; S.init(SEQ, N, G, bid);
            pg8::Gemm g{hb, wt, SEQ, N, D, D, 0};
            pg8::EpiBf16 E{z, 0, N / 256}; pg8::gemm_phase<pg8::EpiBf16>(lds, g, S, E, tid);
            meta_gemm<false>(hb + (size_t)SEQ * D, D, wt, N, z, 0, N / 256, lds, bid, G, wave, lane);
        }
        GSYNC();
        if (isA) {
            PHASE_IDS();
            LAS float* btab = (LAS float*)(lds + 8 * 14336);
            for (int idx = tid; idx < 32 * 129; idx += NTHREADS) {
                const int hd = idx / 129, d = idx % 129;
                int bucket = d;
                if (d >= 16) { bucket = 16 + (int)(logf((float)d * (1.0f / 16.0f)) / 2.0794415416798357f * 16.0f); bucket = bucket > 31 ? 31 : bucket; }
                btab[idx] = p.rel_bias[bucket * 32 + hd] * 1.4426950408889634f;
            }
            __syncthreads();
            LAS bf16_t* vs = (LAS bf16_t*)(lds + wave * 14336);
            const float* sinks = p.sinks_a + j * 32;
            AttnQueue aq{(unsigned*)(p.ws + WS_Q) + layer * 8 * 64, (int)(xb.x & 7u), 0}; int qs, hd;
            while (attn_next(aq, lane_id_fresh() == 0, qs, hd)) attnA_item(z, sinks, hd, qs == NQS ? -1 : qs, vs, btab, lane_id_fresh());
        } else {
            PHASE_IDS();
            LAS bf16_t* vs = (LAS bf16_t*)(lds + wave * (VS_BYTES + 8192));
            AttnQueue aq{(unsigned*)(p.ws + WS_Q) + layer * 8 * 64, (int)(xb.x & 7u), 0}; int qs, hd;
            while (attn_next(aq, lane_id_fresh() == 0, qs, hd)) attnB_item(z, hd, qs == NQS ? -1 : qs, vs, lane_id_fresh());
        }
        GSYNC();
        {
            PHASE_IDS();
            const int znt = isA ? NA / 256 : NB / 256;
            pg8::StaticOrder S; S.init(SEQ, D, G, bid);
            const bf16_t* wt = isA ? (const bf16_t*)(p.ws + WS_W + j * WPAIR + WO_OUTA) : (const bf16_t*)(p.ws + WS_W + j * WPAIR + WO_OUTB);
            pg8::Gemm g{z, wt, SEQ, D, D, 0, znt};
            pg8::EpiBf16 E{hb, D, 0}; pg8::gemm_phase<pg8::EpiBf16>(lds, g, S, E, tid);
            if (layer != DEPTH - 1) meta_gemm<true>(z, 0, wt, D, hb, D, znt, lds, bid, G, wave, lane);
        }
        GSYNC();
        {
            PHASE_IDS();
            phase_ln(p, layer, gw, NGW, lane);
        }
        if (layer != DEPTH - 1) GSYNC();
    }
}

extern "C" void kernel_launch(void* const* d_in, const int* in_sizes, int n_in, void* d_out, int out_size, void* d_ws, size_t ws_size, hipStream_t stream) {
    static int grid = 0;
    if (grid == 0) {
        if (n_in != 10 || out_size != SEQ * D || ws_size < WS_END) { fprintf(stderr, "kernel_launch: unexpected shapes (n_in %d out %d ws %zu, need %zu)\n", n_in, out_size, ws_size, (size_t)WS_END); grid = -1; return; }
        int dev = 0, cus = 0, per_cu = 0;
        hipGetDevice(&dev);
        hipDeviceGetAttribute(&cus, hipDeviceAttributeMultiprocessorCount, dev);
        if (hipFuncSetAttribute((const void*)hybrid_fwd, hipFuncAttributeMaxDynamicSharedMemorySize, LDS_BYTES) != hipSuccess) { fprintf(stderr, "kernel_launch: hipFuncSetAttribute failed\n"); grid = -1; return; }
        if (hipOccupancyMaxActiveBlocksPerMultiprocessor(&per_cu, (const void*)hybrid_fwd, NTHREADS, LDS_BYTES) != hipSuccess || per_cu < 1) { fprintf(stderr, "kernel_launch: occupancy query failed (%d)\n", per_cu); (void)hipGetLastError(); per_cu = 1; }
        grid = cus * 1;
    }
    if (grid < 0) return;
    Params p{};
    p.x = (const float*)d_in[0]; p.meta = (const float*)d_in[1]; p.rel_bias = (const float*)d_in[2]; p.w_in_a = (const float*)d_in[3]; p.sinks_a = (const float*)d_in[4];
    p.w_out_a = (const float*)d_in[5]; p.w_in_b = (const float*)d_in[6]; p.w_out_b = (const float*)d_in[7]; p.ln_g = (const float*)d_in[8]; p.ln_b = (const float*)d_in[9];
    p.out = (float*)d_out; p.ws = (unsigned char*)d_ws; p.probe = 1;
    void* args[] = {&p};
    hipError_t e = hipLaunchCooperativeKernel((const void*)hybrid_fwd, dim3(grid), dim3(NTHREADS), args, LDS_BYTES, stream);
    if (e != hipSuccess) fprintf(stderr, "kernel_launch: cooperative launch failed: %s (grid %d)\n", hipGetErrorString(e), grid);
}
```

```cpp
#include <hip/hip_runtime.h>
#include <hip/hip_cooperative_groups.h>
#include <cstdio>
namespace cg = cooperative_groups;

#define LAS __attribute__((address_space(3)))
#define DI __device__ __forceinline__
typedef unsigned short bf16_t;
typedef short bf16x8 __attribute__((ext_vector_type(8)));
typedef float f32x2 __attribute__((ext_vector_type(2)));
typedef float f32x4 __attribute__((ext_vector_type(4)));
typedef float f32x16 __attribute__((ext_vector_type(16)));
typedef unsigned u32x2 __attribute__((ext_vector_type(2)));
typedef unsigned u32x4 __attribute__((ext_vector_type(4)));
typedef __bf16 bf16v2 __attribute__((ext_vector_type(2)));

constexpr int D = 2048, SEQ = 16384, NMETA = 16, LTOK = SEQ + NMETA, MPAD = SEQ + 256;
constexpr int NA = 4608, NB = 8192, DEPTH = 4;
constexpr int NTHREADS = 512, NWAVES = 8;
constexpr int LDS_MAIN = 147456, LDS_BYTES = LDS_MAIN + 16;
constexpr float LN_EPS = 1e-5f;
constexpr float DN_ALPHA = 1.6817928305074290f;

constexpr size_t WS_W = 0;
constexpr size_t WPAIR = (size_t)(NA + D + NB + D) * D * 2;
constexpr size_t WO_INA = 0, WO_OUTA = (size_t)NA * D * 2, WO_INB = WO_OUTA + (size_t)D * D * 2, WO_OUTB = WO_INB + (size_t)NB * D * 2;
constexpr size_t WS_HB = WS_W + 2 * WPAIR;
constexpr size_t WS_Z = WS_HB + (size_t)MPAD * D * 2;
constexpr size_t WS_BAR = WS_Z + (size_t)MPAD * NB * 2;
static_assert((size_t)LTOK * D * 2 <= WPAIR, "the fp16 residual stream must fit in the first layer pair's weight region");
constexpr size_t WS_Q = WS_BAR + 16384;
constexpr size_t WS_END = WS_Q + 4 * 8 * 256;

DI unsigned pk2(float a, float b) { f32x2 v = {a, b}; bf16v2 r = __builtin_convertvector(v, bf16v2); return __builtin_bit_cast(unsigned, r); }
typedef _Float16 h16v2 __attribute__((ext_vector_type(2)));
DI unsigned pkh2(float a, float b) { f32x2 v = {a, b}; h16v2 r = __builtin_convertvector(v, h16v2); return __builtin_bit_cast(unsigned, r); }
DI float h_lo(unsigned u) { return (float)__builtin_bit_cast(h16v2, u)[0]; }
DI float h_hi(unsigned u) { return (float)__builtin_bit_cast(h16v2, u)[1]; }
DI float bf_lo(unsigned u) { return __uint_as_float(u << 16); }
DI float bf_hi(unsigned u) { return __uint_as_float(u & 0xffff0000u); }
DI float shflx(float v, int mask, int lane) { return __int_as_float(__builtin_amdgcn_ds_bpermute((lane ^ mask) << 2, __float_as_int(v))); }
DI int lane_id_fresh() { unsigned zero; asm volatile("v_mov_b32 %0, 0" : "=v"(zero)); return (int)__builtin_amdgcn_mbcnt_hi(~0u, __builtin_amdgcn_mbcnt_lo(~0u, zero)); }
DI float wave_sum(float v, int lane) {
#pragma unroll
    for (int o = 1; o < 64; o <<= 1) v += shflx(v, o, lane);
    return v;
}


DI size_t zrowU(int row0, int NT) { return ((size_t)((row0 >> 8) * NT) << 16) + (size_t)((((row0 >> 7) & 1) << 15) | (((row0 >> 5) & 1) << 14) | (((row0 >> 6) & 1) << 11)); }
DI unsigned zlaneRC(int r5, int col) { return (unsigned)(((col >> 8) << 16) | ((r5 >> 4) << 13) | (((col >> 7) & 1) << 12) | (((col >> 5) & 3) << 9) | (((col >> 3) & 3) << 7) | ((r5 & 15) << 3) | (col & 7)); }

namespace pg8 {
constexpr int BM = 256, BK = 64, HALF = 128, HTB = HALF * BK * 2, NXCD = 8, WGM = 8;
DI int lds_byte(int r, int c) { const int st = (r >> 4) * 2 + (c >> 5), rr = r & 15, cc = c & 31, ob = rr * 64 + cc * 2; return st * 1024 + (ob ^ (((ob >> 9) & 1) << 5)); }
DI void stage_rc(int b, int& R, int& C) { const int st = b / 1024, sb = b % 1024, swz = sb ^ (((sb >> 9) & 1) << 5); R = (st >> 1) * 16 + swz / 64; C = (st & 1) * 32 + (swz % 64) / 2; }
DI int perm32(int rho) { const int n = rho >> 4, i = rho & 15; return 8 * (i >> 2) + 4 * n + (i & 3); }

struct Unit { int pm, pn; };
struct Gemm { const bf16_t* A; const bf16_t* Bt; int M, N, K, lda; int ant; };

struct StaticOrder {
    int nM, nN, nwg, G, c;
    DI void init(int M, int N, int G_, int c_) { nM = M / BM; nN = N / BM; nwg = nM * nN; G = G_; c = c_; }
    DI bool next(int i, Unit& u) const {
        const long L = (long)i * G + c; if (L >= nwg) return false;
        int wgid = (int)L; { const int q = nwg / NXCD, r = nwg % NXCD, xcd = wgid % NXCD, off = wgid / NXCD; wgid = (xcd < r ? xcd * (q + 1) : r * (q + 1) + (xcd - r) * q) + off; }
        const int nig = WGM * nN, gid = wgid / nig, fm = gid * WGM, gsz = (nM - fm) < WGM ? (nM - fm) : WGM;
        u.pm = fm + ((wgid % nig) % gsz); u.pn = (wgid % nig) / gsz; return true;
    }
};

struct EpiBf16 {
    static constexpr bool PERM = true;
    bf16_t* O; int ldc; int nt;
    DI void operator()(const f32x4 (&acc)[2][2][4][2], const Unit& u, int wr, int wc, int fr, int fq) const {
        if (nt) {
            unsigned char* tb = (unsigned char*)O + ((size_t)(u.pm * nt + u.pn) << 17) + (wr * 4 + wc) * 1024 + (fq * 16 + fr) * 16;
#pragma unroll
            for (int ai = 0; ai < 2; ++ai)
#pragma unroll
                for (int m = 0; m < 4; ++m)
#pragma unroll
                    for (int bj = 0; bj < 2; ++bj) { const f32x4 v0 = acc[ai][bj][m][0], v1 = acc[ai][bj][m][1];
                        u32x4 w; w.x = pk2(v0[0], v0[1]); w.y = pk2(v0[2], v0[3]); w.z = pk2(v1[0], v1[1]); w.w = pk2(v1[2], v1[3]);
                        *(u32x4*)(tb + ((ai * 4 + m) * 2 + bj) * 8192) = w; }
            return;
        }
        const int row0 = u.pm * BM + wr * 64 + fr; const int col0 = u.pn * BM + wc * 32 + 8 * fq;
#pragma unroll
        for (int ai = 0; ai < 2; ++ai)
#pragma unroll
            for (int m = 0; m < 4; ++m) { bf16_t* rowp = O + (size_t)(row0 + ai * HALF + m * 16) * ldc + col0;
#pragma unroll
                for (int bj = 0; bj < 2; ++bj) { const f32x4 v0 = acc[ai][bj][m][0], v1 = acc[ai][bj][m][1];
                    u32x4 w; w.x = pk2(v0[0], v0[1]); w.y = pk2(v0[2], v0[3]); w.z = pk2(v1[0], v1[1]); w.w = pk2(v1[2], v1[3]);
                    *(u32x4*)(rowp + bj * HALF) = w; } }
    }
};

template <class Epi>
DI void gemm_phase(LAS unsigned char* lds, const Gemm g, const StaticOrder& S, const Epi& E, const int tid) {
    const int wid = __builtin_amdgcn_readfirstlane(tid >> 6), lane = tid & 63, wr = wid >> 2, wc = wid & 3, fr = lane & 15, fq = lane >> 4;
    const int K = g.K, nt = K / BK, lda = g.lda;
    unsigned voffA[2], voffB[2];
#pragma unroll
    for (int i = 0; i < 2; ++i) { int R, C; stage_rc(tid * 16 + i * 8192, R, C); const int Rb = Epi::PERM ? ((R & ~31) + perm32(R & 31)) : R;
        voffA[i] = g.ant ? (unsigned)((((R >> 4) & 3) << 14) | (((R >> 6) & 1) << 12) | (((C >> 5) & 1) << 10) | (((C >> 3) & 3) << 8) | ((R & 15) << 4)) : (unsigned)(R * lda + C) * 2u;
        voffB[i] = (unsigned)(Rb * K + C) * 2u; }
    const size_t kstep = (size_t)(BK * 2);
    const size_t hstepA = g.ant ? (size_t)65536 : (size_t)HALF * lda * 2, hstepB = (size_t)HALF * K * 2;
    const size_t tstepA = g.ant ? (size_t)g.ant * 131072 : 2 * hstepA, tstepB = 2 * hstepB;
#define PG8_KTA(t) (g.ant ? ((size_t)((t) >> 2) * 131072 + (size_t)((((t) >> 1) & 1) * 8192 + ((t) & 1) * 2048)) : (size_t)(t) * kstep)
    const unsigned ldsw = (unsigned)wid * 1024u;
    const int aoff = lds_byte(wr * 64 + fr, fq * 8), boff = lds_byte(wc * 32 + fr, fq * 8);
#define PG8_SA(b, h) (((b) * 2 + (h)) * HTB)
#define PG8_SB(b, h) ((4 + (b) * 2 + (h)) * HTB)
#define PG8_STAGE(bufoff, gbase, voff) do { _Pragma("unroll") for (int _i = 0; _i < 2; ++_i) \
        __builtin_amdgcn_global_load_lds((const unsigned*)((const char*)(gbase) + (voff)[_i]), (LAS unsigned*)(lds + (bufoff) + ldsw + _i * 8192), 16, 0, 0); } while (0)
#define PG8_LDA(dst, b, h) do { _Pragma("unroll") for (int m = 0; m < 4; ++m) _Pragma("unroll") for (int k = 0; k < 2; ++k) dst[m][k] = *(const LAS bf16x8*)(lds + PG8_SA(b, h) + aoff + m * 2048 + k * 1024); } while (0)
#define PG8_LDB(dst, b, h) do { _Pragma("unroll") for (int n = 0; n < 2; ++n) _Pragma("unroll") for (int k = 0; k < 2; ++k) dst[n][k] = *(const LAS bf16x8*)(lds + PG8_SB(b, h) + boff + n * 2048 + k * 1024); } while (0)
#define PG8_MMA(ai, bj, At, Bt) do { __builtin_amdgcn_s_setprio(1); _Pragma("unroll") for (int m = 0; m < 4; ++m) _Pragma("unroll") for (int n = 0; n < 2; ++n) _Pragma("unroll") for (int k = 0; k < 2; ++k) \
        acc[ai][bj][m][n] = __builtin_amdgcn_mfma_f32_16x16x32_bf16(Bt[n][k], At[m][k], acc[ai][bj][m][n], 0, 0, 0); __builtin_amdgcn_s_setprio(0); } while (0)
#define PG8_WAIT_V(n) asm volatile("s_waitcnt vmcnt(" #n ")" ::: "memory")
#define PG8_WAIT_L(n) asm volatile("s_waitcnt lgkmcnt(" #n ")" ::: "memory")
#define PG8_BAR __builtin_amdgcn_s_barrier()
#define PG8_SCHED __builtin_amdgcn_sched_barrier(0)
    Unit cur, nxt; int ui = 0;
    if (!S.next(0, cur)) return;
    f32x4 acc[2][2][4][2];
#pragma unroll
    for (int a = 0; a < 2; ++a)
#pragma unroll
        for (int b = 0; b < 2; ++b)
#pragma unroll
            for (int m = 0; m < 4; ++m)
#pragma unroll
                for (int n = 0; n < 2; ++n) acc[a][b][m][n] = (f32x4){0.f, 0.f, 0.f, 0.f};
    bf16x8 At[4][2], B0[2][2], B1[2][2];
    const char* cA = (const char*)g.A + (size_t)cur.pm * tstepA; const char* cB = (const char*)g.Bt + (size_t)cur.pn * tstepB;
    PG8_STAGE(PG8_SB(0, 0), cB, voffB); PG8_STAGE(PG8_SA(0, 0), cA, voffA); PG8_STAGE(PG8_SB(0, 1), cB + hstepB, voffB); PG8_STAGE(PG8_SA(0, 1), cA + hstepA, voffA);
    if (wr == 1) PG8_BAR;
    PG8_WAIT_V(4); PG8_BAR;
    PG8_STAGE(PG8_SB(1, 0), cB + kstep, voffB); PG8_STAGE(PG8_SA(1, 0), cA + PG8_KTA(1), voffA); PG8_STAGE(PG8_SB(1, 1), cB + hstepB + kstep, voffB);
    PG8_WAIT_V(6); PG8_BAR;
    for (;;) {
        const bool has_next = S.next(ui + 1, nxt);
        const char* nA = has_next ? (const char*)g.A + (size_t)nxt.pm * tstepA : cA; const char* nB = has_next ? (const char*)g.Bt + (size_t)nxt.pn * tstepB : cB;
        for (int t = 0; t < nt; t += 2) {
            const bool last = (t == nt - 2);
            const char* a1 = cA + PG8_KTA(t + 1);
            const char* a2 = last ? nA : cA + PG8_KTA(t + 2); const char* b2 = last ? nB : cB + (size_t)(t + 2) * kstep;
            const char* a3 = last ? nA + PG8_KTA(1) : cA + PG8_KTA(t + 3); const char* b3 = b2 + kstep;
            PG8_LDB(B0, 0, 0); PG8_SCHED; PG8_LDA(At, 0, 0); PG8_STAGE(PG8_SA(1, 1), a1 + hstepA, voffA);
            PG8_WAIT_L(8); PG8_BAR; PG8_WAIT_L(0); PG8_MMA(0, 0, At, B0); PG8_BAR; PG8_SCHED;
            PG8_LDB(B1, 0, 1); PG8_STAGE(PG8_SB(0, 0), b2, voffB);
            PG8_BAR; PG8_WAIT_L(0); PG8_MMA(0, 1, At, B1); PG8_BAR;
            PG8_LDA(At, 0, 1); PG8_STAGE(PG8_SA(0, 0), a2, voffA);
            PG8_BAR; PG8_WAIT_L(0); PG8_MMA(1, 0, At, B0); PG8_BAR; PG8_SCHED;
            PG8_STAGE(PG8_SB(0, 1), b2 + hstepB, voffB);
            PG8_WAIT_V(6); PG8_BAR; PG8_MMA(1, 1, At, B1); PG8_BAR;
            PG8_LDB(B0, 1, 0); PG8_SCHED; PG8_LDA(At, 1, 0); PG8_STAGE(PG8_SA(0, 1), a2 + hstepA, voffA);
            PG8_WAIT_L(8); PG8_BAR; PG8_WAIT_L(0); PG8_MMA(0, 0, At, B0); PG8_BAR; PG8_SCHED;
            PG8_LDB(B1, 1, 1); PG8_STAGE(PG8_SB(1, 0), b3, voffB);
            PG8_BAR; PG8_WAIT_L(0); PG8_MMA(0, 1, At, B1); PG8_BAR;
            PG8_LDA(At, 1, 1); PG8_STAGE(PG8_SA(1, 0), a3, voffA);
            PG8_BAR; PG8_WAIT_L(0); PG8_MMA(1, 0, At, B0); PG8_BAR; PG8_SCHED;
            PG8_STAGE(PG8_SB(1, 1), b3 + hstepB, voffB);
            PG8_WAIT_V(6); PG8_BAR; PG8_MMA(1, 1, At, B1); PG8_BAR;
        }
        E(acc, cur, wr, wc, fr, fq);
        if (!has_next) break;
#pragma unroll
        for (int a = 0; a < 2; ++a)
#pragma unroll
            for (int b = 0; b < 2; ++b)
#pragma unroll
                for (int m = 0; m < 4; ++m)
#pragma unroll
                    for (int n = 0; n < 2; ++n) acc[a][b][m][n] = (f32x4){0.f, 0.f, 0.f, 0.f};
        cur = nxt; cA = nA; cB = nB; ++ui;
    }
    PG8_WAIT_V(0);
    if (wr == 0) PG8_BAR;
    PG8_BAR;
#undef PG8_KTA
#undef PG8_SA
#undef PG8_SB
#undef PG8_STAGE
#undef PG8_LDA
#undef PG8_LDB
#undef PG8_MMA
#undef PG8_WAIT_V
#undef PG8_WAIT_L
#undef PG8_BAR
#undef PG8_SCHED
}
}


#define XB_TMO      128
#define XB_XCNT(j)  (256  + 64 * (j))
#define XB_XSUB(j)  (1280 + 64 * (j))
#define XB_XGEN(j)  (2304 + 64 * (j))
#define XB_TOP      3328
#define XB_TOPGEN   3392
#define XCD_BAR_WORDS 3456
#define XB_SPIN_CAP (1u << 22)
DI unsigned xb_ld(unsigned* p)              { return __hip_atomic_load(p, __ATOMIC_RELAXED, __HIP_MEMORY_SCOPE_AGENT); }
DI unsigned xb_add(unsigned* p, unsigned v) { return __hip_atomic_fetch_add(p, v, __ATOMIC_RELAXED, __HIP_MEMORY_SCOPE_AGENT); }
DI unsigned xb_xcc_id() { return (unsigned)__builtin_amdgcn_s_getreg((3 << 11) | 20) & 0xFu; }
#define XB_SPIN(cond, bar) do { unsigned _sp = 0; while (cond) { __builtin_amdgcn_s_sleep(1); \
    if ((++_sp & 255u) == 0u) { if (xb_ld(&(bar)[XB_TMO])) break; if (_sp > XB_SPIN_CAP) { atomicAdd(&(bar)[XB_TMO], 1u); break; } } } } while (0)
struct XcdBarrier { unsigned* bar; unsigned x; volatile LAS unsigned* st; };
DI XcdBarrier xcd_barrier_post(unsigned* bar, volatile LAS unsigned* st) {
    XcdBarrier b; b.bar = bar; b.x = xb_xcc_id(); b.st = st;
    if (threadIdx.x == 0) (void)xb_add(&bar[XB_XCNT(b.x)], 1u);
    return b;
}
DI void xcd_barrier_complete(unsigned* bar, unsigned x, unsigned& nloc, unsigned& nx) {
    const unsigned G = gridDim.x;
    unsigned sum, cnt, mine, sp = 0u;
    for (;;) {
        sum = 0u; cnt = 0u; mine = 0u;
#pragma unroll
        for (unsigned j = 0; j < 16; ++j) { const unsigned c = xb_ld(&bar[XB_XCNT(j)]); sum += c; cnt += (c > 0u) ? 1u : 0u; mine = (j == x) ? c : mine; }
        if (sum == G) break;
        __builtin_amdgcn_s_sleep(1);
        if ((++sp & 255u) == 0u) { if (xb_ld(&bar[XB_TMO])) break; if (sp > XB_SPIN_CAP) { atomicAdd(&bar[XB_TMO], 1u); break; } }
    }
    nloc = mine > 0u ? mine : 1u; nx = cnt > 0u ? cnt : 1u;
}
DI void xcd_barrier(const XcdBarrier& b, int wave_s) {
    asm volatile("s_waitcnt vmcnt(0)" ::: "memory");
    __syncthreads();
    if (wave_s == 0 && lane_id_fresh() == 0) {
        unsigned* bar = b.bar;
        __builtin_amdgcn_s_waitcnt(0);
        unsigned nloc = b.st[0], nx = b.st[1];
        if (nloc == 0u) { xcd_barrier_complete(bar, b.x, nloc, nx); b.st[0] = nloc; b.st[1] = nx; }
        const unsigned old = xb_add(&bar[XB_XSUB(b.x)], 1u);
        const unsigned gen = old / nloc;
        if (old + 1u == (gen + 1u) * nloc) {
            __builtin_amdgcn_fence(__ATOMIC_RELEASE, "agent");
            asm volatile("s_waitcnt vmcnt(0)" ::: "memory");
            const unsigned og = xb_add(&bar[XB_TOP], 1u);
            const unsigned tg = og / nx;
            if (og + 1u == (tg + 1u) * nx) xb_add(&bar[XB_TOPGEN], 1u);
            else XB_SPIN(xb_ld(&bar[XB_TOPGEN]) == tg, bar);
            __builtin_amdgcn_fence(__ATOMIC_ACQUIRE, "agent");
            xb_add(&bar[XB_XGEN(b.x)], 1u);
            asm volatile("s_waitcnt vmcnt(0)" ::: "memory");
        } else {
            XB_SPIN(xb_ld(&bar[XB_XGEN(b.x)]) == gen, bar);
            __builtin_amdgcn_fence(__ATOMIC_ACQUIRE, "agent");
            asm volatile("s_waitcnt vmcnt(0)" ::: "memory");
        }
    }
    __syncthreads();
}

template <bool TILED_IN>
DI void meta_gemm(const bf16_t* am, int lda, const bf16_t* Wt, int N, bf16_t* zo, int ldzo, int nt, LAS unsigned char* lds, int bid, int G, int wave, int lane) {
    const int ntasks = N / 16, r = lane & 15, q = lane >> 4, kq = wave & 3;
    LAS f32x4* part = (LAS f32x4*)lds;
    for (int t0 = 2 * (G - 1 - bid); t0 < ntasks; t0 += 2 * G) {
        const int task = t0 + (wave >> 2), n0 = task * 16;
        const bf16_t* ap = Wt + (size_t)(n0 + r) * D + 8 * q + 512 * kq;
        const bf16_t* bp = TILED_IN ? am + zrowU(SEQ, nt) + zlaneRC(r, 512 * kq + 8 * q) : am + (size_t)r * lda + 8 * q + 512 * kq;
        f32x4 acc = {0.f, 0.f, 0.f, 0.f};
        if (task < ntasks) {
#pragma unroll
            for (int k = 0; k < 16; ++k) { const bf16x8 a = *(const bf16x8*)(ap + 32 * k);
                const bf16x8 b = *(const bf16x8*)(bp + (TILED_IN ? (((k >> 3) << 16) | (((k >> 2) & 1) << 12) | ((k & 3) << 9)) : 32 * k));
                acc = __builtin_amdgcn_mfma_f32_16x16x32_bf16(a, b, acc, 0, 0, 0); }
        }
        part[wave * 64 + lane] = acc;
        __syncthreads();
        if (kq == 0 && task < ntasks) {
            const f32x4 t = (part[wave * 64 + lane] + part[(wave + 1) * 64 + lane]) + (part[(wave + 2) * 64 + lane] + part[(wave + 3) * 64 + lane]);
            u32x2 w; w.x = pk2(t[0], t[1]); w.y = pk2(t[2], t[3]);
            if (TILED_IN) *(u32x2*)(zo + (size_t)(SEQ + r) * ldzo + n0 + 4 * q) = w;
            else *(u32x2*)(zo + zrowU(SEQ, nt) + zlaneRC(r, n0 + 4 * q)) = w;
        }
        __syncthreads();
    }
}

DI void p0_transpose_item(const float* W, int K, int N, bf16_t* WT, LAS float* scr, int item, int lane) {
    const int nblk = N / 32, kb = item / nblk, nb = item % nblk, k0 = 64 * kb, n0 = 32 * nb;
    const int n4 = lane & 7, kr = lane >> 3;
    f32x4 v[8];
#pragma unroll
    for (int i = 0; i < 8; ++i) v[i] = *(const f32x4*)(W + (size_t)(k0 + kr + 8 * i) * N + n0 + 4 * n4);
#pragma unroll
    for (int i = 0; i < 8; ++i) { LAS float* d = scr + (kr + 8 * i) * 33 + 4 * n4; d[0] = v[i][0]; d[1] = v[i][1]; d[2] = v[i][2]; d[3] = v[i][3]; }
    asm volatile("s_waitcnt lgkmcnt(0)" ::: "memory");
    const int c = lane & 7;
#pragma unroll
    for (int j = 0; j < 4; ++j) { const int n = (lane >> 3) + 8 * j; const LAS float* s = scr + (8 * c) * 33 + n;
        u32x4 o; o.x = pk2(s[0 * 33], s[1 * 33]); o.y = pk2(s[2 * 33], s[3 * 33]); o.z = pk2(s[4 * 33], s[5 * 33]); o.w = pk2(s[6 * 33], s[7 * 33]);
        *(u32x4*)(WT + (size_t)(n0 + n) * K + k0 + 8 * c) = o; }
    asm volatile("s_waitcnt lgkmcnt(0)" ::: "memory");
}

struct Params {
    const float* x; const float* meta; const float* rel_bias; const float* w_in_a; const float* sinks_a; const float* w_out_a;
    const float* w_in_b; const float* w_out_b; const float* ln_g; const float* ln_b;
    float* out; unsigned char* ws; int probe; int pad;
};


DI void phase_p0(const Params& p, LAS unsigned char* lds, int gw, int NGW, int wave, int lane) {
    LAS float* scr = (LAS float*)(lds + wave * 8448);
    constexpr int I_INA = (D / 64) * (NA / 32), I_OUT = (D / 64) * (D / 32), I_INB = (D / 64) * (NB / 32);
    constexpr int NITEMS = 2 * (I_INA + I_OUT + I_INB + I_OUT);
    for (int it = gw; it < NITEMS; it += NGW) {
        int r = it;
        if (r < 2 * I_INA) { const int j = r / I_INA; p0_transpose_item(p.w_in_a + (size_t)j * D * NA, D, NA, (bf16_t*)(p.ws + WS_W + j * WPAIR + WO_INA), scr, r % I_INA, lane); continue; } r -= 2 * I_INA;
        if (r < 2 * I_OUT) { const int j = r / I_OUT; p0_transpose_item(p.w_out_a + (size_t)j * D * D, D, D, (bf16_t*)(p.ws + WS_W + j * WPAIR + WO_OUTA), scr, r % I_OUT, lane); continue; } r -= 2 * I_OUT;
        if (r < 2 * I_INB) { const int j = r / I_INB; p0_transpose_item(p.w_in_b + (size_t)j * D * NB, D, NB, (bf16_t*)(p.ws + WS_W + j * WPAIR + WO_INB), scr, r % I_INB, lane); continue; } r -= 2 * I_INB;
        { const int j = r / I_OUT; p0_transpose_item(p.w_out_b + (size_t)j * D * D, D, D, (bf16_t*)(p.ws + WS_W + j * WPAIR + WO_OUTB), scr, r % I_OUT, lane); }
    }
    bf16_t* hb = (bf16_t*)(p.ws + WS_HB);
    { unsigned char* zb = p.ws + WS_Z;
      for (size_t i = (size_t)(gw * 64 + lane) * 16; i < (size_t)(18 + 32) << 17; i += (size_t)NGW * 64 * 16) {
          unsigned char* dst = i < ((size_t)18 << 17) ? zb + ((size_t)(64 * 18) << 17) + i : zb + ((size_t)(64 * 32) << 17) + (i - ((size_t)18 << 17));
          *(u32x4*)dst = (u32x4){0u, 0u, 0u, 0u}; } }
    for (int r0 = gw; r0 < LTOK; r0 += 2 * NGW) {
        f32x4 v[2][8];
#pragma unroll
        for (int q = 0; q < 2; ++q) { const int r = r0 + q * NGW < LTOK ? r0 + q * NGW : r0;
            const f32x4* src = (const f32x4*)(r < SEQ ? p.x + (size_t)r * D : p.meta + (size_t)(r - SEQ) * D) + 2 * lane;
#pragma unroll
            for (int j = 0; j < 4; ++j) { v[q][2 * j] = src[128 * j]; v[q][2 * j + 1] = src[128 * j + 1]; } }
#pragma unroll
        for (int q = 0; q < 2; ++q) { const int r = r0 + q * NGW; if (r >= LTOK) break;
            u32x4* ob = (u32x4*)(hb + (size_t)r * D) + lane;
#pragma unroll
            for (int j = 0; j < 4; ++j) { const f32x4 a0 = v[q][2 * j], a1 = v[q][2 * j + 1]; u32x4 w; w.x = pk2(a0[0], a0[1]); w.y = pk2(a0[2], a0[3]); w.z = pk2(a1[0], a1[1]); w.w = pk2(a1[2], a1[3]); ob[64 * j] = w; } }
    }
}

DI void phase_ln(const Params& p, int layer, int gw, int NGW, int lane) {
    const float* g = p.ln_g + (size_t)layer * D; const float* b = p.ln_b + (size_t)layer * D;
    bf16_t* hb = (bf16_t*)(p.ws + WS_HB);
    const bool last = layer == DEPTH - 1;
    const int nrows = last ? SEQ : LTOK;
    const unsigned short* h16in = layer == DEPTH - 1 ? (const unsigned short*)(p.ws + WS_W) : (const unsigned short*)p.out;
    unsigned short* h16out = layer == DEPTH - 2 ? (unsigned short*)(p.ws + WS_W) : (unsigned short*)p.out;
    constexpr int R = 2;
    for (int r0 = gw; r0 < nrows; r0 += R * NGW) {
        int rr[R]; bool ok[R];
#pragma unroll
        for (int q = 0; q < R; ++q) { ok[q] = r0 + q * NGW < nrows; rr[q] = ok[q] ? r0 + q * NGW : r0; }
        float v[R][32]; float s1[R], s2[R];
#pragma unroll
        for (int q = 0; q < R; ++q) {
            const u32x4* yb = (const u32x4*)(hb + (size_t)rr[q] * D) + lane;
            u32x4 yv[4];
#pragma unroll
            for (int j = 0; j < 4; ++j) yv[j] = yb[64 * j];
            if (layer == 0) {
                const f32x4* src32 = (const f32x4*)(rr[q] < SEQ ? p.x + (size_t)rr[q] * D : p.meta + (size_t)(rr[q] - SEQ) * D) + 2 * lane;
#pragma unroll
                for (int j = 0; j < 4; ++j) { const f32x4 a0 = src32[128 * j], a1 = src32[128 * j + 1];
                    v[q][8 * j + 0] = a0[0]; v[q][8 * j + 1] = a0[1]; v[q][8 * j + 2] = a0[2]; v[q][8 * j + 3] = a0[3];
                    v[q][8 * j + 4] = a1[0]; v[q][8 * j + 5] = a1[1]; v[q][8 * j + 6] = a1[2]; v[q][8 * j + 7] = a1[3]; }
            } else {
                const u32x4* src16 = (const u32x4*)(h16in + (size_t)rr[q] * D) + lane;
#pragma unroll
                for (int j = 0; j < 4; ++j) { const u32x4 hh = src16[64 * j];
                    v[q][8 * j + 0] = h_lo(hh.x); v[q][8 * j + 1] = h_hi(hh.x); v[q][8 * j + 2] = h_lo(hh.y); v[q][8 * j + 3] = h_hi(hh.y);
                    v[q][8 * j + 4] = h_lo(hh.z); v[q][8 * j + 5] = h_hi(hh.z); v[q][8 * j + 6] = h_lo(hh.w); v[q][8 * j + 7] = h_hi(hh.w); }
            }
            float a1 = 0.f, a2 = 0.f;
#pragma unroll
            for (int j = 0; j < 4; ++j) { const unsigned yw[4] = {yv[j].x, yv[j].y, yv[j].z, yv[j].w};
#pragma unroll
                for (int e = 0; e < 4; ++e) { const float u0 = v[q][8 * j + 2 * e] * DN_ALPHA + bf_lo(yw[e]), u1 = v[q][8 * j + 2 * e + 1] * DN_ALPHA + bf_hi(yw[e]);
                    v[q][8 * j + 2 * e] = u0; v[q][8 * j + 2 * e + 1] = u1; a1 += u0 + u1; a2 += u0 * u0 + u1 * u1; } }
            s1[q] = a1; s2[q] = a2;
        }
#pragma unroll
        for (int o = 1; o < 64; o <<= 1)
#pragma unroll
            for (int q = 0; q < R; ++q) { s1[q] += shflx(s1[q], o, lane); s2[q] += shflx(s2[q], o, lane); }
        float mean[R], rstd[R];
#pragma unroll
        for (int q = 0; q < R; ++q) { mean[q] = s1[q] * (1.f / D); const float var = fmaxf(s2[q] * (1.f / D) - mean[q] * mean[q], 0.f); rstd[q] = 1.0f / sqrtf(var + LN_EPS); }
#pragma unroll
        for (int j = 0; j < 4; ++j) {
            const f32x4 g0 = ((const f32x4*)g)[128 * j + 2 * lane], g1 = ((const f32x4*)g)[128 * j + 2 * lane + 1], b0 = ((const f32x4*)b)[128 * j + 2 * lane], b1 = ((const f32x4*)b)[128 * j + 2 * lane + 1];
            const float gg[8] = {g0[0], g0[1], g0[2], g0[3], g1[0], g1[1], g1[2], g1[3]}, bb[8] = {b0[0], b0[1], b0[2], b0[3], b1[0], b1[1], b1[2], b1[3]};
#pragma unroll
            for (int q = 0; q < R; ++q) { if (!ok[q]) continue;
                float y[8];
#pragma unroll
                for (int e = 0; e < 8; ++e) y[e] = (v[q][8 * j + e] - mean[q]) * rstd[q] * gg[e] + bb[e];
                if (last) { f32x4* o = (f32x4*)(p.out + (size_t)rr[q] * D) + 128 * j + 2 * lane; o[0] = (f32x4){y[0], y[1], y[2], y[3]}; o[1] = (f32x4){y[4], y[5], y[6], y[7]}; }
                else { u32x4 hw; hw.x = pkh2(y[0], y[1]); hw.y = pkh2(y[2], y[3]); hw.z = pkh2(y[4], y[5]); hw.w = pkh2(y[6], y[7]);
                       ((u32x4*)(h16out + (size_t)rr[q] * D) + lane)[64 * j] = hw;
                       u32x4 w; w.x = pk2(y[0], y[1]); w.y = pk2(y[2], y[3]); w.z = pk2(y[4], y[5]); w.w = pk2(y[6], y[7]);
                       ((u32x4*)(hb + (size_t)rr[q] * D) + lane)[64 * j] = w; } }
        }
    }
}

#define MFMA32(a, b, c) __builtin_amdgcn_mfma_f32_32x32x16_bf16((a), (b), (c), 0, 0, 0)
DI float silu_mul(float o, float g) { return o * g * __builtin_amdgcn_rcpf(1.0f + __builtin_amdgcn_exp2f(g * -1.4426950408889634f)); }

typedef short s16x4 __attribute__((ext_vector_type(4)));
DI bf16x8 tr_frag(const LAS bf16_t* lo, const LAS bf16_t* hi) {
    const s16x4 a = __builtin_amdgcn_ds_read_tr16_b64_v4i16((LAS s16x4*)lo), b = __builtin_amdgcn_ds_read_tr16_b64_v4i16((LAS s16x4*)hi);
    return __builtin_shufflevector(a, b, 0, 1, 2, 3, 4, 5, 6, 7);
}
constexpr int PB = 160, PA = 96;
constexpr int VS_BYTES = 32 * PB * 2;

template <bool MASKED>
DI void attnB_tile_math(const f32x16& S, int kpos0, int kvalid, int qpos, int h, int lane, float& later, unsigned (&pw)[8]) {
    const float scale2 = 0.08838834764831845f * 1.4426950408889634f;
    float x2[16], sp[16];
#pragma unroll
    for (int r = 0; r < 16; ++r) {
        const float x = S[r] * scale2; x2[r] = x;
        const float e = __builtin_amdgcn_exp2f(-fabsf(x));
        const float v = fmaxf(x, 0.f) + __builtin_amdgcn_logf(1.0f + e);
        if (MASKED) { const int row = (r & 3) + 8 * (r >> 2) + 4 * h; const bool vis = (row < kvalid) && (kpos0 + row < qpos); sp[r] = vis ? v : 0.f; }
        else sp[r] = v;
    }
    float G[4], P[4];
#pragma unroll
    for (int g = 0; g < 4; ++g) { G[g] = (sp[4 * g] + sp[4 * g + 1]) + (sp[4 * g + 2] + sp[4 * g + 3]); P[g] = shflx(G[g], 32, lane); }
    float R[4]; R[3] = 0.f; R[2] = G[3] + P[3]; R[1] = R[2] + (G[2] + P[2]); R[0] = R[1] + (G[1] + P[1]);
    const float total = R[0] + (G[0] + P[0]);
#pragma unroll
    for (int g = 0; g < 4; ++g) {
        float sfx = later + R[g] + (h == 0 ? P[g] : 0.f); float wv[4];
#pragma unroll
        for (int i = 3; i >= 0; --i) {
            const int r = 4 * g + i;
            sfx += sp[r];
            float t = __builtin_amdgcn_exp2f(x2[r] - sfx);
            if (MASKED) { const int row = (r & 3) + 8 * (r >> 2) + 4 * h; const bool vis = (row < kvalid) && (kpos0 + row < qpos); t = vis ? t : 0.f; }
            wv[i] = t;
        }
        pw[2 * g] = pk2(wv[0], wv[1]); pw[2 * g + 1] = pk2(wv[2], wv[3]);
    }
    later += total;
}

DI void attnB_item(bf16_t* z, int hh, int qs, LAS bf16_t* vs, int lane) {
    const int c = lane & 31, h = lane >> 5;
    const bool metaq = qs < 0;
    const int qrow = metaq ? SEQ + c : 32 * qs + c;
    const int qpos = metaq ? (c < NMETA ? c : 0) : NMETA + 32 * qs + c;
    const int trb = (4 * h + ((lane & 15) >> 2)) * PB + 16 * ((lane >> 4) & 1) + 4 * (lane & 3);
    const int qrow0 = metaq ? SEQ : 32 * qs;
    LAS bf16x8* qs_lds = (LAS bf16x8*)(vs + 32 * PB) + lane;
    { const bf16_t* qp = z + zrowU(qrow0, 32) + zlaneRC(c, hh * 128 + 8 * h);
      bf16x8 qf[8];
#pragma unroll
      for (int s = 0; s < 8; ++s) qf[s] = *(const bf16x8*)(qp + (((s >> 1) << 9) | ((s & 1) << 8)));
      asm volatile("s_waitcnt lgkmcnt(0)" ::: "memory");
#pragma unroll
      for (int s = 0; s < 8; ++s) qs_lds[64 * s] = qf[s]; }
    f32x16 acc[4];
#pragma unroll
    for (int dt = 0; dt < 4; ++dt)
#pragma unroll
        for (int i = 0; i < 16; ++i) acc[dt][i] = 0.f;
    float later = 0.f;
    int t = metaq ? -1 : qs;
    const int tfirst = t;
    const bf16_t* kbase = z + zlaneRC(c, 2048 + hh * 128 + 8 * h);
    const bf16_t* vbase = z + zlaneRC(lane & 15, 4096 + hh * 128 + 8 * (lane >> 4));
    bf16x8 kf[8]; u32x4 vv[8];
    { const size_t ro = zrowU(t < 0 ? SEQ : 32 * t, 32);
#pragma unroll
      for (int s = 0; s < 8; ++s) kf[s] = *(const bf16x8*)(kbase + ro + (((s >> 1) << 9) | ((s & 1) << 8)));
#pragma unroll
      for (int i = 0; i < 8; ++i) vv[i] = *(const u32x4*)(vbase + ro + (((i >> 2) << 13) | ((i & 3) << 9))); }
    for (;;) {
        const int kpos0 = t < 0 ? 0 : NMETA + 32 * t, kvalid = t < 0 ? NMETA : 32;
        const int tn = t <= 0 ? -1 : t - 1;
        const size_t ron = zrowU(tn < 0 ? SEQ : 32 * tn, 32);
        f32x16 S; bf16x8 qf[8];
#pragma unroll
        for (int i = 0; i < 16; ++i) S[i] = 0.f;
#pragma unroll
        for (int s = 0; s < 8; ++s) qf[s] = qs_lds[64 * s];
        asm volatile("s_waitcnt lgkmcnt(0)" ::: "memory"); __builtin_amdgcn_sched_barrier(0);
        __builtin_amdgcn_s_setprio(1);
#pragma unroll
        for (int s = 0; s < 8; ++s) S = MFMA32(kf[s], qf[s], S);
        __builtin_amdgcn_s_setprio(0);
#pragma unroll
        for (int s = 0; s < 8; ++s) kf[s] = *(const bf16x8*)(kbase + ron + (((s >> 1) << 9) | ((s & 1) << 8)));
        unsigned pw[8];
        if (t == tfirst || t < 0) attnB_tile_math<true>(S, kpos0, kvalid, qpos, h, lane, later, pw); else attnB_tile_math<false>(S, kpos0, kvalid, qpos, h, lane, later, pw);
        asm volatile("s_waitcnt lgkmcnt(0)" ::: "memory");
#pragma unroll
        for (int i = 0; i < 8; ++i) *(LAS u32x4*)(vs + (16 * (i >> 2) + (lane & 15)) * PB + 32 * (i & 3) + 8 * (lane >> 4)) = vv[i];
#pragma unroll
        for (int i = 0; i < 8; ++i) vv[i] = *(const u32x4*)(vbase + ron + (((i >> 2) << 13) | ((i & 3) << 9)));
        asm volatile("s_waitcnt lgkmcnt(0)" ::: "memory");
        bf16x8 af[2][4];
#pragma unroll
        for (int s = 0; s < 2; ++s)
#pragma unroll
            for (int dt = 0; dt < 4; ++dt) { const LAS bf16_t* lo = vs + trb + 16 * s * PB + 32 * dt; af[s][dt] = tr_frag(lo, lo + 8 * PB); }
        asm volatile("s_waitcnt lgkmcnt(0)" ::: "memory"); __builtin_amdgcn_sched_barrier(0);
        __builtin_amdgcn_s_setprio(1);
#pragma unroll
        for (int s = 0; s < 2; ++s) {
            const u32x4 pwv = {pw[4 * s], pw[4 * s + 1], pw[4 * s + 2], pw[4 * s + 3]};
            const bf16x8 bfrag = __builtin_bit_cast(bf16x8, pwv);
#pragma unroll
            for (int dt = 0; dt < 4; ++dt) acc[dt] = MFMA32(af[s][dt], bfrag, acc[dt]);
        }
        __builtin_amdgcn_s_setprio(0);
        if (t < 0) break;
        if (__all(later > 150.1f)) break;
        t = tn;
    }
    if (!metaq || c < NMETA) {
        bf16_t* orow = z + zrowU(qrow0, 32) + zlaneRC(c, hh * 128 + 4 * h);
        const bf16_t* grow = z + zrowU(qrow0, 32) + zlaneRC(c, 6144 + hh * 128 + 4 * h);
#pragma unroll
        for (int dt = 0; dt < 4; ++dt)
#pragma unroll
            for (int g = 0; g < 4; ++g) {
                const int d0 = (dt << 9) | (g << 7);
                const u32x2 gv = *(const u32x2*)(grow + d0);
                u32x2 o; o.x = pk2(silu_mul(acc[dt][4 * g], bf_lo(gv.x)), silu_mul(acc[dt][4 * g + 1], bf_hi(gv.x)));
                o.y = pk2(silu_mul(acc[dt][4 * g + 2], bf_lo(gv.y)), silu_mul(acc[dt][4 * g + 3], bf_hi(gv.y)));
                *(u32x2*)(orow + d0) = o;
            }
    }
}

template <bool MASKED>
DI void attnA_tile_math(const f32x16& Su, const LAS float* bt, int qpos, int kpos0, int kvalid, bool meta_tile, int h, int lane, float& m, float& l, float& corr, bf16x8 (&bfrag)[2]) {
    float sc[16]; float tmax = -1e30f;
#pragma unroll
    for (int r = 0; r < 16; ++r) {
        const int row = (r & 3) + 8 * (r >> 2) + 4 * h;
        const int dist = qpos - (kpos0 + row);
        if (MASKED) {
            const bool vis = (row < kvalid) && (dist >= 0) && (meta_tile || dist < 128);
            const int di = dist < 0 ? 0 : (dist > 128 ? 128 : dist);
            const float v = Su[r] * (0.125f * 1.4426950408889634f) + bt[di];
            sc[r] = vis ? v : -1e30f;
        } else sc[r] = Su[r] * (0.125f * 1.4426950408889634f) + bt[dist];
        tmax = fmaxf(tmax, sc[r]);
    }
    tmax = fmaxf(tmax, shflx(tmax, 32, lane));
    const float mnew = fmaxf(m, tmax);
    corr = __builtin_amdgcn_exp2f(m - mnew);
    float pr[16]; float psum = 0.f;
#pragma unroll
    for (int r = 0; r < 16; ++r) { pr[r] = __builtin_amdgcn_exp2f(sc[r] - mnew); psum += pr[r]; }
    psum += shflx(psum, 32, lane);
    l = l * corr + psum; m = mnew;
#pragma unroll
    for (int s = 0; s < 2; ++s) {
        u32x4 pw; pw.x = pk2(pr[8 * s], pr[8 * s + 1]); pw.y = pk2(pr[8 * s + 2], pr[8 * s + 3]); pw.z = pk2(pr[8 * s + 4], pr[8 * s + 5]); pw.w = pk2(pr[8 * s + 6], pr[8 * s + 7]);
        bfrag[s] = __builtin_bit_cast(bf16x8, pw);
    }
}

DI void attnA_item(bf16_t* z, const float* sinks, int hp, int qs, LAS bf16_t* vs, const LAS float* btab, int lane) {
    const int c = lane & 31, h = lane >> 5, kvh = hp >> 2;
    const bool metaq = qs < 0;
    const int qrow = metaq ? SEQ + c : 32 * qs + c;
    const int qpos = metaq ? (c < NMETA ? c : 0) : NMETA + 32 * qs + c;
    const int trb = (4 * h + ((lane & 15) >> 2)) * PA + 16 * ((lane >> 4) & 1) + 4 * (lane & 3);
    const int qrow0 = metaq ? SEQ : 32 * qs;
    LAS bf16x8* qs_lds = (LAS bf16x8*)(vs + 32 * PA) + lane;
    { bf16x8 qf[2][4];
#pragma unroll
      for (int u = 0; u < 2; ++u) { const bf16_t* qp = z + zrowU(qrow0, 18) + zlaneRC(c, (2 * hp + u) * 64 + 8 * h);
#pragma unroll
        for (int s = 0; s < 4; ++s) qf[u][s] = *(const bf16x8*)(qp + (((s >> 1) << 9) | ((s & 1) << 8))); }
      asm volatile("s_waitcnt lgkmcnt(0)" ::: "memory");
#pragma unroll
      for (int u = 0; u < 2; ++u)
#pragma unroll
        for (int s = 0; s < 4; ++s) qs_lds[64 * (4 * u + s)] = qf[u][s]; }
    f32x16 acc[2][2];
#pragma unroll
    for (int u = 0; u < 2; ++u)
#pragma unroll
        for (int dt = 0; dt < 2; ++dt)
#pragma unroll
            for (int i = 0; i < 16; ++i) acc[u][dt][i] = 0.f;
    float m[2] = {sinks[2 * hp] * 1.4426950408889634f, sinks[2 * hp + 1] * 1.4426950408889634f}, l[2] = {1.0f, 1.0f};
    const int tlo = metaq ? 0 : (qs - 4 > 0 ? qs - 4 : 0), thi = metaq ? -1 : qs;
    const bf16_t* kbase = z + zlaneRC(c, 2048 + kvh * 64 + 8 * h);
    const bf16_t* vbase = z + zlaneRC(lane & 15, 2304 + kvh * 64 + 8 * (lane >> 4));
    bf16x8 kf[4]; u32x4 vv[4];
    int t = -1;
    { const size_t ro = zrowU(SEQ, 18);
#pragma unroll
      for (int s = 0; s < 4; ++s) kf[s] = *(const bf16x8*)(kbase + ro + (((s >> 1) << 9) | ((s & 1) << 8)));
#pragma unroll
      for (int i = 0; i < 4; ++i) vv[i] = *(const u32x4*)(vbase + ro + (((i >> 1) << 13) | ((i & 1) << 9))); }
    for (;;) {
        const int kpos0 = t < 0 ? 0 : NMETA + 32 * t, kvalid = t < 0 ? NMETA : 32;
        const bool lastt = metaq || t == thi;
        const bool interior = !metaq && t >= 0 && t > qs - 4 && t < qs;
        const int tn = lastt ? t : (t < 0 ? tlo : t + 1);
        const size_t ron = zrowU(tn < 0 ? SEQ : 32 * tn, 18);
        bf16x8 bfrag[2][2];
#pragma unroll
        for (int u = 0; u < 2; ++u) {
            f32x16 Su; bf16x8 qf[4];
#pragma unroll
            for (int i = 0; i < 16; ++i) Su[i] = 0.f;
#pragma unroll
            for (int s = 0; s < 4; ++s) qf[s] = qs_lds[64 * (4 * u + s)];
            asm volatile("s_waitcnt lgkmcnt(0)" ::: "memory"); __builtin_amdgcn_sched_barrier(0);
            __builtin_amdgcn_s_setprio(1);
#pragma unroll
            for (int s = 0; s < 4; ++s) Su = MFMA32(kf[s], qf[s], Su);
            __builtin_amdgcn_s_setprio(0);
            if (u == 1) {
#pragma unroll
                for (int s = 0; s < 4; ++s) kf[s] = *(const bf16x8*)(kbase + ron + (((s >> 1) << 9) | ((s & 1) << 8)));
            }
            const LAS float* bt = btab + (2 * hp + u) * 129;
            float corr;
            if (interior) attnA_tile_math<false>(Su, bt, qpos, kpos0, kvalid, t < 0, h, lane, m[u], l[u], corr, bfrag[u]);
            else attnA_tile_math<true>(Su, bt, qpos, kpos0, kvalid, t < 0, h, lane, m[u], l[u], corr, bfrag[u]);
#pragma unroll
            for (int dt = 0; dt < 2; ++dt)
#pragma unroll
                for (int i = 0; i < 16; ++i) acc[u][dt][i] *= corr;
        }
        asm volatile("s_waitcnt lgkmcnt(0)" ::: "memory");
#pragma unroll
        for (int i = 0; i < 4; ++i) *(LAS u32x4*)(vs + (16 * (i >> 1) + (lane & 15)) * PA + 32 * (i & 1) + 8 * (lane >> 4)) = vv[i];
#pragma unroll
        for (int i = 0; i < 4; ++i) vv[i] = *(const u32x4*)(vbase + ron + (((i >> 1) << 13) | ((i & 1) << 9)));
        asm volatile("s_waitcnt lgkmcnt(0)" ::: "memory");
        bf16x8 af[2][2];
#pragma unroll
        for (int s = 0; s < 2; ++s)
#pragma unroll
            for (int dt = 0; dt < 2; ++dt) { const LAS bf16_t* lo = vs + trb + 16 * s * PA + 32 * dt; af[s][dt] = tr_frag(lo, lo + 8 * PA); }
        asm volatile("s_waitcnt lgkmcnt(0)" ::: "memory"); __builtin_amdgcn_sched_barrier(0);
        __builtin_amdgcn_s_setprio(1);
#pragma unroll
        for (int s = 0; s < 2; ++s)
#pragma unroll
            for (int dt = 0; dt < 2; ++dt) {
                acc[0][dt] = MFMA32(af[s][dt], bfrag[0][s], acc[0][dt]);
                acc[1][dt] = MFMA32(af[s][dt], bfrag[1][s], acc[1][dt]);
            }
        __builtin_amdgcn_s_setprio(0);
        if (lastt) break;
        t = tn;
    }
    if (!metaq || c < NMETA) {
#pragma unroll
        for (int u = 0; u < 2; ++u) {
            const float inv = 1.0f / l[u];
            bf16_t* orow = z + zrowU(qrow0, 18) + zlaneRC(c, (2 * hp + u) * 64 + 4 * h);
            const bf16_t* grow = z + zrowU(qrow0, 18) + zlaneRC(c, 2560 + (2 * hp + u) * 64 + 4 * h);
#pragma unroll
            for (int dt = 0; dt < 2; ++dt)
#pragma unroll
                for (int g = 0; g < 4; ++g) {
                    const int d0 = (dt << 9) | (g << 7);
                    const u32x2 gv = *(const u32x2*)(grow + d0);
                    u32x2 o; o.x = pk2(silu_mul(acc[u][dt][4 * g] * inv, bf_lo(gv.x)), silu_mul(acc[u][dt][4 * g + 1] * inv, bf_hi(gv.x)));
                    o.y = pk2(silu_mul(acc[u][dt][4 * g + 2] * inv, bf_lo(gv.y)), silu_mul(acc[u][dt][4 * g + 3] * inv, bf_hi(gv.y)));
                    *(u32x2*)(orow + d0) = o;
                }
        }
    }
}

constexpr int NQS = SEQ / 32;

struct AttnQueue { unsigned* heads; int x; int cur; };
DI bool attn_next(AttnQueue& q, int lane0, int& qs, int& hd) {
    for (;;) {
        if (q.cur >= 8) return false;
        const int xq = (q.x + q.cur) & 7;
        const int nqs = NQS / 8 + (xq == 7 ? 1 : 0);
        unsigned n = 0;
        if (lane0) n = __hip_atomic_fetch_add(q.heads + 64 * xq, 1u, __ATOMIC_RELAXED, __HIP_MEMORY_SCOPE_AGENT);
        n = (unsigned)__builtin_amdgcn_readfirstlane((int)n);
        if (n < (unsigned)(nqs * 16)) { qs = (NQS / 8) * xq + (int)(n >> 4); hd = (int)(n & 15u); return true; }
        ++q.cur;
    }
}


__global__ void __launch_bounds__(NTHREADS) hybrid_fwd(Params p) {
    extern __shared__ __attribute__((aligned(16))) unsigned char lds_raw[];
    LAS unsigned char* lds = (LAS unsigned char*)lds_raw;
    cg::grid_group grid = cg::this_grid();
    bf16_t* hb = (bf16_t*)(p.ws + WS_HB);
    bf16_t* z = (bf16_t*)(p.ws + WS_Z);
    unsigned* barw = (unsigned*)(p.ws + WS_BAR);
    volatile LAS unsigned* bst = (volatile LAS unsigned*)(lds + LDS_MAIN);
    {
        const int tid = threadIdx.x, lane = tid & 63, wave = __builtin_amdgcn_readfirstlane(tid >> 6);
        const int G = gridDim.x, gw = blockIdx.x * NWAVES + wave, NGW = G * NWAVES;
        if (tid < 2) bst[tid] = 0u;
        if (blockIdx.x == 0) { for (int i = tid; i < XCD_BAR_WORDS; i += NTHREADS) barw[i] = 0u; for (int i = tid; i < 4 * 8 * 64; i += NTHREADS) ((unsigned*)(p.ws + WS_Q))[i] = 0u; }
        phase_p0(p, lds, gw, NGW, wave, lane);
    }
    grid.sync();
    const int wave_s = __builtin_amdgcn_readfirstlane(threadIdx.x >> 6);
    const XcdBarrier xb = xcd_barrier_post(barw, bst);
#define GSYNC() xcd_barrier(xb, wave_s)

#define PHASE_IDS() int lane = lane_id_fresh(); int wave = wave_s; asm volatile("" : "+s"(wave)); \
        int bid = blockIdx.x; asm volatile("" : "+s"(bid)); int G = gridDim.x; asm volatile("" : "+s"(G)); \
        const int tid = wave * 64 + lane, gw = bid * NWAVES + wave, NGW = G * NWAVES; (void)tid; (void)gw; (void)NGW
#pragma unroll 1
    for (int layer = 0; layer < DEPTH; ++layer) {
        const int j = layer >> 1;
        const bool isA = (layer & 1) == 0;
        {
            PHASE_IDS();
            const int N = isA ? NA : NB;
            const bf16_t* wt = isA ? (const bf16_t*)(p.ws + WS_W + j * WPAIR + WO_INA) : (const bf16_t*)(p.ws + WS_W + j * WPAIR + WO_INB);
            pg8::StaticOrder S; S.init(SEQ, N, G, bid);
            pg8::Gemm g{hb, wt, SEQ, N, D, D, 0};
            pg8::EpiBf16 E{z, 0, N / 256}; pg8::gemm_phase<pg8::EpiBf16>(lds, g, S, E, tid);
            meta_gemm<false>(hb + (size_t)SEQ * D, D, wt, N, z, 0, N / 256, lds, bid, G, wave, lane);
        }
        GSYNC();
        if (isA) {
            PHASE_IDS();
            LAS float* btab = (LAS float*)(lds + 8 * 14336);
            for (int idx = tid; idx < 32 * 129; idx += NTHREADS) {
                const int hd = idx / 129, d = idx % 129;
                int bucket = d;
                if (d >= 16) { bucket = 16 + (int)(logf((float)d * (1.0f / 16.0f)) / 2.0794415416798357f * 16.0f); bucket = bucket > 31 ? 31 : bucket; }
                btab[idx] = p.rel_bias[bucket * 32 + hd] * 1.4426950408889634f;
            }
            __syncthreads();
            LAS bf16_t* vs = (LAS bf16_t*)(lds + wave * 14336);
            const float* sinks = p.sinks_a + j * 32;
            AttnQueue aq{(unsigned*)(p.ws + WS_Q) + layer * 8 * 64, (int)(xb.x & 7u), 0}; int qs, hd;
            while (attn_next(aq, lane_id_fresh() == 0, qs, hd)) attnA_item(z, sinks, hd, qs == NQS ? -1 : qs, vs, btab, lane_id_fresh());
        } else {
            PHASE_IDS();
            LAS bf16_t* vs = (LAS bf16_t*)(lds + wave * (VS_BYTES + 8192));
            AttnQueue aq{(unsigned*)(p.ws + WS_Q) + layer * 8 * 64, (int)(xb.x & 7u), 0}; int qs, hd;
            while (attn_next(aq, lane_id_fresh() == 0, qs, hd)) attnB_item(z, hd, qs == NQS ? -1 : qs, vs, lane_id_fresh());
        }
        GSYNC();
        {
            PHASE_IDS();
            const int znt = isA ? NA / 256 : NB / 256;
            pg8::StaticOrder S; S.init(SEQ, D, G, bid);
            const bf16_t* wt = isA ? (const bf16_t*)(p.ws + WS_W + j * WPAIR + WO_OUTA) : (const bf16_t*)(p.ws + WS_W + j * WPAIR + WO_OUTB);
            pg8::Gemm g{z, wt, SEQ, D, D, 0, znt};
            pg8::EpiBf16 E{hb, D, 0}; pg8::gemm_phase<pg8::EpiBf16>(lds, g, S, E, tid);
            if (layer != DEPTH - 1) meta_gemm<true>(z, 0, wt, D, hb, D, znt, lds, bid, G, wave, lane);
        }
        GSYNC();
        {
            PHASE_IDS();
            phase_ln(p, layer, gw, NGW, lane);
        }
        if (layer != DEPTH - 1) GSYNC();
    }
}

extern "C" void kernel_launch(void* const* d_in, const int* in_sizes, int n_in, void* d_out, int out_size, void* d_ws, size_t ws_size, hipStream_t stream) {
    static int grid = 0;
    if (grid == 0) {
        if (n_in != 10 || out_size != SEQ * D || ws_size < WS_END) { fprintf(stderr, "kernel_launch: unexpected shapes (n_in %d out %d ws %zu, need %zu)\n", n_in, out_size, ws_size, (size_t)WS_END); grid = -1; return; }
        int dev = 0, cus = 0, per_cu = 0;
        hipGetDevice(&dev);
        hipDeviceGetAttribute(&cus, hipDeviceAttributeMultiprocessorCount, dev);
        if (hipFuncSetAttribute((const void*)hybrid_fwd, hipFuncAttributeMaxDynamicSharedMemorySize, LDS_BYTES) != hipSuccess) { fprintf(stderr, "kernel_launch: hipFuncSetAttribute failed\n"); grid = -1; return; }
        if (hipOccupancyMaxActiveBlocksPerMultiprocessor(&per_cu, (const void*)hybrid_fwd, NTHREADS, LDS_BYTES) != hipSuccess || per_cu < 1) { fprintf(stderr, "kernel_launch: occupancy query failed (%d)\n", per_cu); (void)hipGetLastError(); per_cu = 1; }
        grid = cus * 1;
    }
    if (grid < 0) return;
    Params p{};
    p.x = (const float*)d_in[0]; p.meta = (const float*)d_in[1]; p.rel_bias = (const float*)d_in[2]; p.w_in_a = (const float*)d_in[3]; p.sinks_a = (const float*)d_in[4];
    p.w_out_a = (const float*)d_in[5]; p.w_in_b = (const float*)d_in[6]; p.w_out_b = (const float*)d_in[7]; p.ln_g = (const float*)d_in[8]; p.ln_b = (const float*)d_in[9];
    p.out = (float*)d_out; p.ws = (unsigned char*)d_ws; p.probe = 1;
    void* args[] = {&p};
    hipError_t e = hipLaunchCooperativeKernel((const void*)hybrid_fwd, dim3(grid), dim3(NTHREADS), args, LDS_BYTES, stream);
    if (e != hipSuccess) fprintf(stderr, "kernel_launch: cooperative launch failed: %s (grid %d)\n", hipGetErrorString(e), grid);
}
```

```cpp
#include <hip/hip_runtime.h>
#include <hip/hip_cooperative_groups.h>
#include <cstdio>
namespace cg = cooperative_groups;

#define LAS __attribute__((address_space(3)))
#define DI __device__ __forceinline__
typedef unsigned short bf16_t;
typedef short bf16x8 __attribute__((ext_vector_type(8)));
typedef float f32x2 __attribute__((ext_vector_type(2)));
typedef float f32x4 __attribute__((ext_vector_type(4)));
typedef float f32x16 __attribute__((ext_vector_type(16)));
typedef unsigned u32x2 __attribute__((ext_vector_type(2)));
typedef unsigned u32x4 __attribute__((ext_vector_type(4)));
typedef __bf16 bf16v2 __attribute__((ext_vector_type(2)));

constexpr int D = 2048, SEQ = 16384, NMETA = 16, LTOK = SEQ + NMETA, MPAD = SEQ + 256;
constexpr int NA = 4608, NB = 8192, DEPTH = 4;
constexpr int NTHREADS = 512, NWAVES = 8;
constexpr int LDS_MAIN = 147456, LDS_BYTES = LDS_MAIN + 16;
constexpr float LN_EPS = 1e-5f;
constexpr float DN_ALPHA = 1.6817928305074290f;

constexpr size_t WS_W = 0;
constexpr size_t WPAIR = (size_t)(NA + D + NB + D) * D * 2;
constexpr size_t WO_INA = 0, WO_OUTA = (size_t)NA * D * 2, WO_INB = WO_OUTA + (size_t)D * D * 2, WO_OUTB = WO_INB + (size_t)NB * D * 2;
constexpr size_t WS_HB = WS_W + 2 * WPAIR;
constexpr size_t WS_Z = WS_HB + (size_t)MPAD * D * 2;
constexpr size_t WS_BAR = WS_Z + (size_t)MPAD * NB * 2;
static_assert((size_t)LTOK * D * 2 <= WPAIR, "the fp16 residual stream must fit in the first layer pair's weight region");
constexpr size_t WS_Q = WS_BAR + 16384;
constexpr size_t WS_END = WS_Q + 4 * 8 * 256;

DI unsigned pk2(float a, float b) { f32x2 v = {a, b}; bf16v2 r = __builtin_convertvector(v, bf16v2); return __builtin_bit_cast(unsigned, r); }
typedef _Float16 h16v2 __attribute__((ext_vector_type(2)));
DI unsigned pkh2(float a, float b) { f32x2 v = {a, b}; h16v2 r = __builtin_convertvector(v, h16v2); return __builtin_bit_cast(unsigned, r); }
DI float h_lo(unsigned u) { return (float)__builtin_bit_cast(h16v2, u)[0]; }
DI float h_hi(unsigned u) { return (float)__builtin_bit_cast(h16v2, u)[1]; }
DI float bf_lo(unsigned u) { return __uint_as_float(u << 16); }
DI float bf_hi(unsigned u) { return __uint_as_float(u & 0xffff0000u); }
DI float shflx(float v, int mask, int lane) { return __int_as_float(__builtin_amdgcn_ds_bpermute((lane ^ mask) << 2, __float_as_int(v))); }
DI int lane_id_fresh() { unsigned zero; asm volatile("v_mov_b32 %0, 0" : "=v"(zero)); return (int)__builtin_amdgcn_mbcnt_hi(~0u, __builtin_amdgcn_mbcnt_lo(~0u, zero)); }
DI float wave_sum(float v, int lane) {
#pragma unroll
    for (int o = 1; o < 64; o <<= 1) v += shflx(v, o, lane);
    return v;
}


DI size_t zrowU(int row0, int NT) { return ((size_t)((row0 >> 8) * NT) << 16) + (size_t)((((row0 >> 7) & 1) << 15) | (((row0 >> 5) & 1) << 14) | (((row0 >> 6) & 1) << 11)); }
DI unsigned zlaneRC(int r5, int col) { return (unsigned)(((col >> 8) << 16) | ((r5 >> 4) << 13) | (((col >> 7) & 1) << 12) | (((col >> 5) & 3) << 9) | (((col >> 3) & 3) << 7) | ((r5 & 15) << 3) | (col & 7)); }

namespace pg8 {
constexpr int BM = 256, BK = 64, HALF = 128, HTB = HALF * BK * 2, NXCD = 8, WGM = 8;
DI int lds_byte(int r, int c) { const int st = (r >> 4) * 2 + (c >> 5), rr = r & 15, cc = c & 31, ob = rr * 64 + cc * 2; return st * 1024 + (ob ^ (((ob >> 9) & 1) << 5)); }
DI void stage_rc(int b, int& R, int& C) { const int st = b / 1024, sb = b % 1024, swz = sb ^ (((sb >> 9) & 1) << 5); R = (st >> 1) * 16 + swz / 64; C = (st & 1) * 32 + (swz % 64) / 2; }
DI int perm32(int rho) { const int n = rho >> 4, i = rho & 15; return 8 * (i >> 2) + 4 * n + (i & 3); }

struct Unit { int pm, pn; };
struct Gemm { const bf16_t* A; const bf16_t* Bt; int M, N, K, lda; int ant; };

struct StaticOrder {
    int nM, nN, nwg, G, c;
    DI void init(int M, int N, int G_, int c_) { nM = M / BM; nN = N / BM; nwg = nM * nN; G = G_; c = c_; }
    DI bool next(int i, Unit& u) const {
        const long L = (long)i * G + c; if (L >= nwg) return false;
        int wgid = (int)L; { const int q = nwg / NXCD, r = nwg % NXCD, xcd = wgid % NXCD, off = wgid / NXCD; wgid = (xcd < r ? xcd * (q + 1) : r * (q + 1) + (xcd - r) * q) + off; }
        const int nig = WGM * nN, gid = wgid / nig, fm = gid * WGM, gsz = (nM - fm) < WGM ? (nM - fm) : WGM;
        u.pm = fm + ((wgid % nig) % gsz); u.pn = (wgid % nig) / gsz; return true;
    }
};

struct EpiBf16 {
    static constexpr bool PERM = true;
    bf16_t* O; int ldc; int nt;
    DI void operator()(const f32x4 (&acc)[2][2][4][2], const Unit& u, int wr, int wc, int fr, int fq) const {
        if (nt) {
            unsigned char* tb = (unsigned char*)O + ((size_t)(u.pm * nt + u.pn) << 17) + (wr * 4 + wc) * 1024 + (fq * 16 + fr) * 16;
#pragma unroll
            for (int ai = 0; ai < 2; ++ai)
#pragma unroll
                for (int m = 0; m < 4; ++m)
#pragma unroll
                    for (int bj = 0; bj < 2; ++bj) { const f32x4 v0 = acc[ai][bj][m][0], v1 = acc[ai][bj][m][1];
                        u32x4 w; w.x = pk2(v0[0], v0[1]); w.y = pk2(v0[2], v0[3]); w.z = pk2(v1[0], v1[1]); w.w = pk2(v1[2], v1[3]);
                        *(u32x4*)(tb + ((ai * 4 + m) * 2 + bj) * 8192) = w; }
            return;
        }
        const int row0 = u.pm * BM + wr * 64 + fr; const int col0 = u.pn * BM + wc * 32 + 8 * fq;
#pragma unroll
        for (int ai = 0; ai < 2; ++ai)
#pragma unroll
            for (int m = 0; m < 4; ++m) { bf16_t* rowp = O + (size_t)(row0 + ai * HALF + m * 16) * ldc + col0;
#pragma unroll
                for (int bj = 0; bj < 2; ++bj) { const f32x4 v0 = acc[ai][bj][m][0], v1 = acc[ai][bj][m][1];
                    u32x4 w; w.x = pk2(v0[0], v0[1]); w.y = pk2(v0[2], v0[3]); w.z = pk2(v1[0], v1[1]); w.w = pk2(v1[2], v1[3]);
                    *(u32x4*)(rowp + bj * HALF) = w; } }
    }
};

template <class Epi>
DI void gemm_phase(LAS unsigned char* lds, const Gemm g, const StaticOrder& S, const Epi& E, const int tid) {
    const int wid = __builtin_amdgcn_readfirstlane(tid >> 6), lane = tid & 63, wr = wid >> 2, wc = wid & 3, fr = lane & 15, fq = lane >> 4;
    const int K = g.K, nt = K / BK, lda = g.lda;
    unsigned voffA[2], voffB[2];
#pragma unroll
    for (int i = 0; i < 2; ++i) { int R, C; stage_rc(tid * 16 + i * 8192, R, C); const int Rb = Epi::PERM ? ((R & ~31) + perm32(R & 31)) : R;
        voffA[i] = g.ant ? (unsigned)((((R >> 4) & 3) << 14) | (((R >> 6) & 1) << 12) | (((C >> 5) & 1) << 10) | (((C >> 3) & 3) << 8) | ((R & 15) << 4)) : (unsigned)(R * lda + C) * 2u;
        voffB[i] = (unsigned)(Rb * K + C) * 2u; }
    const size_t kstep = (size_t)(BK * 2);
    const size_t hstepA = g.ant ? (size_t)65536 : (size_t)HALF * lda * 2, hstepB = (size_t)HALF * K * 2;
    const size_t tstepA = g.ant ? (size_t)g.ant * 131072 : 2 * hstepA, tstepB = 2 * hstepB;
#define PG8_KTA(t) (g.ant ? ((size_t)((t) >> 2) * 131072 + (size_t)((((t) >> 1) & 1) * 8192 + ((t) & 1) * 2048)) : (size_t)(t) * kstep)
    const unsigned ldsw = (unsigned)wid * 1024u;
    const int aoff = lds_byte(wr * 64 + fr, fq * 8), boff = lds_byte(wc * 32 + fr, fq * 8);
#define PG8_SA(b, h) (((b) * 2 + (h)) * HTB)
#define PG8_SB(b, h) ((4 + (b) * 2 + (h)) * HTB)
#define PG8_STAGE(bufoff, gbase, voff) do { _Pragma("unroll") for (int _i = 0; _i < 2; ++_i) \
        __builtin_amdgcn_global_load_lds((const unsigned*)((const char*)(gbase) + (voff)[_i]), (LAS unsigned*)(lds + (bufoff) + ldsw + _i * 8192), 16, 0, 0); } while (0)
#define PG8_LDA(dst, b, h) do { _Pragma("unroll") for (int m = 0; m < 4; ++m) _Pragma("unroll") for (int k = 0; k < 2; ++k) dst[m][k] = *(const LAS bf16x8*)(lds + PG8_SA(b, h) + aoff + m * 2048 + k * 1024); } while (0)
#define PG8_LDB(dst, b, h) do { _Pragma("unroll") for (int n = 0; n < 2; ++n) _Pragma("unroll") for (int k = 0; k < 2; ++k) dst[n][k] = *(const LAS bf16x8*)(lds + PG8_SB(b, h) + boff + n * 2048 + k * 1024); } while (0)
#define PG8_MMA(ai, bj, At, Bt) do { __builtin_amdgcn_s_setprio(1); _Pragma("unroll") for (int m = 0; m < 4; ++m) _Pragma("unroll") for (int n = 0; n < 2; ++n) _Pragma("unroll") for (int k = 0; k < 2; ++k) \
        acc[ai][bj][m][n] = __builtin_amdgcn_mfma_f32_16x16x32_bf16(Bt[n][k], At[m][k], acc[ai][bj][m][n], 0, 0, 0); __builtin_amdgcn_s_setprio(0); } while (0)
#define PG8_WAIT_V(n) asm volatile("s_waitcnt vmcnt(" #n ")" ::: "memory")
#define PG8_WAIT_L(n) asm volatile("s_waitcnt lgkmcnt(" #n ")" ::: "memory")
#define PG8_BAR __builtin_amdgcn_s_barrier()
#define PG8_SCHED __builtin_amdgcn_sched_barrier(0)
    Unit cur, nxt; int ui = 0;
    if (!S.next(0, cur)) return;
    f32x4 acc[2][2][4][2];
#pragma unroll
    for (int a = 0; a < 2; ++a)
#pragma unroll
        for (int b = 0; b < 2; ++b)
#pragma unroll
            for (int m = 0; m < 4; ++m)
#pragma unroll
                for (int n = 0; n < 2; ++n) acc[a][b][m][n] = (f32x4){0.f, 0.f, 0.f, 0.f};
    bf16x8 At[4][2], B0[2][2], B1[2][2];
    const char* cA = (const char*)g.A + (size_t)cur.pm * tstepA; const char* cB = (const char*)g.Bt + (size_t)cur.pn * tstepB;
    PG8_STAGE(PG8_SB(0, 0), cB, voffB); PG8_STAGE(PG8_SA(0, 0), cA, voffA); PG8_STAGE(PG8_SB(0, 1), cB + hstepB, voffB); PG8_STAGE(PG8_SA(0, 1), cA + hstepA, voffA);
    if (wr == 1) PG8_BAR;
    PG8_WAIT_V(4); PG8_BAR;
    PG8_STAGE(PG8_SB(1, 0), cB + kstep, voffB); PG8_STAGE(PG8_SA(1, 0), cA + PG8_KTA(1), voffA); PG8_STAGE(PG8_SB(1, 1), cB + hstepB + kstep, voffB);
    PG8_WAIT_V(6); PG8_BAR;
    for (;;) {
        const bool has_next = S.next(ui + 1, nxt);
        const char* nA = has_next ? (const char*)g.A + (size_t)nxt.pm * tstepA : cA; const char* nB = has_next ? (const char*)g.Bt + (size_t)nxt.pn * tstepB : cB;
        for (int t = 0; t < nt; t += 2) {
            const bool last = (t == nt - 2);
            const char* a1 = cA + PG8_KTA(t + 1);
            const char* a2 = last ? nA : cA + PG8_KTA(t + 2); const char* b2 = last ? nB : cB + (size_t)(t + 2) * kstep;
            const char* a3 = last ? nA + PG8_KTA(1) : cA + PG8_KTA(t + 3); const char* b3 = b2 + kstep;
            PG8_LDB(B0, 0, 0); PG8_SCHED; PG8_LDA(At, 0, 0); PG8_STAGE(PG8_SA(1, 1), a1 + hstepA, voffA);
            PG8_WAIT_L(8); PG8_BAR; PG8_WAIT_L(0); PG8_MMA(0, 0, At, B0); PG8_BAR; PG8_SCHED;
            PG8_LDB(B1, 0, 1); PG8_STAGE(PG8_SB(0, 0), b2, voffB);
            PG8_BAR; PG8_WAIT_L(0); PG8_MMA(0, 1, At, B1); PG8_BAR;
            PG8_LDA(At, 0, 1); PG8_STAGE(PG8_SA(0, 0), a2, voffA);
            PG8_BAR; PG8_WAIT_L(0); PG8_MMA(1, 0, At, B0); PG8_BAR; PG8_SCHED;
            PG8_STAGE(PG8_SB(0, 1), b2 + hstepB, voffB);
            PG8_WAIT_V(6); PG8_BAR; PG8_MMA(1, 1, At, B1); PG8_BAR;
            PG8_LDB(B0, 1, 0); PG8_SCHED; PG8_LDA(At, 1, 0); PG8_STAGE(PG8_SA(0, 1), a2 + hstepA, voffA);
            PG8_WAIT_L(8); PG8_BAR; PG8_WAIT_L(0); PG8_MMA(0, 0, At, B0); PG8_BAR; PG8_SCHED;
            PG8_LDB(B1, 1, 1); PG8_STAGE(PG8_SB(1, 0), b3, voffB);
            PG8_BAR; PG8_WAIT_L(0); PG8_MMA(0, 1, At, B1); PG8_BAR;
            PG8_LDA(At, 1, 1); PG8_STAGE(PG8_SA(1, 0), a3, voffA);
            PG8_BAR; PG8_WAIT_L(0); PG8_MMA(1, 0, At, B0); PG8_BAR; PG8_SCHED;
            PG8_STAGE(PG8_SB(1, 1), b3 + hstepB, voffB);
            PG8_WAIT_V(6); PG8_BAR; PG8_MMA(1, 1, At, B1); PG8_BAR;
        }
        E(acc, cur, wr, wc, fr, fq);
        if (!has_next) break;
#pragma unroll
        for (int a = 0; a < 2; ++a)
#pragma unroll
            for (int b = 0; b < 2; ++b)
#pragma unroll
                for (int m = 0; m < 4; ++m)
#pragma unroll
                    for (int n = 0; n < 2; ++n) acc[a][b][m][n] = (f32x4){0.f, 0.f, 0.f, 0.f};
        cur = nxt; cA = nA; cB = nB; ++ui;
    }
    PG8_WAIT_V(0);
    if (wr == 0) PG8_BAR;
    PG8_BAR;
#undef PG8_KTA
#undef PG8_SA
#undef PG8_SB
#undef PG8_STAGE
#undef PG8_LDA
#undef PG8_LDB
#undef PG8_MMA
#undef PG8_WAIT_V
#undef PG8_WAIT_L
#undef PG8_BAR
#undef PG8_SCHED
}
}


#define XB_TMO      128
#define XB_XCNT(j)  (256  + 64 * (j))
#define XB_XSUB(j)  (1280 + 64 * (j))
#define XB_XGEN(j)  (2304 + 64 * (j))
#define XB_TOP      3328
#define XB_TOPGEN   3392
#define XCD_BAR_WORDS 3456
#define XB_SPIN_CAP (1u << 22)
DI unsigned xb_ld(unsigned* p)              { return __hip_atomic_load(p, __ATOMIC_RELAXED, __HIP_MEMORY_SCOPE_AGENT); }
DI unsigned xb_add(unsigned* p, unsigned v) { return __hip_atomic_fetch_add(p, v, __ATOMIC_RELAXED, __HIP_MEMORY_SCOPE_AGENT); }
DI unsigned xb_xcc_id() { return (unsigned)__builtin_amdgcn_s_getreg((3 << 11) | 20) & 0xFu; }
#define XB_SPIN(cond, bar) do { unsigned _sp = 0; while (cond) { __builtin_amdgcn_s_sleep(1); \
    if ((++_sp & 255u) == 0u) { if (xb_ld(&(bar)[XB_TMO])) break; if (_sp > XB_SPIN_CAP) { atomicAdd(&(bar)[XB_TMO], 1u); break; } } } } while (0)
struct XcdBarrier { unsigned* bar; unsigned x; volatile LAS unsigned* st; };
DI XcdBarrier xcd_barrier_post(unsigned* bar, volatile LAS unsigned* st) {
    XcdBarrier b; b.bar = bar; b.x = xb_xcc_id(); b.st = st;
    if (threadIdx.x == 0) (void)xb_add(&bar[XB_XCNT(b.x)], 1u);
    return b;
}
DI void xcd_barrier_complete(unsigned* bar, unsigned x, unsigned& nloc, unsigned& nx) {
    const unsigned G = gridDim.x;
    unsigned sum, cnt, mine, sp = 0u;
    for (;;) {
        sum = 0u; cnt = 0u; mine = 0u;
#pragma unroll
        for (unsigned j = 0; j < 16; ++j) { const unsigned c = xb_ld(&bar[XB_XCNT(j)]); sum += c; cnt += (c > 0u) ? 1u : 0u; mine = (j == x) ? c : mine; }
        if (sum == G) break;
        __builtin_amdgcn_s_sleep(1);
        if ((++sp & 255u) == 0u) { if (xb_ld(&bar[XB_TMO])) break; if (sp > XB_SPIN_CAP) { atomicAdd(&bar[XB_TMO], 1u); break; } }
    }
    nloc = mine > 0u ? mine : 1u; nx = cnt > 0u ? cnt : 1u;
}
DI void xcd_barrier(const XcdBarrier& b, int wave_s) {
    asm volatile("s_waitcnt vmcnt(0)" ::: "memory");
    __syncthreads();
    if (wave_s == 0 && lane_id_fresh() == 0) {
        unsigned* bar = b.bar;
        __builtin_amdgcn_s_waitcnt(0);
        unsigned nloc = b.st[0], nx = b.st[1];
        if (nloc == 0u) { xcd_barrier_complete(bar, b.x, nloc, nx); b.st[0] = nloc; b.st[1] = nx; }
        const unsigned old = xb_add(&bar[XB_XSUB(b.x)], 1u);
        const unsigned gen = old / nloc;
        if (old + 1u == (gen + 1u) * nloc) {
            __builtin_amdgcn_fence(__ATOMIC_RELEASE, "agent");
            asm volatile("s_waitcnt vmcnt(0)" ::: "memory");
            const unsigned og = xb_add(&bar[XB_TOP], 1u);
            const unsigned tg = og / nx;
            if (og + 1u == (tg + 1u) * nx) xb_add(&bar[XB_TOPGEN], 1u);
            else XB_SPIN(xb_ld(&bar[XB_TOPGEN]) == tg, bar);
            __builtin_amdgcn_fence(__ATOMIC_ACQUIRE, "agent");
            xb_add(&bar[XB_XGEN(b.x)], 1u);
            asm volatile("s_waitcnt vmcnt(0)" ::: "memory");
        } else {
            XB_SPIN(xb_ld(&bar[XB_XGEN(b.x)]) == gen, bar);
            __builtin_amdgcn_fence(__ATOMIC_ACQUIRE, "agent");
            asm volatile("s_waitcnt vmcnt(0)" ::: "memory");
        }
    }
    __syncthreads();
}

template <bool TILED_IN>
DI void meta_gemm(const bf16_t* am, int lda, const bf16_t* Wt, int N, bf16_t* zo, int ldzo, int nt, LAS unsigned char* lds, int bid, int G, int wave, int lane) {
    const int ntasks = N / 16, r = lane & 15, q = lane >> 4, kq = wave & 3;
    LAS f32x4* part = (LAS f32x4*)lds;
    for (int t0 = 2 * (G - 1 - bid); t0 < ntasks; t0 += 2 * G) {
        const int task = t0 + (wave >> 2), n0 = task * 16;
        const bf16_t* ap = Wt + (size_t)(n0 + r) * D + 8 * q + 512 * kq;
        const bf16_t* bp = TILED_IN ? am + zrowU(SEQ, nt) + zlaneRC(r, 512 * kq + 8 * q) : am + (size_t)r * lda + 8 * q + 512 * kq;
        f32x4 acc = {0.f, 0.f, 0.f, 0.f};
        if (task < ntasks) {
#pragma unroll
            for (int k = 0; k < 16; ++k) { const bf16x8 a = *(const bf16x8*)(ap + 32 * k);
                const bf16x8 b = *(const bf16x8*)(bp + (TILED_IN ? (((k >> 3) << 16) | (((k >> 2) & 1) << 12) | ((k & 3) << 9)) : 32 * k));
                acc = __builtin_amdgcn_mfma_f32_16x16x32_bf16(a, b, acc, 0, 0, 0); }
        }
        part[wave * 64 + lane] = acc;
        __syncthreads();
        if (kq == 0 && task < ntasks) {
            const f32x4 t = (part[wave * 64 + lane] + part[(wave + 1) * 64 + lane]) + (part[(wave + 2) * 64 + lane] + part[(wave + 3) * 64 + lane]);
            u32x2 w; w.x = pk2(t[0], t[1]); w.y = pk2(t[2], t[3]);
            if (TILED_IN) *(u32x2*)(zo + (size_t)(SEQ + r) * ldzo + n0 + 4 * q) = w;
            else *(u32x2*)(zo + zrowU(SEQ, nt) + zlaneRC(r, n0 + 4 * q)) = w;
        }
        __syncthreads();
    }
}

DI void p0_transpose_item(const float* W, int K, int N, bf16_t* WT, LAS float* scr, int item, int lane) {
    const int nblk = N / 32, kb = item / nblk, nb = item % nblk, k0 = 128 * kb, n0 = 32 * nb;
    const int n4 = lane & 7, kr = lane >> 3;
    f32x4 v[16];
#pragma unroll
    for (int i = 0; i < 16; ++i) v[i] = *(const f32x4*)(W + (size_t)(k0 + kr + 8 * i) * N + n0 + 4 * n4);
#pragma unroll
    for (int i = 0; i < 16; ++i) { LAS float* d = scr + (kr + 8 * i) * 33 + 4 * n4; d[0] = v[i][0]; d[1] = v[i][1]; d[2] = v[i][2]; d[3] = v[i][3]; }
    asm volatile("s_waitcnt lgkmcnt(0)" ::: "memory");
    const int c = lane & 15;
#pragma unroll
    for (int j = 0; j < 8; ++j) { const int n = (lane >> 4) + 4 * j; const LAS float* s = scr + (8 * c) * 33 + n;
        u32x4 o; o.x = pk2(s[0 * 33], s[1 * 33]); o.y = pk2(s[2 * 33], s[3 * 33]); o.z = pk2(s[4 * 33], s[5 * 33]); o.w = pk2(s[6 * 33], s[7 * 33]);
        *(u32x4*)(WT + (size_t)(n0 + n) * K + k0 + 8 * c) = o; }
    asm volatile("s_waitcnt lgkmcnt(0)" ::: "memory");
}

struct Params {
    const float* x; const float* meta; const float* rel_bias; const float* w_in_a; const float* sinks_a; const float* w_out_a;
    const float* w_in_b; const float* w_out_b; const float* ln_g; const float* ln_b;
    float* out; unsigned char* ws; int probe; int pad;
};


DI void phase_p0(const Params& p, LAS unsigned char* lds, int gw, int NGW, int wave, int lane) {
    LAS float* scr = (LAS float*)(lds + wave * 16896);
    constexpr int I_INA = (D / 128) * (NA / 32), I_OUT = (D / 128) * (D / 32), I_INB = (D / 128) * (NB / 32);
    constexpr int NITEMS = 2 * (I_INA + I_OUT + I_INB + I_OUT);
    for (int it = gw; it < NITEMS; it += NGW) {
        int r = it;
        if (r < 2 * I_INA) { const int j = r / I_INA; p0_transpose_item(p.w_in_a + (size_t)j * D * NA, D, NA, (bf16_t*)(p.ws + WS_W + j * WPAIR + WO_INA), scr, r % I_INA, lane); continue; } r -= 2 * I_INA;
        if (r < 2 * I_OUT) { const int j = r / I_OUT; p0_transpose_item(p.w_out_a + (size_t)j * D * D, D, D, (bf16_t*)(p.ws + WS_W + j * WPAIR + WO_OUTA), scr, r % I_OUT, lane); continue; } r -= 2 * I_OUT;
        if (r < 2 * I_INB) { const int j = r / I_INB; p0_transpose_item(p.w_in_b + (size_t)j * D * NB, D, NB, (bf16_t*)(p.ws + WS_W + j * WPAIR + WO_INB), scr, r % I_INB, lane); continue; } r -= 2 * I_INB;
        { const int j = r / I_OUT; p0_transpose_item(p.w_out_b + (size_t)j * D * D, D, D, (bf16_t*)(p.ws + WS_W + j * WPAIR + WO_OUTB), scr, r % I_OUT, lane); }
    }
    bf16_t* hb = (bf16_t*)(p.ws + WS_HB);
    { unsigned char* zb = p.ws + WS_Z;
      for (size_t i = (size_t)(gw * 64 + lane) * 16; i < (size_t)(18 + 32) << 17; i += (size_t)NGW * 64 * 16) {
          unsigned char* dst = i < ((size_t)18 << 17) ? zb + ((size_t)(64 * 18) << 17) + i : zb + ((size_t)(64 * 32) << 17) + (i - ((size_t)18 << 17));
          *(u32x4*)dst = (u32x4){0u, 0u, 0u, 0u}; } }
    for (int r0 = gw; r0 < LTOK; r0 += 2 * NGW) {
        f32x4 v[2][8];
#pragma unroll
        for (int q = 0; q < 2; ++q) { const int r = r0 + q * NGW < LTOK ? r0 + q * NGW : r0;
            const f32x4* src = (const f32x4*)(r < SEQ ? p.x + (size_t)r * D : p.meta + (size_t)(r - SEQ) * D) + 2 * lane;
#pragma unroll
            for (int j = 0; j < 4; ++j) { v[q][2 * j] = src[128 * j]; v[q][2 * j + 1] = src[128 * j + 1]; } }
#pragma unroll
        for (int q = 0; q < 2; ++q) { const int r = r0 + q * NGW; if (r >= LTOK) break;
            u32x4* ob = (u32x4*)(hb + (size_t)r * D) + lane;
#pragma unroll
            for (int j = 0; j < 4; ++j) { const f32x4 a0 = v[q][2 * j], a1 = v[q][2 * j + 1]; u32x4 w; w.x = pk2(a0[0], a0[1]); w.y = pk2(a0[2], a0[3]); w.z = pk2(a1[0], a1[1]); w.w = pk2(a1[2], a1[3]); ob[64 * j] = w; } }
    }
}

DI void phase_ln(const Params& p, int layer, int gw, int NGW, int lane) {
    const float* g = p.ln_g + (size_t)layer * D; const float* b = p.ln_b + (size_t)layer * D;
    bf16_t* hb = (bf16_t*)(p.ws + WS_HB);
    const bool last = layer == DEPTH - 1;
    const int nrows = last ? SEQ : LTOK;
    const unsigned short* h16in = layer == DEPTH - 1 ? (const unsigned short*)(p.ws + WS_W) : (const unsigned short*)p.out;
    unsigned short* h16out = layer == DEPTH - 2 ? (unsigned short*)(p.ws + WS_W) : (unsigned short*)p.out;
    constexpr int R = 2;
    for (int r0 = gw; r0 < nrows; r0 += R * NGW) {
        int rr[R]; bool ok[R];
#pragma unroll
        for (int q = 0; q < R; ++q) { ok[q] = r0 + q * NGW < nrows; rr[q] = ok[q] ? r0 + q * NGW : r0; }
        float v[R][32]; float s1[R], s2[R];
#pragma unroll
        for (int q = 0; q < R; ++q) {
            const u32x4* yb = (const u32x4*)(hb + (size_t)rr[q] * D) + lane;
            u32x4 yv[4];
#pragma unroll
            for (int j = 0; j < 4; ++j) yv[j] = yb[64 * j];
            if (layer == 0) {
                const f32x4* src32 = (const f32x4*)(rr[q] < SEQ ? p.x + (size_t)rr[q] * D : p.meta + (size_t)(rr[q] - SEQ) * D) + 2 * lane;
#pragma unroll
                for (int j = 0; j < 4; ++j) { const f32x4 a0 = src32[128 * j], a1 = src32[128 * j + 1];
                    v[q][8 * j + 0] = a0[0]; v[q][8 * j + 1] = a0[1]; v[q][8 * j + 2] = a0[2]; v[q][8 * j + 3] = a0[3];
                    v[q][8 * j + 4] = a1[0]; v[q][8 * j + 5] = a1[1]; v[q][8 * j + 6] = a1[2]; v[q][8 * j + 7] = a1[3]; }
            } else {
                const u32x4* src16 = (const u32x4*)(h16in + (size_t)rr[q] * D) + lane;
#pragma unroll
                for (int j = 0; j < 4; ++j) { const u32x4 hh = src16[64 * j];
                    v[q][8 * j + 0] = h_lo(hh.x); v[q][8 * j + 1] = h_hi(hh.x); v[q][8 * j + 2] = h_lo(hh.y); v[q][8 * j + 3] = h_hi(hh.y);
                    v[q][8 * j + 4] = h_lo(hh.z); v[q][8 * j + 5] = h_hi(hh.z); v[q][8 * j + 6] = h_lo(hh.w); v[q][8 * j + 7] = h_hi(hh.w); }
            }
            float a1 = 0.f, a2 = 0.f;
#pragma unroll
            for (int j = 0; j < 4; ++j) { const unsigned yw[4] = {yv[j].x, yv[j].y, yv[j].z, yv[j].w};
#pragma unroll
                for (int e = 0; e < 4; ++e) { const float u0 = v[q][8 * j + 2 * e] * DN_ALPHA + bf_lo(yw[e]), u1 = v[q][8 * j + 2 * e + 1] * DN_ALPHA + bf_hi(yw[e]);
                    v[q][8 * j + 2 * e] = u0; v[q][8 * j + 2 * e + 1] = u1; a1 += u0 + u1; a2 += u0 * u0 + u1 * u1; } }
            s1[q] = a1; s2[q] = a2;
        }
#pragma unroll
        for (int o = 1; o < 64; o <<= 1)
#pragma unroll
            for (int q = 0; q < R; ++q) { s1[q] += shflx(s1[q], o, lane); s2[q] += shflx(s2[q], o, lane); }
        float mean[R], rstd[R];
#pragma unroll
        for (int q = 0; q < R; ++q) { mean[q] = s1[q] * (1.f / D); const float var = fmaxf(s2[q] * (1.f / D) - mean[q] * mean[q], 0.f); rstd[q] = 1.0f / sqrtf(var + LN_EPS); }
#pragma unroll
        for (int j = 0; j < 4; ++j) {
            const f32x4 g0 = ((const f32x4*)g)[128 * j + 2 * lane], g1 = ((const f32x4*)g)[128 * j + 2 * lane + 1], b0 = ((const f32x4*)b)[128 * j + 2 * lane], b1 = ((const f32x4*)b)[128 * j + 2 * lane + 1];
            const float gg[8] = {g0[0], g0[1], g0[2], g0[3], g1[0], g1[1], g1[2], g1[3]}, bb[8] = {b0[0], b0[1], b0[2], b0[3], b1[0], b1[1], b1[2], b1[3]};
#pragma unroll
            for (int q = 0; q < R; ++q) { if (!ok[q]) continue;
                float y[8];
#pragma unroll
                for (int e = 0; e < 8; ++e) y[e] = (v[q][8 * j + e] - mean[q]) * rstd[q] * gg[e] + bb[e];
                if (last) { f32x4* o = (f32x4*)(p.out + (size_t)rr[q] * D) + 128 * j + 2 * lane; o[0] = (f32x4){y[0], y[1], y[2], y[3]}; o[1] = (f32x4){y[4], y[5], y[6], y[7]}; }
                else { u32x4 hw; hw.x = pkh2(y[0], y[1]); hw.y = pkh2(y[2], y[3]); hw.z = pkh2(y[4], y[5]); hw.w = pkh2(y[6], y[7]);
                       ((u32x4*)(h16out + (size_t)rr[q] * D) + lane)[64 * j] = hw;
                       u32x4 w; w.x = pk2(y[0], y[1]); w.y = pk2(y[2], y[3]); w.z = pk2(y[4], y[5]); w.w = pk2(y[6], y[7]);
                       ((u32x4*)(hb + (size_t)rr[q] * D) + lane)[64 * j] = w; } }
        }
    }
}

#define MFMA32(a, b, c) __builtin_amdgcn_mfma_f32_32x32x16_bf16((a), (b), (c), 0, 0, 0)
DI float silu_mul(float o, float g) { return o * g * __builtin_amdgcn_rcpf(1.0f + __builtin_amdgcn_exp2f(g * -1.4426950408889634f)); }

typedef short s16x4 __attribute__((ext_vector_type(4)));
DI bf16x8 tr_frag(const LAS bf16_t* lo, const LAS bf16_t* hi) {
    const s16x4 a = __builtin_amdgcn_ds_read_tr16_b64_v4i16((LAS s16x4*)lo), b = __builtin_amdgcn_ds_read_tr16_b64_v4i16((LAS s16x4*)hi);
    return __builtin_shufflevector(a, b, 0, 1, 2, 3, 4, 5, 6, 7);
}
constexpr int PB = 160, PA = 96;
constexpr int VS_BYTES = 32 * PB * 2;

template <bool MASKED>
DI void attnB_tile_math(const f32x16& S, int kpos0, int kvalid, int qpos, int h, int lane, float& later, unsigned (&pw)[8]) {
    const float scale2 = 0.08838834764831845f * 1.4426950408889634f;
    float x2[16], sp[16];
#pragma unroll
    for (int r = 0; r < 16; ++r) {
        const float x = S[r] * scale2; x2[r] = x;
        const float e = __builtin_amdgcn_exp2f(-fabsf(x));
        const float v = fmaxf(x, 0.f) + __builtin_amdgcn_logf(1.0f + e);
        if (MASKED) { const int row = (r & 3) + 8 * (r >> 2) + 4 * h; const bool vis = (row < kvalid) && (kpos0 + row < qpos); sp[r] = vis ? v : 0.f; }
        else sp[r] = v;
    }
    float G[4], P[4];
#pragma unroll
    for (int g = 0; g < 4; ++g) { G[g] = (sp[4 * g] + sp[4 * g + 1]) + (sp[4 * g + 2] + sp[4 * g + 3]); P[g] = shflx(G[g], 32, lane); }
    float R[4]; R[3] = 0.f; R[2] = G[3] + P[3]; R[1] = R[2] + (G[2] + P[2]); R[0] = R[1] + (G[1] + P[1]);
    const float total = R[0] + (G[0] + P[0]);
#pragma unroll
    for (int g = 0; g < 4; ++g) {
        float sfx = later + R[g] + (h == 0 ? P[g] : 0.f); float wv[4];
#pragma unroll
        for (int i = 3; i >= 0; --i) {
            const int r = 4 * g + i;
            sfx += sp[r];
            float t = __builtin_amdgcn_exp2f(x2[r] - sfx);
            if (MASKED) { const int row = (r & 3) + 8 * (r >> 2) + 4 * h; const bool vis = (row < kvalid) && (kpos0 + row < qpos); t = vis ? t : 0.f; }
            wv[i] = t;
        }
        pw[2 * g] = pk2(wv[0], wv[1]); pw[2 * g + 1] = pk2(wv[2], wv[3]);
    }
    later += total;
}

DI void attnB_item(bf16_t* z, int hh, int qs, LAS bf16_t* vs, int lane) {
    const int c = lane & 31, h = lane >> 5;
    const bool metaq = qs < 0;
    const int qrow = metaq ? SEQ + c : 32 * qs + c;
    const int qpos = metaq ? (c < NMETA ? c : 0) : NMETA + 32 * qs + c;
    const int trb = (4 * h + ((lane & 15) >> 2)) * PB + 16 * ((lane >> 4) & 1) + 4 * (lane & 3);
    const int qrow0 = metaq ? SEQ : 32 * qs;
    LAS bf16x8* qs_lds = (LAS bf16x8*)(vs + 32 * PB) + lane;
    { const bf16_t* qp = z + zrowU(qrow0, 32) + zlaneRC(c, hh * 128 + 8 * h);
      bf16x8 qf[8];
#pragma unroll
      for (int s = 0; s < 8; ++s) qf[s] = *(const bf16x8*)(qp + (((s >> 1) << 9) | ((s & 1) << 8)));
      asm volatile("s_waitcnt lgkmcnt(0)" ::: "memory");
#pragma unroll
      for (int s = 0; s < 8; ++s) qs_lds[64 * s] = qf[s]; }
    f32x16 acc[4];
#pragma unroll
    for (int dt = 0; dt < 4; ++dt)
#pragma unroll
        for (int i = 0; i < 16; ++i) acc[dt][i] = 0.f;
    float later = 0.f;
    int t = metaq ? -1 : qs;
    const int tfirst = t;
    const bf16_t* kbase = z + zlaneRC(c, 2048 + hh * 128 + 8 * h);
    const bf16_t* vbase = z + zlaneRC(lane & 15, 4096 + hh * 128 + 8 * (lane >> 4));
    bf16x8 kf[8]; u32x4 vv[8];
    { const size_t ro = zrowU(t < 0 ? SEQ : 32 * t, 32);
#pragma unroll
      for (int s = 0; s < 8; ++s) kf[s] = *(const bf16x8*)(kbase + ro + (((s >> 1) << 9) | ((s & 1) << 8)));
#pragma unroll
      for (int i = 0; i < 8; ++i) vv[i] = *(const u32x4*)(vbase + ro + (((i >> 2) << 13) | ((i & 3) << 9))); }
    for (;;) {
        const int kpos0 = t < 0 ? 0 : NMETA + 32 * t, kvalid = t < 0 ? NMETA : 32;
        const int tn = t <= 0 ? -1 : t - 1;
        const size_t ron = zrowU(tn < 0 ? SEQ : 32 * tn, 32);
        f32x16 S; bf16x8 qf[8];
#pragma unroll
        for (int i = 0; i < 16; ++i) S[i] = 0.f;
#pragma unroll
        for (int s = 0; s < 8; ++s) qf[s] = qs_lds[64 * s];
        asm volatile("s_waitcnt lgkmcnt(0)" ::: "memory"); __builtin_amdgcn_sched_barrier(0);
        __builtin_amdgcn_s_setprio(1);
#pragma unroll
        for (int s = 0; s < 8; ++s) S = MFMA32(kf[s], qf[s], S);
        __builtin_amdgcn_s_setprio(0);
#pragma unroll
        for (int s = 0; s < 8; ++s) kf[s] = *(const bf16x8*)(kbase + ron + (((s >> 1) << 9) | ((s & 1) << 8)));
        unsigned pw[8];
        if (t == tfirst || t < 0) attnB_tile_math<true>(S, kpos0, kvalid, qpos, h, lane, later, pw); else attnB_tile_math<false>(S, kpos0, kvalid, qpos, h, lane, later, pw);
        asm volatile("s_waitcnt lgkmcnt(0)" ::: "memory");
#pragma unroll
        for (int i = 0; i < 8; ++i) *(LAS u32x4*)(vs + (16 * (i >> 2) + (lane & 15)) * PB + 32 * (i & 3) + 8 * (lane >> 4)) = vv[i];
#pragma unroll
        for (int i = 0; i < 8; ++i) vv[i] = *(const u32x4*)(vbase + ron + (((i >> 2) << 13) | ((i & 3) << 9)));
        asm volatile("s_waitcnt lgkmcnt(0)" ::: "memory");
        bf16x8 af[2][4];
#pragma unroll
        for (int s = 0; s < 2; ++s)
#pragma unroll
            for (int dt = 0; dt < 4; ++dt) { const LAS bf16_t* lo = vs + trb + 16 * s * PB + 32 * dt; af[s][dt] = tr_frag(lo, lo + 8 * PB); }
        asm volatile("s_waitcnt lgkmcnt(0)" ::: "memory"); __builtin_amdgcn_sched_barrier(0);
        __builtin_amdgcn_s_setprio(1);
#pragma unroll
        for (int s = 0; s < 2; ++s) {
            const u32x4 pwv = {pw[4 * s], pw[4 * s + 1], pw[4 * s + 2], pw[4 * s + 3]};
            const bf16x8 bfrag = __builtin_bit_cast(bf16x8, pwv);
#pragma unroll
            for (int dt = 0; dt < 4; ++dt) acc[dt] = MFMA32(af[s][dt], bfrag, acc[dt]);
        }
        __builtin_amdgcn_s_setprio(0);
        if (t < 0) break;
        if (__all(later > 150.1f)) break;
        t = tn;
    }
    if (!metaq || c < NMETA) {
        bf16_t* orow = z + zrowU(qrow0, 32) + zlaneRC(c, hh * 128 + 4 * h);
        const bf16_t* grow = z + zrowU(qrow0, 32) + zlaneRC(c, 6144 + hh * 128 + 4 * h);
#pragma unroll
        for (int dt = 0; dt < 4; ++dt)
#pragma unroll
            for (int g = 0; g < 4; ++g) {
                const int d0 = (dt << 9) | (g << 7);
                const u32x2 gv = *(const u32x2*)(grow + d0);
                u32x2 o; o.x = pk2(silu_mul(acc[dt][4 * g], bf_lo(gv.x)), silu_mul(acc[dt][4 * g + 1], bf_hi(gv.x)));
                o.y = pk2(silu_mul(acc[dt][4 * g + 2], bf_lo(gv.y)), silu_mul(acc[dt][4 * g + 3], bf_hi(gv.y)));
                *(u32x2*)(orow + d0) = o;
            }
    }
}

template <bool MASKED>
DI void attnA_tile_math(const f32x16& Su, const LAS float* bt, int qpos, int kpos0, int kvalid, bool meta_tile, int h, int lane, float& m, float& l, float& corr, bf16x8 (&bfrag)[2]) {
    float sc[16]; float tmax = -1e30f;
#pragma unroll
    for (int r = 0; r < 16; ++r) {
        const int row = (r & 3) + 8 * (r >> 2) + 4 * h;
        const int dist = qpos - (kpos0 + row);
        if (MASKED) {
            const bool vis = (row < kvalid) && (dist >= 0) && (meta_tile || dist < 128);
            const int di = dist < 0 ? 0 : (dist > 128 ? 128 : dist);
            const float v = Su[r] * (0.125f * 1.4426950408889634f) + bt[di];
            sc[r] = vis ? v : -1e30f;
        } else sc[r] = Su[r] * (0.125f * 1.4426950408889634f) + bt[dist];
        tmax = fmaxf(tmax, sc[r]);
    }
    tmax = fmaxf(tmax, shflx(tmax, 32, lane));
    const float mnew = fmaxf(m, tmax);
    corr = __builtin_amdgcn_exp2f(m - mnew);
    float pr[16]; float psum = 0.f;
#pragma unroll
    for (int r = 0; r < 16; ++r) { pr[r] = __builtin_amdgcn_exp2f(sc[r] - mnew); psum += pr[r]; }
    psum += shflx(psum, 32, lane);
    l = l * corr + psum; m = mnew;
#pragma unroll
    for (int s = 0; s < 2; ++s) {
        u32x4 pw; pw.x = pk2(pr[8 * s], pr[8 * s + 1]); pw.y = pk2(pr[8 * s + 2], pr[8 * s + 3]); pw.z = pk2(pr[8 * s + 4], pr[8 * s + 5]); pw.w = pk2(pr[8 * s + 6], pr[8 * s + 7]);
        bfrag[s] = __builtin_bit_cast(bf16x8, pw);
    }
}

DI void attnA_item(bf16_t* z, const float* sinks, int hp, int qs, LAS bf16_t* vs, const LAS float* btab, int lane) {
    const int c = lane & 31, h = lane >> 5, kvh = hp >> 2;
    const bool metaq = qs < 0;
    const int qrow = metaq ? SEQ + c : 32 * qs + c;
    const int qpos = metaq ? (c < NMETA ? c : 0) : NMETA + 32 * qs + c;
    const int trb = (4 * h + ((lane & 15) >> 2)) * PA + 16 * ((lane >> 4) & 1) + 4 * (lane & 3);
    const int qrow0 = metaq ? SEQ : 32 * qs;
    LAS bf16x8* qs_lds = (LAS bf16x8*)(vs + 32 * PA) + lane;
    { bf16x8 qf[2][4];
#pragma unroll
      for (int u = 0; u < 2; ++u) { const bf16_t* qp = z + zrowU(qrow0, 18) + zlaneRC(c, (2 * hp + u) * 64 + 8 * h);
#pragma unroll
        for (int s = 0; s < 4; ++s) qf[u][s] = *(const bf16x8*)(qp + (((s >> 1) << 9) | ((s & 1) << 8))); }
      asm volatile("s_waitcnt lgkmcnt(0)" ::: "memory");
#pragma unroll
      for (int u = 0; u < 2; ++u)
#pragma unroll
        for (int s = 0; s < 4; ++s) qs_lds[64 * (4 * u + s)] = qf[u][s]; }
    f32x16 acc[2][2];
#pragma unroll
    for (int u = 0; u < 2; ++u)
#pragma unroll
        for (int dt = 0; dt < 2; ++dt)
#pragma unroll
            for (int i = 0; i < 16; ++i) acc[u][dt][i] = 0.f;
    float m[2] = {sinks[2 * hp] * 1.4426950408889634f, sinks[2 * hp + 1] * 1.4426950408889634f}, l[2] = {1.0f, 1.0f};
    const int tlo = metaq ? 0 : (qs - 4 > 0 ? qs - 4 : 0), thi = metaq ? -1 : qs;
    const bf16_t* kbase = z + zlaneRC(c, 2048 + kvh * 64 + 8 * h);
    const bf16_t* vbase = z + zlaneRC(lane & 15, 2304 + kvh * 64 + 8 * (lane >> 4));
    bf16x8 kf[4]; u32x4 vv[4];
    int t = -1;
    { const size_t ro = zrowU(SEQ, 18);
#pragma unroll
      for (int s = 0; s < 4; ++s) kf[s] = *(const bf16x8*)(kbase + ro + (((s >> 1) << 9) | ((s & 1) << 8)));
#pragma unroll
      for (int i = 0; i < 4; ++i) vv[i] = *(const u32x4*)(vbase + ro + (((i >> 1) << 13) | ((i & 1) << 9))); }
    for (;;) {
        const int kpos0 = t < 0 ? 0 : NMETA + 32 * t, kvalid = t < 0 ? NMETA : 32;
        const bool lastt = metaq || t == thi;
        const bool interior = !metaq && t >= 0 && t > qs - 4 && t < qs;
        const int tn = lastt ? t : (t < 0 ? tlo : t + 1);
        const size_t ron = zrowU(tn < 0 ? SEQ : 32 * tn, 18);
        bf16x8 bfrag[2][2];
#pragma unroll
        for (int u = 0; u < 2; ++u) {
            f32x16 Su; bf16x8 qf[4];
#pragma unroll
            for (int i = 0; i < 16; ++i) Su[i] = 0.f;
#pragma unroll
            for (int s = 0; s < 4; ++s) qf[s] = qs_lds[64 * (4 * u + s)];
            asm volatile("s_waitcnt lgkmcnt(0)" ::: "memory"); __builtin_amdgcn_sched_barrier(0);
            __builtin_amdgcn_s_setprio(1);
#pragma unroll
            for (int s = 0; s < 4; ++s) Su = MFMA32(kf[s], qf[s], Su);
            __builtin_amdgcn_s_setprio(0);
            if (u == 1) {
#pragma unroll
                for (int s = 0; s < 4; ++s) kf[s] = *(const bf16x8*)(kbase + ron + (((s >> 1) << 9) | ((s & 1) << 8)));
            }
            const LAS float* bt = btab + (2 * hp + u) * 129;
            float corr;
            if (interior) attnA_tile_math<false>(Su, bt, qpos, kpos0, kvalid, t < 0, h, lane, m[u], l[u], corr, bfrag[u]);
            else attnA_tile_math<true>(Su, bt, qpos, kpos0, kvalid, t < 0, h, lane, m[u], l[u], corr, bfrag[u]);
#pragma unroll
            for (int dt = 0; dt < 2; ++dt)
#pragma unroll
                for (int i = 0; i < 16; ++i) acc[u][dt][i] *= corr;
        }
        asm volatile("s_waitcnt lgkmcnt(0)" ::: "memory");
#pragma unroll
        for (int i = 0; i < 4; ++i) *(LAS u32x4*)(vs + (16 * (i >> 1) + (lane & 15)) * PA + 32 * (i & 1) + 8 * (lane >> 4)) = vv[i];
#pragma unroll
        for (int i = 0; i < 4; ++i) vv[i] = *(const u32x4*)(vbase + ron + (((i >> 1) << 13) | ((i & 1) << 9)));
        asm volatile("s_waitcnt lgkmcnt(0)" ::: "memory");
        bf16x8 af[2][2];
#pragma unroll
        for (int s = 0; s < 2; ++s)
#pragma unroll
            for (int dt = 0; dt < 2; ++dt) { const LAS bf16_t* lo = vs + trb + 16 * s * PA + 32 * dt; af[s][dt] = tr_frag(lo, lo + 8 * PA); }
        asm volatile("s_waitcnt lgkmcnt(0)" ::: "memory"); __builtin_amdgcn_sched_barrier(0);
        __builtin_amdgcn_s_setprio(1);
#pragma unroll
        for (int s = 0; s < 2; ++s)
#pragma unroll
            for (int dt = 0; dt < 2; ++dt) {
                acc[0][dt] = MFMA32(af[s][dt], bfrag[0][s], acc[0][dt]);
                acc[1][dt] = MFMA32(af[s][dt], bfrag[1][s], acc[1][dt]);
            }
        __builtin_amdgcn_s_setprio(0);
        if (lastt) break;
        t = tn;
    }
    if (!metaq || c < NMETA) {
#pragma unroll
        for (int u = 0; u < 2; ++u) {
            const float inv = 1.0f / l[u];
            bf16_t* orow = z + zrowU(qrow0, 18) + zlaneRC(c, (2 * hp + u) * 64 + 4 * h);
            const bf16_t* grow = z + zrowU(qrow0, 18) + zlaneRC(c, 2560 + (2 * hp + u) * 64 + 4 * h);
#pragma unroll
            for (int dt = 0; dt < 2; ++dt)
#pragma unroll
                for (int g = 0; g < 4; ++g) {
                    const int d0 = (dt << 9) | (g << 7);
                    const u32x2 gv = *(const u32x2*)(grow + d0);
                    u32x2 o; o.x = pk2(silu_mul(acc[u][dt][4 * g] * inv, bf_lo(gv.x)), silu_mul(acc[u][dt][4 * g + 1] * inv, bf_hi(gv.x)));
                    o.y = pk2(silu_mul(acc[u][dt][4 * g + 2] * inv, bf_lo(gv.y)), silu_mul(acc[u][dt][4 * g + 3] * inv, bf_hi(gv.y)));
                    *(u32x2*)(orow + d0) = o;
                }
        }
    }
}

constexpr int NQS = SEQ / 32;

struct AttnQueue { unsigned* heads; int x; int cur; };
DI bool attn_next(AttnQueue& q, int lane0, int& qs, int& hd) {
    for (;;) {
        if (q.cur >= 8) return false;
        const int xq = (q.x + q.cur) & 7;
        const int nqs = NQS / 8 + (xq == 7 ? 1 : 0);
        unsigned n = 0;
        if (lane0) n = __hip_atomic_fetch_add(q.heads + 64 * xq, 1u, __ATOMIC_RELAXED, __HIP_MEMORY_SCOPE_AGENT);
        n = (unsigned)__builtin_amdgcn_readfirstlane((int)n);
        if (n < (unsigned)(nqs * 16)) { qs = (NQS / 8) * xq + (int)(n >> 4); hd = (int)(n & 15u); return true; }
        ++q.cur;
    }
}


__global__ void __launch_bounds__(NTHREADS) hybrid_fwd(Params p) {
    extern __shared__ __attribute__((aligned(16))) unsigned char lds_raw[];
    LAS unsigned char* lds = (LAS unsigned char*)lds_raw;
    cg::grid_group grid = cg::this_grid();
    bf16_t* hb = (bf16_t*)(p.ws + WS_HB);
    bf16_t* z = (bf16_t*)(p.ws + WS_Z);
    unsigned* barw = (unsigned*)(p.ws + WS_BAR);
    volatile LAS unsigned* bst = (volatile LAS unsigned*)(lds + LDS_MAIN);
    {
        const int tid = threadIdx.x, lane = tid & 63, wave = __builtin_amdgcn_readfirstlane(tid >> 6);
        const int G = gridDim.x, gw = blockIdx.x * NWAVES + wave, NGW = G * NWAVES;
        if (tid < 2) bst[tid] = 0u;
        if (blockIdx.x == 0) { for (int i = tid; i < XCD_BAR_WORDS; i += NTHREADS) barw[i] = 0u; for (int i = tid; i < 4 * 8 * 64; i += NTHREADS) ((unsigned*)(p.ws + WS_Q))[i] = 0u; }
        phase_p0(p, lds, gw, NGW, wave, lane);
    }
    grid.sync();
    const int wave_s = __builtin_amdgcn_readfirstlane(threadIdx.x >> 6);
    const XcdBarrier xb = xcd_barrier_post(barw, bst);
#define GSYNC() xcd_barrier(xb, wave_s)

#define PHASE_IDS() int lane = lane_id_fresh(); int wave = wave_s; asm volatile("" : "+s"(wave)); \
        int bid = blockIdx.x; asm volatile("" : "+s"(bid)); int G = gridDim.x; asm volatile("" : "+s"(G)); \
        const int tid = wave * 64 + lane, gw = bid * NWAVES + wave, NGW = G * NWAVES; (void)tid; (void)gw; (void)NGW
#pragma unroll 1
    for (int layer = 0; layer < DEPTH; ++layer) {
        const int j = layer >> 1;
        const bool isA = (layer & 1) == 0;
        {
            PHASE_IDS();
            const int N = isA ? NA : NB;
            const bf16_t* wt = isA ? (const bf16_t*)(p.ws + WS_W + j * WPAIR + WO_INA) : (const bf16_t*)(p.ws + WS_W + j * WPAIR + WO_INB);
            pg8::StaticOrder S; S.init(SEQ, N, G, bid);
            pg8::Gemm g{hb, wt, SEQ, N, D, D, 0};
            pg8::EpiBf16 E{z, 0, N / 256}; pg8::gemm_phase<pg8::EpiBf16>(lds, g, S, E, tid);
            meta_gemm<false>(hb + (size_t)SEQ * D, D, wt, N, z, 0, N / 256, lds, bid, G, wave, lane);
        }
        GSYNC();
        if (isA) {
            PHASE_IDS();
            LAS float* btab = (LAS float*)(lds + 8 * 14336);
            for (int idx = tid; idx < 32 * 129; idx += NTHREADS) {
                const int hd = idx / 129, d = idx % 129;
                int bucket = d;
                if (d >= 16) { bucket = 16 + (int)(logf((float)d * (1.0f / 16.0f)) / 2.0794415416798357f * 16.0f); bucket = bucket > 31 ? 31 : bucket; }
                btab[idx] = p.rel_bias[bucket * 32 + hd] * 1.4426950408889634f;
            }
            __syncthreads();
            LAS bf16_t* vs = (LAS bf16_t*)(lds + wave * 14336);
            const float* sinks = p.sinks_a + j * 32;
            AttnQueue aq{(unsigned*)(p.ws + WS_Q) + layer * 8 * 64, (int)(xb.x & 7u), 0}; int qs, hd;
            while (attn_next(aq, lane_id_fresh() == 0, qs, hd)) attnA_item(z, sinks, hd, qs == NQS ? -1 : qs, vs, btab, lane_id_fresh());
        } else {
            PHASE_IDS();
            LAS bf16_t* vs = (LAS bf16_t*)(lds + wave * (VS_BYTES + 8192));
            AttnQueue aq{(unsigned*)(p.ws + WS_Q) + layer * 8 * 64, (int)(xb.x & 7u), 0}; int qs, hd;
            while (attn_next(aq, lane_id_fresh() == 0, qs, hd)) attnB_item(z, hd, qs == NQS ? -1 : qs, vs, lane_id_fresh());
        }
        GSYNC();
        {
            PHASE_IDS();
            const int znt = isA ? NA / 256 : NB / 256;
            pg8::StaticOrder S; S.init(SEQ, D, G, bid);
            const bf16_t* wt = isA ? (const bf16_t*)(p.ws + WS_W + j * WPAIR + WO_OUTA) : (const bf16_t*)(p.ws + WS_W + j * WPAIR + WO_OUTB);
            pg8::Gemm g{z, wt, SEQ, D, D, 0, znt};
            pg8::EpiBf16 E{hb, D, 0}; pg8::gemm_phase<pg8::EpiBf16>(lds, g, S, E, tid);
            if (layer != DEPTH - 1) meta_gemm<true>(z, 0, wt, D, hb, D, znt, lds, bid, G, wave, lane);
        }
        GSYNC();
        {
            PHASE_IDS();
            phase_ln(p, layer, gw, NGW, lane);
        }
        if (layer != DEPTH - 1) GSYNC();
    }
}

extern "C" void kernel_launch(void* const* d_in, const int* in_sizes, int n_in, void* d_out, int out_size, void* d_ws, size_t ws_size, hipStream_t stream) {
    static int grid = 0;
    if (grid == 0) {
        if (n_in != 10 || out_size != SEQ * D || ws_size < WS_END) { fprintf(stderr, "kernel_launch: unexpected shapes (n_in %d out %d ws %zu, need %zu)\n", n_in, out_size, ws_size, (size_t)WS_END); grid = -1; return; }
        int dev = 0, cus = 0, per_cu = 0;
        hipGetDevice(&dev);
        hipDeviceGetAttribute(&cus, hipDeviceAttributeMultiprocessorCount, dev);
        if (hipFuncSetAttribute((const void*)hybrid_fwd, hipFuncAttributeMaxDynamicSharedMemorySize, LDS_BYTES) != hipSuccess) { fprintf(stderr, "kernel_launch: hipFuncSetAttribute failed\n"); grid = -1; return; }
        if (hipOccupancyMaxActiveBlocksPerMultiprocessor(&per_cu, (const void*)hybrid_fwd, NTHREADS, LDS_BYTES) != hipSuccess || per_cu < 1) { fprintf(stderr, "kernel_launch: occupancy query failed (%d)\n", per_cu); (void)hipGetLastError(); per_cu = 1; }
        grid = cus * 1;
    }
    if (grid < 0) return;
    Params p{};
    p.x = (const float*)d_in[0]; p.meta = (const float*)d_in[1]; p.rel_bias = (const float*)d_in[2]; p.w_in_a = (const float*)d_in[3]; p.sinks_a = (const float*)d_in[4];
    p.w_out_a = (const float*)d_in[5]; p.w_in_b = (const float*)d_in[6]; p.w_out_b = (const float*)d_in[7]; p.ln_g = (const float*)d_in[8]; p.ln_b = (const float*)d_in[9];
    p.out = (float*)d_out; p.ws = (unsigned char*)d_ws; p.probe = 1;
    void* args[] = {&p};
    hipError_t e = hipLaunchCooperativeKernel((const void*)hybrid_fwd, dim3(grid), dim3(NTHREADS), args, LDS_BYTES, stream);
    if (e != hipSuccess) fprintf(stderr, "kernel_launch: cooperative launch failed: %s (grid %d)\n", hipGetErrorString(e), grid);
}
```

```cpp
#include <hip/hip_runtime.h>
#include <hip/hip_cooperative_groups.h>
#include <cstdio>
namespace cg = cooperative_groups;

#define LAS __attribute__((address_space(3)))
#define DI __device__ __forceinline__
typedef unsigned short bf16_t;
typedef short bf16x8 __attribute__((ext_vector_type(8)));
typedef float f32x2 __attribute__((ext_vector_type(2)));
typedef float f32x4 __attribute__((ext_vector_type(4)));
typedef float f32x16 __attribute__((ext_vector_type(16)));
typedef unsigned u32x2 __attribute__((ext_vector_type(2)));
typedef unsigned u32x4 __attribute__((ext_vector_type(4)));
typedef __bf16 bf16v2 __attribute__((ext_vector_type(2)));

constexpr int D = 2048, SEQ = 16384, NMETA = 16, LTOK = SEQ + NMETA, MPAD = SEQ + 256;
constexpr int NA = 4608, NB = 8192, DEPTH = 4;
constexpr int NTHREADS = 512, NWAVES = 8;
constexpr int LDS_MAIN = 147456, LDS_BYTES = LDS_MAIN + 16;
constexpr float LN_EPS = 1e-5f;
constexpr float DN_ALPHA = 1.6817928305074290f;

constexpr size_t WS_W = 0;
constexpr size_t WPAIR = (size_t)(NA + D + NB + D) * D * 2;
constexpr size_t WO_INA = 0, WO_OUTA = (size_t)NA * D * 2, WO_INB = WO_OUTA + (size_t)D * D * 2, WO_OUTB = WO_INB + (size_t)NB * D * 2;
constexpr size_t WS_HB = WS_W + 2 * WPAIR;
constexpr size_t WS_Z = WS_HB + (size_t)MPAD * D * 2;
constexpr size_t WS_BAR = WS_Z + (size_t)MPAD * NB * 2;
static_assert((size_t)LTOK * D * 2 <= WPAIR, "the fp16 residual stream must fit in the first layer pair's weight region");
constexpr size_t WS_Q = WS_BAR + 16384;
constexpr size_t WS_END = WS_Q + 4 * 8 * 256;

DI unsigned pk2(float a, float b) { f32x2 v = {a, b}; bf16v2 r = __builtin_convertvector(v, bf16v2); return __builtin_bit_cast(unsigned, r); }
typedef _Float16 h16v2 __attribute__((ext_vector_type(2)));
DI unsigned pkh2(float a, float b) { f32x2 v = {a, b}; h16v2 r = __builtin_convertvector(v, h16v2); return __builtin_bit_cast(unsigned, r); }
DI float h_lo(unsigned u) { return (float)__builtin_bit_cast(h16v2, u)[0]; }
DI float h_hi(unsigned u) { return (float)__builtin_bit_cast(h16v2, u)[1]; }
DI float bf_lo(unsigned u) { return __uint_as_float(u << 16); }
DI float bf_hi(unsigned u) { return __uint_as_float(u & 0xffff0000u); }
DI float shflx(float v, int mask, int lane) { return __int_as_float(__builtin_amdgcn_ds_bpermute((lane ^ mask) << 2, __float_as_int(v))); }
DI int lane_id_fresh() { unsigned zero; asm volatile("v_mov_b32 %0, 0" : "=v"(zero)); return (int)__builtin_amdgcn_mbcnt_hi(~0u, __builtin_amdgcn_mbcnt_lo(~0u, zero)); }
DI float wave_sum(float v, int lane) {
#pragma unroll
    for (int o = 1; o < 64; o <<= 1) v += shflx(v, o, lane);
    return v;
}


DI size_t zrowU(int row0, int NT) { return ((size_t)((row0 >> 8) * NT) << 16) + (size_t)((((row0 >> 7) & 1) << 15) | (((row0 >> 5) & 1) << 14) | (((row0 >> 6) & 1) << 11)); }
DI unsigned zlaneRC(int r5, int col) { return (unsigned)(((col >> 8) << 16) | ((r5 >> 4) << 13) | (((col >> 7) & 1) << 12) | (((col >> 5) & 3) << 9) | (((col >> 3) & 3) << 7) | ((r5 & 15) << 3) | (col & 7)); }

namespace pg8 {
constexpr int BM = 256, BK = 64, HALF = 128, HTB = HALF * BK * 2, NXCD = 8, WGM = 8;
DI int lds_byte(int r, int c) { const int st = (r >> 4) * 2 + (c >> 5), rr = r & 15, cc = c & 31, ob = rr * 64 + cc * 2; return st * 1024 + (ob ^ (((ob >> 9) & 1) << 5)); }
DI void stage_rc(int b, int& R, int& C) { const int st = b / 1024, sb = b % 1024, swz = sb ^ (((sb >> 9) & 1) << 5); R = (st >> 1) * 16 + swz / 64; C = (st & 1) * 32 + (swz % 64) / 2; }
DI int perm32(int rho) { const int n = rho >> 4, i = rho & 15; return 8 * (i >> 2) + 4 * n + (i & 3); }

struct Unit { int pm, pn; };
struct Gemm { const bf16_t* A; const bf16_t* Bt; int M, N, K, lda; int ant; };

struct StaticOrder {
    int nM, nN, nwg, G, c;
    DI void init(int M, int N, int G_, int c_) { nM = M / BM; nN = N / BM; nwg = nM * nN; G = G_; c = c_; }
    DI bool next(int i, Unit& u) const {
        const long L = (long)i * G + c; if (L >= nwg) return false;
        int wgid = (int)L; { const int q = nwg / NXCD, r = nwg % NXCD, xcd = wgid % NXCD, off = wgid / NXCD; wgid = (xcd < r ? xcd * (q + 1) : r * (q + 1) + (xcd - r) * q) + off; }
        const int nig = WGM * nN, gid = wgid / nig, fm = gid * WGM, gsz = (nM - fm) < WGM ? (nM - fm) : WGM;
        u.pm = fm + ((wgid % nig) % gsz); u.pn = (wgid % nig) / gsz; return true;
    }
};

struct EpiBf16 {
    static constexpr bool PERM = true;
    bf16_t* O; int ldc; int nt;
    DI void operator()(const f32x4 (&acc)[2][2][4][2], const Unit& u, int wr, int wc, int fr, int fq) const {
        if (nt) {
            unsigned char* tb = (unsigned char*)O + ((size_t)(u.pm * nt + u.pn) << 17) + (wr * 4 + wc) * 1024 + (fq * 16 + fr) * 16;
#pragma unroll
            for (int ai = 0; ai < 2; ++ai)
#pragma unroll
                for (int m = 0; m < 4; ++m)
#pragma unroll
                    for (int bj = 0; bj < 2; ++bj) { const f32x4 v0 = acc[ai][bj][m][0], v1 = acc[ai][bj][m][1];
                        u32x4 w; w.x = pk2(v0[0], v0[1]); w.y = pk2(v0[2], v0[3]); w.z = pk2(v1[0], v1[1]); w.w = pk2(v1[2], v1[3]);
                        *(u32x4*)(tb + ((ai * 4 + m) * 2 + bj) * 8192) = w; }
            return;
        }
        const int row0 = u.pm * BM + wr * 64 + fr; const int col0 = u.pn * BM + wc * 32 + 8 * fq;
#pragma unroll
        for (int ai = 0; ai < 2; ++ai)
#pragma unroll
            for (int m = 0; m < 4; ++m) { bf16_t* rowp = O + (size_t)(row0 + ai * HALF + m * 16) * ldc + col0;
#pragma unroll
                for (int bj = 0; bj < 2; ++bj) { const f32x4 v0 = acc[ai][bj][m][0], v1 = acc[ai][bj][m][1];
                    u32x4 w; w.x = pk2(v0[0], v0[1]); w.y = pk2(v0[2], v0[3]); w.z = pk2(v1[0], v1[1]); w.w = pk2(v1[2], v1[3]);
                    *(u32x4*)(rowp + bj * HALF) = w; } }
    }
};

template <class Epi>
DI void gemm_phase(LAS unsigned char* lds, const Gemm g, const StaticOrder& S, const Epi& E, const int tid) {
    const int wid = __builtin_amdgcn_readfirstlane(tid >> 6), lane = tid & 63, wr = wid >> 2, wc = wid & 3, fr = lane & 15, fq = lane >> 4;
    const int K = g.K, nt = K / BK, lda = g.lda;
    unsigned voffA[2], voffB[2];
#pragma unroll
    for (int i = 0; i < 2; ++i) { int R, C; stage_rc(tid * 16 + i * 8192, R, C); const int Rb = Epi::PERM ? ((R & ~31) + perm32(R & 31)) : R;
        voffA[i] = g.ant ? (unsigned)((((R >> 4) & 3) << 14) | (((R >> 6) & 1) << 12) | (((C >> 5) & 1) << 10) | (((C >> 3) & 3) << 8) | ((R & 15) << 4)) : (unsigned)(R * lda + C) * 2u;
        voffB[i] = (unsigned)(Rb * K + C) * 2u; }
    const size_t kstep = (size_t)(BK * 2);
    const size_t hstepA = g.ant ? (size_t)65536 : (size_t)HALF * lda * 2, hstepB = (size_t)HALF * K * 2;
    const size_t tstepA = g.ant ? (size_t)g.ant * 131072 : 2 * hstepA, tstepB = 2 * hstepB;
#define PG8_KTA(t) (g.ant ? ((size_t)((t) >> 2) * 131072 + (size_t)((((t) >> 1) & 1) * 8192 + ((t) & 1) * 2048)) : (size_t)(t) * kstep)
    const unsigned ldsw = (unsigned)wid * 1024u;
    const int aoff = lds_byte(wr * 64 + fr, fq * 8), boff = lds_byte(wc * 32 + fr, fq * 8);
#define PG8_SA(b, h) (((b) * 2 + (h)) * HTB)
#define PG8_SB(b, h) ((4 + (b) * 2 + (h)) * HTB)
#define PG8_STAGE(bufoff, gbase, voff) do { _Pragma("unroll") for (int _i = 0; _i < 2; ++_i) \
        __builtin_amdgcn_global_load_lds((const unsigned*)((const char*)(gbase) + (voff)[_i]), (LAS unsigned*)(lds + (bufoff) + ldsw + _i * 8192), 16, 0, 0); } while (0)
#define PG8_LDA(dst, b, h) do { _Pragma("unroll") for (int m = 0; m < 4; ++m) _Pragma("unroll") for (int k = 0; k < 2; ++k) dst[m][k] = *(const LAS bf16x8*)(lds + PG8_SA(b, h) + aoff + m * 2048 + k * 1024); } while (0)
#define PG8_LDB(dst, b, h) do { _Pragma("unroll") for (int n = 0; n < 2; ++n) _Pragma("unroll") for (int k = 0; k < 2; ++k) dst[n][k] = *(const LAS bf16x8*)(lds + PG8_SB(b, h) + boff + n * 2048 + k * 1024); } while (0)
#define PG8_MMA(ai, bj, At, Bt) do { __builtin_amdgcn_s_setprio(1); _Pragma("unroll") for (int m = 0; m < 4; ++m) _Pragma("unroll") for (int n = 0; n < 2; ++n) _Pragma("unroll") for (int k = 0; k < 2; ++k) \
        acc[ai][bj][m][n] = __builtin_amdgcn_mfma_f32_16x16x32_bf16(Bt[n][k], At[m][k], acc[ai][bj][m][n], 0, 0, 0); __builtin_amdgcn_s_setprio(0); } while (0)
#define PG8_WAIT_V(n) asm volatile("s_waitcnt vmcnt(" #n ")" ::: "memory")
#define PG8_WAIT_L(n) asm volatile("s_waitcnt lgkmcnt(" #n ")" ::: "memory")
#define PG8_BAR __builtin_amdgcn_s_barrier()
#define PG8_SCHED __builtin_amdgcn_sched_barrier(0)
    Unit cur, nxt; int ui = 0;
    if (!S.next(0, cur)) return;
    f32x4 acc[2][2][4][2];
#pragma unroll
    for (int a = 0; a < 2; ++a)
#pragma unroll
        for (int b = 0; b < 2; ++b)
#pragma unroll
            for (int m = 0; m < 4; ++m)
#pragma unroll
                for (int n = 0; n < 2; ++n) acc[a][b][m][n] = (f32x4){0.f, 0.f, 0.f, 0.f};
    bf16x8 At[4][2], B0[2][2], B1[2][2];
    const char* cA = (const char*)g.A + (size_t)cur.pm * tstepA; const char* cB = (const char*)g.Bt + (size_t)cur.pn * tstepB;
    PG8_STAGE(PG8_SB(0, 0), cB, voffB); PG8_STAGE(PG8_SA(0, 0), cA, voffA); PG8_STAGE(PG8_SB(0, 1), cB + hstepB, voffB); PG8_STAGE(PG8_SA(0, 1), cA + hstepA, voffA);
    if (wr == 1) PG8_BAR;
    PG8_WAIT_V(4); PG8_BAR;
    PG8_STAGE(PG8_SB(1, 0), cB + kstep, voffB); PG8_STAGE(PG8_SA(1, 0), cA + PG8_KTA(1), voffA); PG8_STAGE(PG8_SB(1, 1), cB + hstepB + kstep, voffB);
    PG8_WAIT_V(6); PG8_BAR;
    for (;;) {
        const bool has_next = S.next(ui + 1, nxt);
        const char* nA = has_next ? (const char*)g.A + (size_t)nxt.pm * tstepA : cA; const char* nB = has_next ? (const char*)g.Bt + (size_t)nxt.pn * tstepB : cB;
        for (int t = 0; t < nt; t += 2) {
            const bool last = (t == nt - 2);
            const char* a1 = cA + PG8_KTA(t + 1);
            const char* a2 = last ? nA : cA + PG8_KTA(t + 2); const char* b2 = last ? nB : cB + (size_t)(t + 2) * kstep;
            const char* a3 = last ? nA + PG8_KTA(1) : cA + PG8_KTA(t + 3); const char* b3 = b2 + kstep;
            PG8_LDB(B0, 0, 0); PG8_SCHED; PG8_LDA(At, 0, 0); PG8_STAGE(PG8_SA(1, 1), a1 + hstepA, voffA);
            PG8_WAIT_L(8); PG8_BAR; PG8_WAIT_L(0); PG8_MMA(0, 0, At, B0); PG8_BAR; PG8_SCHED;
            PG8_LDB(B1, 0, 1); PG8_STAGE(PG8_SB(0, 0), b2, voffB);
            PG8_BAR; PG8_WAIT_L(0); PG8_MMA(0, 1, At, B1); PG8_BAR;
            PG8_LDA(At, 0, 1); PG8_STAGE(PG8_SA(0, 0), a2, voffA);
            PG8_BAR; PG8_WAIT_L(0); PG8_MMA(1, 0, At, B0); PG8_BAR; PG8_SCHED;
            PG8_STAGE(PG8_SB(0, 1), b2 + hstepB, voffB);
            PG8_WAIT_V(6); PG8_BAR; PG8_MMA(1, 1, At, B1); PG8_BAR;
            PG8_LDB(B0, 1, 0); PG8_SCHED; PG8_LDA(At, 1, 0); PG8_STAGE(PG8_SA(0, 1), a2 + hstepA, voffA);
            PG8_WAIT_L(8); PG8_BAR; PG8_WAIT_L(0); PG8_MMA(0, 0, At, B0); PG8_BAR; PG8_SCHED;
            PG8_LDB(B1, 1, 1); PG8_STAGE(PG8_SB(1, 0), b3, voffB);
            PG8_BAR; PG8_WAIT_L(0); PG8_MMA(0, 1, At, B1); PG8_BAR;
            PG8_LDA(At, 1, 1); PG8_STAGE(PG8_SA(1, 0), a3, voffA);
            PG8_BAR; PG8_WAIT_L(0); PG8_MMA(1, 0, At, B0); PG8_BAR; PG8_SCHED;
            PG8_STAGE(PG8_SB(1, 1), b3 + hstepB, voffB);
            PG8_WAIT_V(6); PG8_BAR; PG8_MMA(1, 1, At, B1); PG8_BAR;
        }
        E(acc, cur, wr, wc, fr, fq);
        if (!has_next) break;
#pragma unroll
        for (int a = 0; a < 2; ++a)
#pragma unroll
            for (int b = 0; b < 2; ++b)
#pragma unroll
                for (int m = 0; m < 4; ++m)
#pragma unroll
                    for (int n = 0; n < 2; ++n) acc[a][b][m][n] = (f32x4){0.f, 0.f, 0.f, 0.f};
        cur = nxt; cA = nA; cB = nB; ++ui;
    }
    PG8_WAIT_V(0);
    if (wr == 0) PG8_BAR;
    PG8_BAR;
#undef PG8_KTA
#undef PG8_SA
#undef PG8_SB
#undef PG8_STAGE
#undef PG8_LDA
#undef PG8_LDB
#undef PG8_MMA
#undef PG8_WAIT_V
#undef PG8_WAIT_L
#undef PG8_BAR
#undef PG8_SCHED
}
}


#define XB_TMO      128
#define XB_XCNT(j)  (256  + 64 * (j))
#define XB_XSUB(j)  (1280 + 64 * (j))
#define XB_XGEN(j)  (2304 + 64 * (j))
#define XB_TOP      3328
#define XB_TOPGEN   3392
#define XCD_BAR_WORDS 3456
#define XB_SPIN_CAP (1u << 22)
DI unsigned xb_ld(unsigned* p)              { return __hip_atomic_load(p, __ATOMIC_RELAXED, __HIP_MEMORY_SCOPE_AGENT); }
DI unsigned xb_add(unsigned* p, unsigned v) { return __hip_atomic_fetch_add(p, v, __ATOMIC_RELAXED, __HIP_MEMORY_SCOPE_AGENT); }
DI unsigned xb_xcc_id() { return (unsigned)__builtin_amdgcn_s_getreg((3 << 11) | 20) & 0xFu; }
#define XB_SPIN(cond, bar) do { unsigned _sp = 0; while (cond) { __builtin_amdgcn_s_sleep(1); \
    if ((++_sp & 255u) == 0u) { if (xb_ld(&(bar)[XB_TMO])) break; if (_sp > XB_SPIN_CAP) { atomicAdd(&(bar)[XB_TMO], 1u); break; } } } } while (0)
struct XcdBarrier { unsigned* bar; unsigned x; volatile LAS unsigned* st; };
DI XcdBarrier xcd_barrier_post(unsigned* bar, volatile LAS unsigned* st) {
    XcdBarrier b; b.bar = bar; b.x = xb_xcc_id(); b.st = st;
    if (threadIdx.x == 0) (void)xb_add(&bar[XB_XCNT(b.x)], 1u);
    return b;
}
DI void xcd_barrier_complete(unsigned* bar, unsigned x, unsigned& nloc, unsigned& nx) {
    const unsigned G = gridDim.x;
    unsigned sum, cnt, mine, sp = 0u;
    for (;;) {
        sum = 0u; cnt = 0u; mine = 0u;
#pragma unroll
        for (unsigned j = 0; j < 16; ++j) { const unsigned c = xb_ld(&bar[XB_XCNT(j)]); sum += c; cnt += (c > 0u) ? 1u : 0u; mine = (j == x) ? c : mine; }
        if (sum == G) break;
        __builtin_amdgcn_s_sleep(1);
        if ((++sp & 255u) == 0u) { if (xb_ld(&bar[XB_TMO])) break; if (sp > XB_SPIN_CAP) { atomicAdd(&bar[XB_TMO], 1u); break; } }
    }
    nloc = mine > 0u ? mine : 1u; nx = cnt > 0u ? cnt : 1u;
}
DI void xcd_barrier(const XcdBarrier& b, int wave_s) {
    asm volatile("s_waitcnt vmcnt(0)" ::: "memory");
    __syncthreads();
    if (wave_s == 0 && lane_id_fresh() == 0) {
        unsigned* bar = b.bar;
        __builtin_amdgcn_s_waitcnt(0);
        unsigned nloc = b.st[0], nx = b.st[1];
        if (nloc == 0u) { xcd_barrier_complete(bar, b.x, nloc, nx); b.st[0] = nloc; b.st[1] = nx; }
        const unsigned old = xb_add(&bar[XB_XSUB(b.x)], 1u);
        const unsigned gen = old / nloc;
        if (old + 1u == (gen + 1u) * nloc) {
            __builtin_amdgcn_fence(__ATOMIC_RELEASE, "agent");
            asm volatile("s_waitcnt vmcnt(0)" ::: "memory");
            const unsigned og = xb_add(&bar[XB_TOP], 1u);
            const unsigned tg = og / nx;
            if (og + 1u == (tg + 1u) * nx) xb_add(&bar[XB_TOPGEN], 1u);
            else XB_SPIN(xb_ld(&bar[XB_TOPGEN]) == tg, bar);
            __builtin_amdgcn_fence(__ATOMIC_ACQUIRE, "agent");
            xb_add(&bar[XB_XGEN(b.x)], 1u);
            asm volatile("s_waitcnt vmcnt(0)" ::: "memory");
        } else {
            XB_SPIN(xb_ld(&bar[XB_XGEN(b.x)]) == gen, bar);
            __builtin_amdgcn_fence(__ATOMIC_ACQUIRE, "agent");
            asm volatile("s_waitcnt vmcnt(0)" ::: "memory");
        }
    }
    __syncthreads();
}

template <bool TILED_IN>
DI void meta_gemm(const bf16_t* am, int lda, const bf16_t* Wt, int N, bf16_t* zo, int ldzo, int nt, LAS unsigned char* lds, int bid, int G, int wave, int lane) {
    const int ntasks = N / 16, r = lane & 15, q = lane >> 4, kq = wave & 3;
    LAS f32x4* part = (LAS f32x4*)lds;
    for (int t0 = 2 * (G - 1 - bid); t0 < ntasks; t0 += 2 * G) {
        const int task = t0 + (wave >> 2), n0 = task * 16;
        const bf16_t* ap = Wt + (size_t)(n0 + r) * D + 8 * q + 512 * kq;
        const bf16_t* bp = TILED_IN ? am + zrowU(SEQ, nt) + zlaneRC(r, 512 * kq + 8 * q) : am + (size_t)r * lda + 8 * q + 512 * kq;
        f32x4 acc = {0.f, 0.f, 0.f, 0.f};
        if (task < ntasks) {
#pragma unroll
            for (int k = 0; k < 16; ++k) { const bf16x8 a = *(const bf16x8*)(ap + 32 * k);
                const bf16x8 b = *(const bf16x8*)(bp + (TILED_IN ? (((k >> 3) << 16) | (((k >> 2) & 1) << 12) | ((k & 3) << 9)) : 32 * k));
                acc = __builtin_amdgcn_mfma_f32_16x16x32_bf16(a, b, acc, 0, 0, 0); }
        }
        part[wave * 64 + lane] = acc;
        __syncthreads();
        if (kq == 0 && task < ntasks) {
            const f32x4 t = (part[wave * 64 + lane] + part[(wave + 1) * 64 + lane]) + (part[(wave + 2) * 64 + lane] + part[(wave + 3) * 64 + lane]);
            u32x2 w; w.x = pk2(t[0], t[1]); w.y = pk2(t[2], t[3]);
            if (TILED_IN) *(u32x2*)(zo + (size_t)(SEQ + r) * ldzo + n0 + 4 * q) = w;
            else *(u32x2*)(zo + zrowU(SEQ, nt) + zlaneRC(r, n0 + 4 * q)) = w;
        }
        __syncthreads();
    }
}

DI void p0_transpose_item(const float* W, int K, int N, bf16_t* WT, LAS float* scr, int item, int lane) {
    const int nblk = N / 32, kb = item / nblk, nb = item % nblk, k0 = 128 * kb, n0 = 32 * nb;
    const int n4 = lane & 7, kr = lane >> 3;
    f32x4 v[16];
#pragma unroll
    for (int i = 0; i < 16; ++i) v[i] = *(const f32x4*)(W + (size_t)(k0 + kr + 8 * i) * N + n0 + 4 * n4);
#pragma unroll
    for (int i = 0; i < 16; ++i) { LAS float* d = scr + (kr + 8 * i) * 33 + 4 * n4; d[0] = v[i][0]; d[1] = v[i][1]; d[2] = v[i][2]; d[3] = v[i][3]; }
    asm volatile("s_waitcnt lgkmcnt(0)" ::: "memory");
    const int c = lane & 15;
#pragma unroll
    for (int j = 0; j < 8; ++j) { const int n = (lane >> 4) + 4 * j; const LAS float* s = scr + (8 * c) * 33 + n;
        u32x4 o; o.x = pk2(s[0 * 33], s[1 * 33]); o.y = pk2(s[2 * 33], s[3 * 33]); o.z = pk2(s[4 * 33], s[5 * 33]); o.w = pk2(s[6 * 33], s[7 * 33]);
        *(u32x4*)(WT + (size_t)(n0 + n) * K + k0 + 8 * c) = o; }
    asm volatile("s_waitcnt lgkmcnt(0)" ::: "memory");
}

struct Params {
    const float* x; const float* meta; const float* rel_bias; const float* w_in_a; const float* sinks_a; const float* w_out_a;
    const float* w_in_b; const float* w_out_b; const float* ln_g; const float* ln_b;
    float* out; unsigned char* ws; int probe; int pad;
};


DI void phase_p0(const Params& p, LAS unsigned char* lds, int gw, int NGW, int wave, int lane) {
    LAS float* scr = (LAS float*)(lds + wave * 16896);
    constexpr int I_INA = (D / 128) * (NA / 32), I_OUT = (D / 128) * (D / 32), I_INB = (D / 128) * (NB / 32);
    constexpr int NITEMS = 2 * (I_INA + I_OUT + I_INB + I_OUT);
    for (int it = gw; it < NITEMS; it += NGW) {
        int r = it;
        if (r < 2 * I_INA) { const int j = r / I_INA; p0_transpose_item(p.w_in_a + (size_t)j * D * NA, D, NA, (bf16_t*)(p.ws + WS_W + j * WPAIR + WO_INA), scr, r % I_INA, lane); continue; } r -= 2 * I_INA;
        if (r < 2 * I_OUT) { const int j = r / I_OUT; p0_transpose_item(p.w_out_a + (size_t)j * D * D, D, D, (bf16_t*)(p.ws + WS_W + j * WPAIR + WO_OUTA), scr, r % I_OUT, lane); continue; } r -= 2 * I_OUT;
        if (r < 2 * I_INB) { const int j = r / I_INB; p0_transpose_item(p.w_in_b + (size_t)j * D * NB, D, NB, (bf16_t*)(p.ws + WS_W + j * WPAIR + WO_INB), scr, r % I_INB, lane); continue; } r -= 2 * I_INB;
        { const int j = r / I_OUT; p0_transpose_item(p.w_out_b + (size_t)j * D * D, D, D, (bf16_t*)(p.ws + WS_W + j * WPAIR + WO_OUTB), scr, r % I_OUT, lane); }
    }
    bf16_t* hb = (bf16_t*)(p.ws + WS_HB);
    { unsigned char* zb = p.ws + WS_Z;
      for (size_t i = (size_t)(gw * 64 + lane) * 16; i < (size_t)(18 + 32) << 17; i += (size_t)NGW * 64 * 16) {
          unsigned char* dst = i < ((size_t)18 << 17) ? zb + ((size_t)(64 * 18) << 17) + i : zb + ((size_t)(64 * 32) << 17) + (i - ((size_t)18 << 17));
          *(u32x4*)dst = (u32x4){0u, 0u, 0u, 0u}; } }
    for (int r0 = gw; r0 < LTOK; r0 += 2 * NGW) {
        f32x4 v[2][8];
#pragma unroll
        for (int q = 0; q < 2; ++q) { const int r = r0 + q * NGW < LTOK ? r0 + q * NGW : r0;
            const f32x4* src = (const f32x4*)(r < SEQ ? p.x + (size_t)r * D : p.meta + (size_t)(r - SEQ) * D) + 2 * lane;
#pragma unroll
            for (int j = 0; j < 4; ++j) { v[q][2 * j] = src[128 * j]; v[q][2 * j + 1] = src[128 * j + 1]; } }
#pragma unroll
        for (int q = 0; q < 2; ++q) { const int r = r0 + q * NGW; if (r >= LTOK) break;
            u32x4* ob = (u32x4*)(hb + (size_t)r * D) + lane;
#pragma unroll
            for (int j = 0; j < 4; ++j) { const f32x4 a0 = v[q][2 * j], a1 = v[q][2 * j + 1]; u32x4 w; w.x = pk2(a0[0], a0[1]); w.y = pk2(a0[2], a0[3]); w.z = pk2(a1[0], a1[1]); w.w = pk2(a1[2], a1[3]); ob[64 * j] = w; } }
    }
}

DI void phase_ln(const Params& p, int layer, int gw, int NGW, int lane) {
    const float* g = p.ln_g + (size_t)layer * D; const float* b = p.ln_b + (size_t)layer * D;
    bf16_t* hb = (bf16_t*)(p.ws + WS_HB);
    const bool last = layer == DEPTH - 1;
    const int nrows = last ? SEQ : LTOK;
    const unsigned short* h16in = layer == DEPTH - 1 ? (const unsigned short*)(p.ws + WS_W) : (const unsigned short*)p.out;
    unsigned short* h16out = layer == DEPTH - 2 ? (unsigned short*)(p.ws + WS_W) : (unsigned short*)p.out;
    constexpr int R = 2;
    for (int r0 = gw; r0 < nrows; r0 += R * NGW) {
        int rr[R]; bool ok[R];
#pragma unroll
        for (int q = 0; q < R; ++q) { ok[q] = r0 + q * NGW < nrows; rr[q] = ok[q] ? r0 + q * NGW : r0; }
        float v[R][32]; float s1[R], s2[R];
#pragma unroll
        for (int q = 0; q < R; ++q) {
            const u32x4* yb = (const u32x4*)(hb + (size_t)rr[q] * D) + lane;
            u32x4 yv[4];
#pragma unroll
            for (int j = 0; j < 4; ++j) yv[j] = yb[64 * j];
            if (layer == 0) {
                const f32x4* src32 = (const f32x4*)(rr[q] < SEQ ? p.x + (size_t)rr[q] * D : p.meta + (size_t)(rr[q] - SEQ) * D) + 2 * lane;
#pragma unroll
                for (int j = 0; j < 4; ++j) { const f32x4 a0 = src32[128 * j], a1 = src32[128 * j + 1];
                    v[q][8 * j + 0] = a0[0]; v[q][8 * j + 1] = a0[1]; v[q][8 * j + 2] = a0[2]; v[q][8 * j + 3] = a0[3];
                    v[q][8 * j + 4] = a1[0]; v[q][8 * j + 5] = a1[1]; v[q][8 * j + 6] = a1[2]; v[q][8 * j + 7] = a1[3]; }
            } else {
                const u32x4* src16 = (const u32x4*)(h16in + (size_t)rr[q] * D) + lane;
#pragma unroll
                for (int j = 0; j < 4; ++j) { const u32x4 hh = src16[64 * j];
                    v[q][8 * j + 0] = h_lo(hh.x); v[q][8 * j + 1] = h_hi(hh.x); v[q][8 * j + 2] = h_lo(hh.y); v[q][8 * j + 3] = h_hi(hh.y);
                    v[q][8 * j + 4] = h_lo(hh.z); v[q][8 * j + 5] = h_hi(hh.z); v[q][8 * j + 6] = h_lo(hh.w); v[q][8 * j + 7] = h_hi(hh.w); }
            }
            float a1 = 0.f, a2 = 0.f;
#pragma unroll
            for (int j = 0; j < 4; ++j) { const unsigned yw[4] = {yv[j].x, yv[j].y, yv[j].z, yv[j].w};
#pragma unroll
                for (int e = 0; e < 4; ++e) { const float u0 = v[q][8 * j + 2 * e] * DN_ALPHA + bf_lo(yw[e]), u1 = v[q][8 * j + 2 * e + 1] * DN_ALPHA + bf_hi(yw[e]);
                    v[q][8 * j + 2 * e] = u0; v[q][8 * j + 2 * e + 1] = u1; a1 += u0 + u1; a2 += u0 * u0 + u1 * u1; } }
            s1[q] = a1; s2[q] = a2;
        }
#pragma unroll
        for (int o = 1; o < 64; o <<= 1)
#pragma unroll
            for (int q = 0; q < R; ++q) { s1[q] += shflx(s1[q], o, lane); s2[q] += shflx(s2[q], o, lane); }
        float mean[R], rstd[R];
#pragma unroll
        for (int q = 0; q < R; ++q) { mean[q] = s1[q] * (1.f / D); const float var = fmaxf(s2[q] * (1.f / D) - mean[q] * mean[q], 0.f); rstd[q] = 1.0f / sqrtf(var + LN_EPS); }
#pragma unroll
        for (int j = 0; j < 4; ++j) {
            const f32x4 g0 = ((const f32x4*)g)[128 * j + 2 * lane], g1 = ((const f32x4*)g)[128 * j + 2 * lane + 1], b0 = ((const f32x4*)b)[128 * j + 2 * lane], b1 = ((const f32x4*)b)[128 * j + 2 * lane + 1];
            const float gg[8] = {g0[0], g0[1], g0[2], g0[3], g1[0], g1[1], g1[2], g1[3]}, bb[8] = {b0[0], b0[1], b0[2], b0[3], b1[0], b1[1], b1[2], b1[3]};
#pragma unroll
            for (int q = 0; q < R; ++q) { if (!ok[q]) continue;
                float y[8];
#pragma unroll
                for (int e = 0; e < 8; ++e) y[e] = (v[q][8 * j + e] - mean[q]) * rstd[q] * gg[e] + bb[e];
                if (last) { f32x4* o = (f32x4*)(p.out + (size_t)rr[q] * D) + 128 * j + 2 * lane; o[0] = (f32x4){y[0], y[1], y[2], y[3]}; o[1] = (f32x4){y[4], y[5], y[6], y[7]}; }
                else { u32x4 hw; hw.x = pkh2(y[0], y[1]); hw.y = pkh2(y[2], y[3]); hw.z = pkh2(y[4], y[5]); hw.w = pkh2(y[6], y[7]);
                       ((u32x4*)(h16out + (size_t)rr[q] * D) + lane)[64 * j] = hw;
                       u32x4 w; w.x = pk2(y[0], y[1]); w.y = pk2(y[2], y[3]); w.z = pk2(y[4], y[5]); w.w = pk2(y[6], y[7]);
                       ((u32x4*)(hb + (size_t)rr[q] * D) + lane)[64 * j] = w; } }
        }
    }
}

#define MFMA32(a, b, c) __builtin_amdgcn_mfma_f32_32x32x16_bf16((a), (b), (c), 0, 0, 0)
DI float silu_mul(float o, float g) { return o * g * __builtin_amdgcn_rcpf(1.0f + __builtin_amdgcn_exp2f(g * -1.4426950408889634f)); }

typedef short s16x4 __attribute__((ext_vector_type(4)));
DI bf16x8 tr_frag(const LAS bf16_t* lo, const LAS bf16_t* hi) {
    const s16x4 a = __builtin_amdgcn_ds_read_tr16_b64_v4i16((LAS s16x4*)lo), b = __builtin_amdgcn_ds_read_tr16_b64_v4i16((LAS s16x4*)hi);
    return __builtin_shufflevector(a, b, 0, 1, 2, 3, 4, 5, 6, 7);
}
constexpr int PB = 160, PA = 96;
constexpr int VS_BYTES = 32 * PB * 2;

template <bool MASKED>
DI void attnB_tile_math(const f32x16& S, int kpos0, int kvalid, int qpos, int h, int lane, float& later, unsigned (&pw)[8]) {
    const float scale2 = 0.08838834764831845f * 1.4426950408889634f;
    float x2[16], sp[16];
#pragma unroll
    for (int r = 0; r < 16; ++r) {
        const float x = S[r] * scale2; x2[r] = x;
        const float e = __builtin_amdgcn_exp2f(-fabsf(x));
        const float v = fmaxf(x, 0.f) + __builtin_amdgcn_logf(1.0f + e);
        if (MASKED) { const int row = (r & 3) + 8 * (r >> 2) + 4 * h; const bool vis = (row < kvalid) && (kpos0 + row < qpos); sp[r] = vis ? v : 0.f; }
        else sp[r] = v;
    }
    float G[4], P[4];
#pragma unroll
    for (int g = 0; g < 4; ++g) { G[g] = (sp[4 * g] + sp[4 * g + 1]) + (sp[4 * g + 2] + sp[4 * g + 3]); P[g] = shflx(G[g], 32, lane); }
    float R[4]; R[3] = 0.f; R[2] = G[3] + P[3]; R[1] = R[2] + (G[2] + P[2]); R[0] = R[1] + (G[1] + P[1]);
    const float total = R[0] + (G[0] + P[0]);
#pragma unroll
    for (int g = 0; g < 4; ++g) {
        float sfx = later + R[g] + (h == 0 ? P[g] : 0.f); float wv[4];
#pragma unroll
        for (int i = 3; i >= 0; --i) {
            const int r = 4 * g + i;
            sfx += sp[r];
            float t = __builtin_amdgcn_exp2f(x2[r] - sfx);
            if (MASKED) { const int row = (r & 3) + 8 * (r >> 2) + 4 * h; const bool vis = (row < kvalid) && (kpos0 + row < qpos); t = vis ? t : 0.f; }
            wv[i] = t;
        }
        pw[2 * g] = pk2(wv[0], wv[1]); pw[2 * g + 1] = pk2(wv[2], wv[3]);
    }
    later += total;
}

DI void attnB_item(bf16_t* z, int hh, int qs, LAS bf16_t* vs, int lane) {
    const int c = lane & 31, h = lane >> 5;
    const bool metaq = qs < 0;
    const int qrow = metaq ? SEQ + c : 32 * qs + c;
    const int qpos = metaq ? (c < NMETA ? c : 0) : NMETA + 32 * qs + c;
    const int trb = (4 * h + ((lane & 15) >> 2)) * PB + 16 * ((lane >> 4) & 1) + 4 * (lane & 3);
    const int qrow0 = metaq ? SEQ : 32 * qs;
    LAS bf16x8* qs_lds = (LAS bf16x8*)(vs + 32 * PB) + lane;
    { const bf16_t* qp = z + zrowU(qrow0, 32) + zlaneRC(c, hh * 128 + 8 * h);
      bf16x8 qf[8];
#pragma unroll
      for (int s = 0; s < 8; ++s) qf[s] = *(const bf16x8*)(qp + (((s >> 1) << 9) | ((s & 1) << 8)));
      asm volatile("s_waitcnt lgkmcnt(0)" ::: "memory");
#pragma unroll
      for (int s = 0; s < 8; ++s) qs_lds[64 * s] = qf[s]; }
    f32x16 acc[4];
#pragma unroll
    for (int dt = 0; dt < 4; ++dt)
#pragma unroll
        for (int i = 0; i < 16; ++i) acc[dt][i] = 0.f;
    float later = 0.f;
    int t = metaq ? -1 : qs;
    const int tfirst = t;
    const bf16_t* kbase = z + zlaneRC(c, 2048 + hh * 128 + 8 * h);
    const bf16_t* vbase = z + zlaneRC(lane & 15, 4096 + hh * 128 + 8 * (lane >> 4));
    bf16x8 kf[8]; u32x4 vv[8];
    { const size_t ro = zrowU(t < 0 ? SEQ : 32 * t, 32);
#pragma unroll
      for (int s = 0; s < 8; ++s) kf[s] = *(const bf16x8*)(kbase + ro + (((s >> 1) << 9) | ((s & 1) << 8)));
#pragma unroll
      for (int i = 0; i < 8; ++i) vv[i] = *(const u32x4*)(vbase + ro + (((i >> 2) << 13) | ((i & 3) << 9))); }
    for (;;) {
        const int kpos0 = t < 0 ? 0 : NMETA + 32 * t, kvalid = t < 0 ? NMETA : 32;
        const int tn = t <= 0 ? -1 : t - 1;
        const size_t ron = zrowU(tn < 0 ? SEQ : 32 * tn, 32);
        f32x16 S; bf16x8 qf[8];
#pragma unroll
        for (int i = 0; i < 16; ++i) S[i] = 0.f;
#pragma unroll
        for (int s = 0; s < 8; ++s) qf[s] = qs_lds[64 * s];
        asm volatile("s_waitcnt lgkmcnt(0)" ::: "memory"); __builtin_amdgcn_sched_barrier(0);
        __builtin_amdgcn_s_setprio(1);
#pragma unroll
        for (int s = 0; s < 8; ++s) S = MFMA32(kf[s], qf[s], S);
        __builtin_amdgcn_s_setprio(0);
#pragma unroll
        for (int s = 0; s < 8; ++s) kf[s] = *(const bf16x8*)(kbase + ron + (((s >> 1) << 9) | ((s & 1) << 8)));
        unsigned pw[8];
        if (t == tfirst || t < 0) attnB_tile_math<true>(S, kpos0, kvalid, qpos, h, lane, later, pw); else attnB_tile_math<false>(S, kpos0, kvalid, qpos, h, lane, later, pw);
        asm volatile("s_waitcnt lgkmcnt(0)" ::: "memory");
#pragma unroll
        for (int i = 0; i < 8; ++i) *(LAS u32x4*)(vs + (16 * (i >> 2) + (lane & 15)) * PB + 32 * (i & 3) + 8 * (lane >> 4)) = vv[i];
#pragma unroll
        for (int i = 0; i < 8; ++i) vv[i] = *(const u32x4*)(vbase + ron + (((i >> 2) << 13) | ((i & 3) << 9)));
        asm volatile("s_waitcnt lgkmcnt(0)" ::: "memory");
        bf16x8 af[2][4];
#pragma unroll
        for (int s = 0; s < 2; ++s)
#pragma unroll
            for (int dt = 0; dt < 4; ++dt) { const LAS bf16_t* lo = vs + trb + 16 * s * PB + 32 * dt; af[s][dt] = tr_frag(lo, lo + 8 * PB); }
        asm volatile("s_waitcnt lgkmcnt(0)" ::: "memory"); __builtin_amdgcn_sched_barrier(0);
        __builtin_amdgcn_s_setprio(1);
#pragma unroll
        for (int s = 0; s < 2; ++s) {
            const u32x4 pwv = {pw[4 * s], pw[4 * s + 1], pw[4 * s + 2], pw[4 * s + 3]};
            const bf16x8 bfrag = __builtin_bit_cast(bf16x8, pwv);
#pragma unroll
            for (int dt = 0; dt < 4; ++dt) acc[dt] = MFMA32(af[s][dt], bfrag, acc[dt]);
        }
        __builtin_amdgcn_s_setprio(0);
        if (t < 0) break;
        if (__all(later > 150.1f)) break;
        t = tn;
    }
    if (!metaq || c < NMETA) {
        bf16_t* orow = z + zrowU(qrow0, 32) + zlaneRC(c, hh * 128 + 4 * h);
        const bf16_t* grow = z + zrowU(qrow0, 32) + zlaneRC(c, 6144 + hh * 128 + 4 * h);
#pragma unroll
        for (int dt = 0; dt < 4; ++dt)
#pragma unroll
            for (int g = 0; g < 4; ++g) {
                const int d0 = (dt << 9) | (g << 7);
                const u32x2 gv = *(const u32x2*)(grow + d0);
                u32x2 o; o.x = pk2(silu_mul(acc[dt][4 * g], bf_lo(gv.x)), silu_mul(acc[dt][4 * g + 1], bf_hi(gv.x)));
                o.y = pk2(silu_mul(acc[dt][4 * g + 2], bf_lo(gv.y)), silu_mul(acc[dt][4 * g + 3], bf_hi(gv.y)));
                *(u32x2*)(orow + d0) = o;
            }
    }
}

template <bool MASKED>
DI bool attnA_tile_math(const f32x16& Su, const LAS float* bt, int qpos, int kpos0, int kvalid, bool meta_tile, int h, int lane, float& m, float& l, float& corr, bf16x8 (&bfrag)[2]) {
    float sc[16]; float tmax = -1e30f;
#pragma unroll
    for (int r = 0; r < 16; ++r) {
        const int row = (r & 3) + 8 * (r >> 2) + 4 * h;
        const int dist = qpos - (kpos0 + row);
        if (MASKED) {
            const bool vis = (row < kvalid) && (dist >= 0) && (meta_tile || dist < 128);
            const int di = dist < 0 ? 0 : (dist > 128 ? 128 : dist);
            const float v = Su[r] * (0.125f * 1.4426950408889634f) + bt[di];
            sc[r] = vis ? v : -1e30f;
        } else sc[r] = Su[r] * (0.125f * 1.4426950408889634f) + bt[dist];
        tmax = fmaxf(tmax, sc[r]);
    }
    tmax = fmaxf(tmax, shflx(tmax, 32, lane));
    const bool resc = __any(tmax > m + 16.0f);
    float mnew = m; corr = 1.0f;
    if (resc) { mnew = fmaxf(m, tmax); corr = __builtin_amdgcn_exp2f(m - mnew); }
    float pr[16]; float psum = 0.f;
#pragma unroll
    for (int r = 0; r < 16; ++r) { pr[r] = __builtin_amdgcn_exp2f(sc[r] - mnew); psum += pr[r]; }
    psum += shflx(psum, 32, lane);
    l = l * corr + psum; m = mnew;
#pragma unroll
    for (int s = 0; s < 2; ++s) {
        u32x4 pw; pw.x = pk2(pr[8 * s], pr[8 * s + 1]); pw.y = pk2(pr[8 * s + 2], pr[8 * s + 3]); pw.z = pk2(pr[8 * s + 4], pr[8 * s + 5]); pw.w = pk2(pr[8 * s + 6], pr[8 * s + 7]);
        bfrag[s] = __builtin_bit_cast(bf16x8, pw);
    }
    return resc;
}

DI void attnA_item(bf16_t* z, const float* sinks, int hp, int qs, LAS bf16_t* vs, const LAS float* btab, int lane) {
    const int c = lane & 31, h = lane >> 5, kvh = hp >> 2;
    const bool metaq = qs < 0;
    const int qrow = metaq ? SEQ + c : 32 * qs + c;
    const int qpos = metaq ? (c < NMETA ? c : 0) : NMETA + 32 * qs + c;
    const int trb = (4 * h + ((lane & 15) >> 2)) * PA + 16 * ((lane >> 4) & 1) + 4 * (lane & 3);
    const int qrow0 = metaq ? SEQ : 32 * qs;
    LAS bf16x8* qs_lds = (LAS bf16x8*)(vs + 32 * PA) + lane;
    { bf16x8 qf[2][4];
#pragma unroll
      for (int u = 0; u < 2; ++u) { const bf16_t* qp = z + zrowU(qrow0, 18) + zlaneRC(c, (2 * hp + u) * 64 + 8 * h);
#pragma unroll
        for (int s = 0; s < 4; ++s) qf[u][s] = *(const bf16x8*)(qp + (((s >> 1) << 9) | ((s & 1) << 8))); }
      asm volatile("s_waitcnt lgkmcnt(0)" ::: "memory");
#pragma unroll
      for (int u = 0; u < 2; ++u)
#pragma unroll
        for (int s = 0; s < 4; ++s) qs_lds[64 * (4 * u + s)] = qf[u][s]; }
    f32x16 acc[2][2];
#pragma unroll
    for (int u = 0; u < 2; ++u)
#pragma unroll
        for (int dt = 0; dt < 2; ++dt)
#pragma unroll
            for (int i = 0; i < 16; ++i) acc[u][dt][i] = 0.f;
    float m[2] = {sinks[2 * hp] * 1.4426950408889634f, sinks[2 * hp + 1] * 1.4426950408889634f}, l[2] = {1.0f, 1.0f};
    const int tlo = metaq ? 0 : (qs - 4 > 0 ? qs - 4 : 0), thi = metaq ? -1 : qs;
    const bf16_t* kbase = z + zlaneRC(c, 2048 + kvh * 64 + 8 * h);
    const bf16_t* vbase = z + zlaneRC(lane & 15, 2304 + kvh * 64 + 8 * (lane >> 4));
    bf16x8 kf[4]; u32x4 vv[4];
    int t = -1;
    { const size_t ro = zrowU(SEQ, 18);
#pragma unroll
      for (int s = 0; s < 4; ++s) kf[s] = *(const bf16x8*)(kbase + ro + (((s >> 1) << 9) | ((s & 1) << 8)));
#pragma unroll
      for (int i = 0; i < 4; ++i) vv[i] = *(const u32x4*)(vbase + ro + (((i >> 1) << 13) | ((i & 1) << 9))); }
    for (;;) {
        const int kpos0 = t < 0 ? 0 : NMETA + 32 * t, kvalid = t < 0 ? NMETA : 32;
        const bool lastt = metaq || t == thi;
        const bool interior = !metaq && t >= 0 && t > qs - 4 && t < qs;
        const int tn = lastt ? t : (t < 0 ? tlo : t + 1);
        const size_t ron = zrowU(tn < 0 ? SEQ : 32 * tn, 18);
        bf16x8 bfrag[2][2];
#pragma unroll
        for (int u = 0; u < 2; ++u) {
            f32x16 Su; bf16x8 qf[4];
#pragma unroll
            for (int i = 0; i < 16; ++i) Su[i] = 0.f;
#pragma unroll
            for (int s = 0; s < 4; ++s) qf[s] = qs_lds[64 * (4 * u + s)];
            asm volatile("s_waitcnt lgkmcnt(0)" ::: "memory"); __builtin_amdgcn_sched_barrier(0);
            __builtin_amdgcn_s_setprio(1);
#pragma unroll
            for (int s = 0; s < 4; ++s) Su = MFMA32(kf[s], qf[s], Su);
            __builtin_amdgcn_s_setprio(0);
            if (u == 1) {
#pragma unroll
                for (int s = 0; s < 4; ++s) kf[s] = *(const bf16x8*)(kbase + ron + (((s >> 1) << 9) | ((s & 1) << 8)));
            }
            const LAS float* bt = btab + (2 * hp + u) * 129;
            float corr; bool resc;
            if (interior) resc = attnA_tile_math<false>(Su, bt, qpos, kpos0, kvalid, t < 0, h, lane, m[u], l[u], corr, bfrag[u]);
            else resc = attnA_tile_math<true>(Su, bt, qpos, kpos0, kvalid, t < 0, h, lane, m[u], l[u], corr, bfrag[u]);
            if (resc) {
#pragma unroll
                for (int dt = 0; dt < 2; ++dt)
#pragma unroll
                    for (int i = 0; i < 16; ++i) acc[u][dt][i] *= corr;
            }
        }
        asm volatile("s_waitcnt lgkmcnt(0)" ::: "memory");
#pragma unroll
        for (int i = 0; i < 4; ++i) *(LAS u32x4*)(vs + (16 * (i >> 1) + (lane & 15)) * PA + 32 * (i & 1) + 8 * (lane >> 4)) = vv[i];
#pragma unroll
        for (int i = 0; i < 4; ++i) vv[i] = *(const u32x4*)(vbase + ron + (((i >> 1) << 13) | ((i & 1) << 9)));
        asm volatile("s_waitcnt lgkmcnt(0)" ::: "memory");
        bf16x8 af[2][2];
#pragma unroll
        for (int s = 0; s < 2; ++s)
#pragma unroll
            for (int dt = 0; dt < 2; ++dt) { const LAS bf16_t* lo = vs + trb + 16 * s * PA + 32 * dt; af[s][dt] = tr_frag(lo, lo + 8 * PA); }
        asm volatile("s_waitcnt lgkmcnt(0)" ::: "memory"); __builtin_amdgcn_sched_barrier(0);
        __builtin_amdgcn_s_setprio(1);
#pragma unroll
        for (int s = 0; s < 2; ++s)
#pragma unroll
            for (int dt = 0; dt < 2; ++dt) {
                acc[0][dt] = MFMA32(af[s][dt], bfrag[0][s], acc[0][dt]);
                acc[1][dt] = MFMA32(af[s][dt], bfrag[1][s], acc[1][dt]);
            }
        __builtin_amdgcn_s_setprio(0);
        if (lastt) break;
        t = tn;
    }
    if (!metaq || c < NMETA) {
#pragma unroll
        for (int u = 0; u < 2; ++u) {
            const float inv = 1.0f / l[u];
            bf16_t* orow = z + zrowU(qrow0, 18) + zlaneRC(c, (2 * hp + u) * 64 + 4 * h);
            const bf16_t* grow = z + zrowU(qrow0, 18) + zlaneRC(c, 2560 + (2 * hp + u) * 64 + 4 * h);
#pragma unroll
            for (int dt = 0; dt < 2; ++dt)
#pragma unroll
                for (int g = 0; g < 4; ++g) {
                    const int d0 = (dt << 9) | (g << 7);
                    const u32x2 gv = *(const u32x2*)(grow + d0);
                    u32x2 o; o.x = pk2(silu_mul(acc[u][dt][4 * g] * inv, bf_lo(gv.x)), silu_mul(acc[u][dt][4 * g + 1] * inv, bf_hi(gv.x)));
                    o.y = pk2(silu_mul(acc[u][dt][4 * g + 2] * inv, bf_lo(gv.y)), silu_mul(acc[u][dt][4 * g + 3] * inv, bf_hi(gv.y)));
                    *(u32x2*)(orow + d0) = o;
                }
        }
    }
}

constexpr int NQS = SEQ / 32;

struct AttnQueue { unsigned* heads; int x; int cur; };
DI bool attn_next(AttnQueue& q, int lane0, int& qs, int& hd) {
    for (;;) {
        if (q.cur >= 8) return false;
        const int xq = (q.x + q.cur) & 7;
        const int nqs = NQS / 8 + (xq == 7 ? 1 : 0);
        unsigned n = 0;
        if (lane0) n = __hip_atomic_fetch_add(q.heads + 64 * xq, 1u, __ATOMIC_RELAXED, __HIP_MEMORY_SCOPE_AGENT);
        n = (unsigned)__builtin_amdgcn_readfirstlane((int)n);
        if (n < (unsigned)(nqs * 16)) { qs = (NQS / 8) * xq + (int)(n >> 4); hd = (int)(n & 15u); return true; }
        ++q.cur;
    }
}


__global__ void __launch_bounds__(NTHREADS) hybrid_fwd(Params p) {
    extern __shared__ __attribute__((aligned(16))) unsigned char lds_raw[];
    LAS unsigned char* lds = (LAS unsigned char*)lds_raw;
    cg::grid_group grid = cg::this_grid();
    bf16_t* hb = (bf16_t*)(p.ws + WS_HB);
    bf16_t* z = (bf16_t*)(p.ws + WS_Z);
    unsigned* barw = (unsigned*)(p.ws + WS_BAR);
    volatile LAS unsigned* bst = (volatile LAS unsigned*)(lds + LDS_MAIN);
    {
        const int tid = threadIdx.x, lane = tid & 63, wave = __builtin_amdgcn_readfirstlane(tid >> 6);
        const int G = gridDim.x, gw = blockIdx.x * NWAVES + wave, NGW = G * NWAVES;
        if (tid < 2) bst[tid] = 0u;
        if (blockIdx.x == 0) { for (int i = tid; i < XCD_BAR_WORDS; i += NTHREADS) barw[i] = 0u; for (int i = tid; i < 4 * 8 * 64; i += NTHREADS) ((unsigned*)(p.ws + WS_Q))[i] = 0u; }
        phase_p0(p, lds, gw, NGW, wave, lane);
    }
    grid.sync();
    const int wave_s = __builtin_amdgcn_readfirstlane(threadIdx.x >> 6);
    const XcdBarrier xb = xcd_barrier_post(barw, bst);
#define GSYNC() xcd_barrier(xb, wave_s)

#define PHASE_IDS() int lane = lane_id_fresh(); int wave = wave_s; asm volatile("" : "+s"(wave)); \
        int bid = blockIdx.x; asm volatile("" : "+s"(bid)); int G = gridDim.x; asm volatile("" : "+s"(G)); \
        const int tid = wave * 64 + lane, gw = bid * NWAVES + wave, NGW = G * NWAVES; (void)tid; (void)gw; (void)NGW
#pragma unroll 1
    for (int layer = 0; layer < DEPTH; ++layer) {
        const int j = layer >> 1;
        const bool isA = (layer & 1) == 0;
        {
            PHASE_IDS();
            const int N = isA ? NA : NB;
            const bf16_t* wt = isA ? (const bf16_t*)(p.ws + WS_W + j * WPAIR + WO_INA) : (const bf16_t*)(p.ws + WS_W + j * WPAIR + WO_INB);
            pg8::StaticOrder S; S.init(SEQ, N, G, bid);
            pg8::Gemm g{hb, wt, SEQ, N, D, D, 0};
            pg8::EpiBf16 E{z, 0, N / 256}; pg8::gemm_phase<pg8::EpiBf16>(lds, g, S, E, tid);
            meta_gemm<false>(hb + (size_t)SEQ * D, D, wt, N, z, 0, N / 256, lds, bid, G, wave, lane);
        }
        GSYNC();
        if (isA) {
            PHASE_IDS();
            LAS float* btab = (LAS float*)(lds + 8 * 14336);
            for (int idx = tid; idx < 32 * 129; idx += NTHREADS) {
                const int hd = idx / 129, d = idx % 129;
                int bucket = d;
                if (d >= 16) { bucket = 16 + (int)(logf((float)d * (1.0f / 16.0f)) / 2.0794415416798357f * 16.0f); bucket = bucket > 31 ? 31 : bucket; }
                btab[idx] = p.rel_bias[bucket * 32 + hd] * 1.4426950408889634f;
            }
            __syncthreads();
            LAS bf16_t* vs = (LAS bf16_t*)(lds + wave * 14336);
            const float* sinks = p.sinks_a + j * 32;
            AttnQueue aq{(unsigned*)(p.ws + WS_Q) + layer * 8 * 64, (int)(xb.x & 7u), 0}; int qs, hd;
            while (attn_next(aq, lane_id_fresh() == 0, qs, hd)) attnA_item(z, sinks, hd, qs == NQS ? -1 : qs, vs, btab, lane_id_fresh());
        } else {
            PHASE_IDS();
            LAS bf16_t* vs = (LAS bf16_t*)(lds + wave * (VS_BYTES + 8192));
            AttnQueue aq{(unsigned*)(p.ws + WS_Q) + layer * 8 * 64, (int)(xb.x & 7u), 0}; int qs, hd;
            while (attn_next(aq, lane_id_fresh() == 0, qs, hd)) attnB_item(z, hd, qs == NQS ? -1 : qs, vs, lane_id_fresh());
        }
        GSYNC();
        {
            PHASE_IDS();
            const int znt = isA ? NA / 256 : NB / 256;
            pg8::StaticOrder S; S.init(SEQ, D, G, bid);
            const bf16_t* wt = isA ? (const bf16_t*)(p.ws + WS_W + j * WPAIR + WO_OUTA) : (const bf16_t*)(p.ws + WS_W + j * WPAIR + WO_OUTB);
            pg8::Gemm g{z, wt, SEQ, D, D, 0, znt};
            pg8::EpiBf16 E{hb, D, 0}; pg8::gemm_phase<pg8::EpiBf16>(lds, g, S, E, tid);
            if (layer != DEPTH - 1) meta_gemm<true>(z, 0, wt, D, hb, D, znt, lds, bid, G, wave, lane);
        }
        GSYNC();
        {
            PHASE_IDS();
            phase_ln(p, layer, gw, NGW, lane);
        }
        if (layer != DEPTH - 1) GSYNC();
    }
}

extern "C" void kernel_launch(void* const* d_in, const int* in_sizes, int n_in, void* d_out, int out_size, void* d_ws, size_t ws_size, hipStream_t stream) {
    static int grid = 0;
    if (grid == 0) {
        if (n_in != 10 || out_size != SEQ * D || ws_size < WS_END) { fprintf(stderr, "kernel_launch: unexpected shapes (n_in %d out %d ws %zu, need %zu)\n", n_in, out_size, ws_size, (size_t)WS_END); grid = -1; return; }
        int dev = 0, cus = 0, per_cu = 0;
        hipGetDevice(&dev);
        hipDeviceGetAttribute(&cus, hipDeviceAttributeMultiprocessorCount, dev);
        if (hipFuncSetAttribute((const void*)hybrid_fwd, hipFuncAttributeMaxDynamicSharedMemorySize, LDS_BYTES) != hipSuccess) { fprintf(stderr, "kernel_launch: hipFuncSetAttribute failed\n"); grid = -1; return; }
        if (hipOccupancyMaxActiveBlocksPerMultiprocessor(&per_cu, (const void*)hybrid_fwd, NTHREADS, LDS_BYTES) != hipSuccess || per_cu < 1) { fprintf(stderr, "kernel_launch: occupancy query failed (%d)\n", per_cu); (void)hipGetLastError(); per_cu = 1; }
        grid = cus * 1;
    }
    if (grid < 0) return;
    Params p{};
    p.x = (const float*)d_in[0]; p.meta = (const float*)d_in[1]; p.rel_bias = (const float*)d_in[2]; p.w_in_a = (const float*)d_in[3]; p.sinks_a = (const float*)d_in[4];
    p.w_out_a = (const float*)d_in[5]; p.w_in_b = (const float*)d_in[6]; p.w_out_b = (const float*)d_in[7]; p.ln_g = (const float*)d_in[8]; p.ln_b = (const float*)d_in[9];
    p.out = (float*)d_out; p.ws = (unsigned char*)d_ws; p.probe = 1;
    void* args[] = {&p};
    hipError_t e = hipLaunchCooperativeKernel((const void*)hybrid_fwd, dim3(grid), dim3(NTHREADS), args, LDS_BYTES, stream);
    if (e != hipSuccess) fprintf(stderr, "kernel_launch: cooperative launch failed: %s (grid %d)\n", hipGetErrorString(e), grid);
}
```

```cpp
#include <hip/hip_runtime.h>
#include <hip/hip_cooperative_groups.h>
#include <cstdio>
namespace cg = cooperative_groups;

#define LAS __attribute__((address_space(3)))
#define DI __device__ __forceinline__
typedef unsigned short bf16_t;
typedef short bf16x8 __attribute__((ext_vector_type(8)));
typedef float f32x2 __attribute__((ext_vector_type(2)));
typedef float f32x4 __attribute__((ext_vector_type(4)));
typedef float f32x16 __attribute__((ext_vector_type(16)));
typedef unsigned u32x2 __attribute__((ext_vector_type(2)));
typedef unsigned u32x4 __attribute__((ext_vector_type(4)));
typedef __bf16 bf16v2 __attribute__((ext_vector_type(2)));

constexpr int D = 2048, SEQ = 16384, NMETA = 16, LTOK = SEQ + NMETA, MPAD = SEQ + 256;
constexpr int NA = 4608, NB = 8192, DEPTH = 4;
constexpr int NTHREADS = 512, NWAVES = 8;
constexpr int LDS_MAIN = 147456, LDS_BYTES = LDS_MAIN + 16;
constexpr float LN_EPS = 1e-5f;
constexpr float DN_ALPHA = 1.6817928305074290f;

constexpr size_t WS_W = 0;
constexpr size_t WPAIR = (size_t)(NA + D + NB + D) * D * 2;
constexpr size_t WO_INA = 0, WO_OUTA = (size_t)NA * D * 2, WO_INB = WO_OUTA + (size_t)D * D * 2, WO_OUTB = WO_INB + (size_t)NB * D * 2;
constexpr size_t WS_HB = WS_W + 2 * WPAIR;
constexpr size_t WS_Z = WS_HB + (size_t)MPAD * D * 2;
constexpr size_t WS_BAR = WS_Z + (size_t)MPAD * NB * 2;
static_assert((size_t)LTOK * D * 2 <= WPAIR, "the fp16 residual stream must fit in the first layer pair's weight region");
constexpr size_t WS_Q = WS_BAR + 16384;
constexpr size_t WS_END = WS_Q + 4 * 8 * 256;

DI unsigned pk2(float a, float b) { f32x2 v = {a, b}; bf16v2 r = __builtin_convertvector(v, bf16v2); return __builtin_bit_cast(unsigned, r); }
typedef _Float16 h16v2 __attribute__((ext_vector_type(2)));
DI unsigned pkh2(float a, float b) { f32x2 v = {a, b}; h16v2 r = __builtin_convertvector(v, h16v2); return __builtin_bit_cast(unsigned, r); }
DI float h_lo(unsigned u) { return (float)__builtin_bit_cast(h16v2, u)[0]; }
DI float h_hi(unsigned u) { return (float)__builtin_bit_cast(h16v2, u)[1]; }
DI float bf_lo(unsigned u) { return __uint_as_float(u << 16); }
DI float bf_hi(unsigned u) { return __uint_as_float(u & 0xffff0000u); }
DI float shflx(float v, int mask, int lane) { return __int_as_float(__builtin_amdgcn_ds_bpermute((lane ^ mask) << 2, __float_as_int(v))); }
DI int lane_id_fresh() { unsigned zero; asm volatile("v_mov_b32 %0, 0" : "=v"(zero)); return (int)__builtin_amdgcn_mbcnt_hi(~0u, __builtin_amdgcn_mbcnt_lo(~0u, zero)); }
DI float wave_sum(float v, int lane) {
#pragma unroll
    for (int o = 1; o < 64; o <<= 1) v += shflx(v, o, lane);
    return v;
}


DI size_t zrowU(int row0, int NT) { return ((size_t)((row0 >> 8) * NT) << 16) + (size_t)((((row0 >> 7) & 1) << 15) | (((row0 >> 5) & 1) << 14) | (((row0 >> 6) & 1) << 11)); }
DI unsigned zlaneRC(int r5, int col) { return (unsigned)(((col >> 8) << 16) | ((r5 >> 4) << 13) | (((col >> 7) & 1) << 12) | (((col >> 5) & 3) << 9) | (((col >> 3) & 3) << 7) | ((r5 & 15) << 3) | (col & 7)); }

namespace pg8 {
constexpr int BM = 256, BK = 64, HALF = 128, HTB = HALF * BK * 2, NXCD = 8, WGM = 8;
DI int lds_byte(int r, int c) { const int st = (r >> 4) * 2 + (c >> 5), rr = r & 15, cc = c & 31, ob = rr * 64 + cc * 2; return st * 1024 + (ob ^ (((ob >> 9) & 1) << 5)); }
DI void stage_rc(int b, int& R, int& C) { const int st = b / 1024, sb = b % 1024, swz = sb ^ (((sb >> 9) & 1) << 5); R = (st >> 1) * 16 + swz / 64; C = (st & 1) * 32 + (swz % 64) / 2; }
DI int perm32(int rho) { const int n = rho >> 4, i = rho & 15; return 8 * (i >> 2) + 4 * n + (i & 3); }

struct Unit { int pm, pn; };
struct Gemm { const bf16_t* A; const bf16_t* Bt; int M, N, K, lda; int ant; };

struct StaticOrder {
    int nM, nN, nwg, G, c;
    DI void init(int M, int N, int G_, int c_) { nM = M / BM; nN = N / BM; nwg = nM * nN; G = G_; c = c_; }
    DI bool next(int i, Unit& u) const {
        const long L = (long)i * G + c; if (L >= nwg) return false;
        int wgid = (int)L; { const int q = nwg / NXCD, r = nwg % NXCD, xcd = wgid % NXCD, off = wgid / NXCD; wgid = (xcd < r ? xcd * (q + 1) : r * (q + 1) + (xcd - r) * q) + off; }
        const int nig = WGM * nN, gid = wgid / nig, fm = gid * WGM, gsz = (nM - fm) < WGM ? (nM - fm) : WGM;
        u.pm = fm + ((wgid % nig) % gsz); u.pn = (wgid % nig) / gsz; return true;
    }
};

struct EpiBf16 {
    static constexpr bool PERM = true;
    bf16_t* O; int ldc; int nt;
    DI void operator()(const f32x4 (&acc)[2][2][4][2], const Unit& u, int wr, int wc, int fr, int fq) const {
        if (nt) {
            unsigned char* tb = (unsigned char*)O + ((size_t)(u.pm * nt + u.pn) << 17) + (wr * 4 + wc) * 1024 + (fq * 16 + fr) * 16;
#pragma unroll
            for (int ai = 0; ai < 2; ++ai)
#pragma unroll
                for (int m = 0; m < 4; ++m)
#pragma unroll
                    for (int bj = 0; bj < 2; ++bj) { const f32x4 v0 = acc[ai][bj][m][0], v1 = acc[ai][bj][m][1];
                        u32x4 w; w.x = pk2(v0[0], v0[1]); w.y = pk2(v0[2], v0[3]); w.z = pk2(v1[0], v1[1]); w.w = pk2(v1[2], v1[3]);
                        *(u32x4*)(tb + ((ai * 4 + m) * 2 + bj) * 8192) = w; }
            return;
        }
        const int row0 = u.pm * BM + wr * 64 + fr; const int col0 = u.pn * BM + wc * 32 + 8 * fq;
#pragma unroll
        for (int ai = 0; ai < 2; ++ai)
#pragma unroll
            for (int m = 0; m < 4; ++m) { bf16_t* rowp = O + (size_t)(row0 + ai * HALF + m * 16) * ldc + col0;
#pragma unroll
                for (int bj = 0; bj < 2; ++bj) { const f32x4 v0 = acc[ai][bj][m][0], v1 = acc[ai][bj][m][1];
                    u32x4 w; w.x = pk2(v0[0], v0[1]); w.y = pk2(v0[2], v0[3]); w.z = pk2(v1[0], v1[1]); w.w = pk2(v1[2], v1[3]);
                    *(u32x4*)(rowp + bj * HALF) = w; } }
    }
};

template <class Epi>
DI void gemm_phase(LAS unsigned char* lds, const Gemm g, const StaticOrder& S, const Epi& E, const int tid) {
    const int wid = __builtin_amdgcn_readfirstlane(tid >> 6), lane = tid & 63, wr = wid >> 2, wc = wid & 3, fr = lane & 15, fq = lane >> 4;
    const int K = g.K, nt = K / BK, lda = g.lda;
    unsigned voffA[2], voffB[2];
#pragma unroll
    for (int i = 0; i < 2; ++i) { int R, C; stage_rc(tid * 16 + i * 8192, R, C); const int Rb = Epi::PERM ? ((R & ~31) + perm32(R & 31)) : R;
        voffA[i] = g.ant ? (unsigned)((((R >> 4) & 3) << 14) | (((R >> 6) & 1) << 12) | (((C >> 5) & 1) << 10) | (((C >> 3) & 3) << 8) | ((R & 15) << 4)) : (unsigned)(R * lda + C) * 2u;
        voffB[i] = (unsigned)(Rb * K + C) * 2u; }
    const size_t kstep = (size_t)(BK * 2);
    const size_t hstepA = g.ant ? (size_t)65536 : (size_t)HALF * lda * 2, hstepB = (size_t)HALF * K * 2;
    const size_t tstepA = g.ant ? (size_t)g.ant * 131072 : 2 * hstepA, tstepB = 2 * hstepB;
#define PG8_KTA(t) (g.ant ? ((size_t)((t) >> 2) * 131072 + (size_t)((((t) >> 1) & 1) * 8192 + ((t) & 1) * 2048)) : (size_t)(t) * kstep)
    const unsigned ldsw = (unsigned)wid * 1024u;
    const int aoff = lds_byte(wr * 64 + fr, fq * 8), boff = lds_byte(wc * 32 + fr, fq * 8);
#define PG8_SA(b, h) (((b) * 2 + (h)) * HTB)
#define PG8_SB(b, h) ((4 + (b) * 2 + (h)) * HTB)
#define PG8_STAGE(bufoff, gbase, voff) do { _Pragma("unroll") for (int _i = 0; _i < 2; ++_i) \
        __builtin_amdgcn_global_load_lds((const unsigned*)((const char*)(gbase) + (voff)[_i]), (LAS unsigned*)(lds + (bufoff) + ldsw + _i * 8192), 16, 0, 0); } while (0)
#define PG8_LDA(dst, b, h) do { _Pragma("unroll") for (int m = 0; m < 4; ++m) _Pragma("unroll") for (int k = 0; k < 2; ++k) dst[m][k] = *(const LAS bf16x8*)(lds + PG8_SA(b, h) + aoff + m * 2048 + k * 1024); } while (0)
#define PG8_LDB(dst, b, h) do { _Pragma("unroll") for (int n = 0; n < 2; ++n) _Pragma("unroll") for (int k = 0; k < 2; ++k) dst[n][k] = *(const LAS bf16x8*)(lds + PG8_SB(b, h) + boff + n * 2048 + k * 1024); } while (0)
#define PG8_MMA(ai, bj, At, Bt) do { __builtin_amdgcn_s_setprio(1); _Pragma("unroll") for (int m = 0; m < 4; ++m) _Pragma("unroll") for (int n = 0; n < 2; ++n) _Pragma("unroll") for (int k = 0; k < 2; ++k) \
        acc[ai][bj][m][n] = __builtin_amdgcn_mfma_f32_16x16x32_bf16(Bt[n][k], At[m][k], acc[ai][bj][m][n], 0, 0, 0); __builtin_amdgcn_s_setprio(0); } while (0)
#define PG8_WAIT_V(n) asm volatile("s_waitcnt vmcnt(" #n ")" ::: "memory")
#define PG8_WAIT_L(n) asm volatile("s_waitcnt lgkmcnt(" #n ")" ::: "memory")
#define PG8_BAR __builtin_amdgcn_s_barrier()
#define PG8_SCHED __builtin_amdgcn_sched_barrier(0)
    Unit cur, nxt; int ui = 0;
    if (!S.next(0, cur)) return;
    f32x4 acc[2][2][4][2];
#pragma unroll
    for (int a = 0; a < 2; ++a)
#pragma unroll
        for (int b = 0; b < 2; ++b)
#pragma unroll
            for (int m = 0; m < 4; ++m)
#pragma unroll
                for (int n = 0; n < 2; ++n) acc[a][b][m][n] = (f32x4){0.f, 0.f, 0.f, 0.f};
    bf16x8 At[4][2], B0[2][2], B1[2][2];
    const char* cA = (const char*)g.A + (size_t)cur.pm * tstepA; const char* cB = (const char*)g.Bt + (size_t)cur.pn * tstepB;
    PG8_STAGE(PG8_SB(0, 0), cB, voffB); PG8_STAGE(PG8_SA(0, 0), cA, voffA); PG8_STAGE(PG8_SB(0, 1), cB + hstepB, voffB); PG8_STAGE(PG8_SA(0, 1), cA + hstepA, voffA);
    if (wr == 1) PG8_BAR;
    PG8_WAIT_V(4); PG8_BAR;
    PG8_STAGE(PG8_SB(1, 0), cB + kstep, voffB); PG8_STAGE(PG8_SA(1, 0), cA + PG8_KTA(1), voffA); PG8_STAGE(PG8_SB(1, 1), cB + hstepB + kstep, voffB);
    PG8_WAIT_V(6); PG8_BAR;
    for (;;) {
        const bool has_next = S.next(ui + 1, nxt);
        const char* nA = has_next ? (const char*)g.A + (size_t)nxt.pm * tstepA : cA; const char* nB = has_next ? (const char*)g.Bt + (size_t)nxt.pn * tstepB : cB;
        for (int t = 0; t < nt; t += 2) {
            const bool last = (t == nt - 2);
            const char* a1 = cA + PG8_KTA(t + 1);
            const char* a2 = last ? nA : cA + PG8_KTA(t + 2); const char* b2 = last ? nB : cB + (size_t)(t + 2) * kstep;
            const char* a3 = last ? nA + PG8_KTA(1) : cA + PG8_KTA(t + 3); const char* b3 = b2 + kstep;
            PG8_LDB(B0, 0, 0); PG8_SCHED; PG8_LDA(At, 0, 0); PG8_STAGE(PG8_SA(1, 1), a1 + hstepA, voffA);
            PG8_WAIT_L(8); PG8_BAR; PG8_WAIT_L(0); PG8_MMA(0, 0, At, B0); PG8_BAR; PG8_SCHED;
            PG8_LDB(B1, 0, 1); PG8_STAGE(PG8_SB(0, 0), b2, voffB);
            PG8_BAR; PG8_WAIT_L(0); PG8_MMA(0, 1, At, B1); PG8_BAR;
            PG8_LDA(At, 0, 1); PG8_STAGE(PG8_SA(0, 0), a2, voffA);
            PG8_BAR; PG8_WAIT_L(0); PG8_MMA(1, 0, At, B0); PG8_BAR; PG8_SCHED;
            PG8_STAGE(PG8_SB(0, 1), b2 + hstepB, voffB);
            PG8_WAIT_V(6); PG8_BAR; PG8_MMA(1, 1, At, B1); PG8_BAR;
            PG8_LDB(B0, 1, 0); PG8_SCHED; PG8_LDA(At, 1, 0); PG8_STAGE(PG8_SA(0, 1), a2 + hstepA, voffA);
            PG8_WAIT_L(8); PG8_BAR; PG8_WAIT_L(0); PG8_MMA(0, 0, At, B0); PG8_BAR; PG8_SCHED;
            PG8_LDB(B1, 1, 1); PG8_STAGE(PG8_SB(1, 0), b3, voffB);
            PG8_BAR; PG8_WAIT_L(0); PG8_MMA(0, 1, At, B1); PG8_BAR;
            PG8_LDA(At, 1, 1); PG8_STAGE(PG8_SA(1, 0), a3, voffA);
            PG8_BAR; PG8_WAIT_L(0); PG8_MMA(1, 0, At, B0); PG8_BAR; PG8_SCHED;
            PG8_STAGE(PG8_SB(1, 1), b3 + hstepB, voffB);
            PG8_WAIT_V(6); PG8_BAR; PG8_MMA(1, 1, At, B1); PG8_BAR;
        }
        E(acc, cur, wr, wc, fr, fq);
        if (!has_next) break;
#pragma unroll
        for (int a = 0; a < 2; ++a)
#pragma unroll
            for (int b = 0; b < 2; ++b)
#pragma unroll
                for (int m = 0; m < 4; ++m)
#pragma unroll
                    for (int n = 0; n < 2; ++n) acc[a][b][m][n] = (f32x4){0.f, 0.f, 0.f, 0.f};
        cur = nxt; cA = nA; cB = nB; ++ui;
    }
    PG8_WAIT_V(0);
    if (wr == 0) PG8_BAR;
    PG8_BAR;
#undef PG8_KTA
#undef PG8_SA
#undef PG8_SB
#undef PG8_STAGE
#undef PG8_LDA
#undef PG8_LDB
#undef PG8_MMA
#undef PG8_WAIT_V
#undef PG8_WAIT_L
#undef PG8_BAR
#undef PG8_SCHED
}
}


#define XB_TMO      128
#define XB_XCNT(j)  (256  + 64 * (j))
#define XB_XSUB(j)  (1280 + 64 * (j))
#define XB_XGEN(j)  (2304 + 64 * (j))
#define XB_TOP      3328
#define XB_TOPGEN   3392
#define XCD_BAR_WORDS 3456
#define XB_SPIN_CAP (1u << 22)
DI unsigned xb_ld(unsigned* p)              { return __hip_atomic_load(p, __ATOMIC_RELAXED, __HIP_MEMORY_SCOPE_AGENT); }
DI unsigned xb_add(unsigned* p, unsigned v) { return __hip_atomic_fetch_add(p, v, __ATOMIC_RELAXED, __HIP_MEMORY_SCOPE_AGENT); }
DI unsigned xb_xcc_id() { return (unsigned)__builtin_amdgcn_s_getreg((3 << 11) | 20) & 0xFu; }
#define XB_SPIN(cond, bar) do { unsigned _sp = 0; while (cond) { __builtin_amdgcn_s_sleep(1); \
    if ((++_sp & 255u) == 0u) { if (xb_ld(&(bar)[XB_TMO])) break; if (_sp > XB_SPIN_CAP) { atomicAdd(&(bar)[XB_TMO], 1u); break; } } } } while (0)
struct XcdBarrier { unsigned* bar; unsigned x; volatile LAS unsigned* st; };
DI XcdBarrier xcd_barrier_post(unsigned* bar, volatile LAS unsigned* st) {
    XcdBarrier b; b.bar = bar; b.x = xb_xcc_id(); b.st = st;
    if (threadIdx.x == 0) (void)xb_add(&bar[XB_XCNT(b.x)], 1u);
    return b;
}
DI void xcd_barrier_complete(unsigned* bar, unsigned x, unsigned& nloc, unsigned& nx) {
    const unsigned G = gridDim.x;
    unsigned sum, cnt, mine, sp = 0u;
    for (;;) {
        sum = 0u; cnt = 0u; mine = 0u;
#pragma unroll
        for (unsigned j = 0; j < 16; ++j) { const unsigned c = xb_ld(&bar[XB_XCNT(j)]); sum += c; cnt += (c > 0u) ? 1u : 0u; mine = (j == x) ? c : mine; }
        if (sum == G) break;
        __builtin_amdgcn_s_sleep(1);
        if ((++sp & 255u) == 0u) { if (xb_ld(&bar[XB_TMO])) break; if (sp > XB_SPIN_CAP) { atomicAdd(&bar[XB_TMO], 1u); break; } }
    }
    nloc = mine > 0u ? mine : 1u; nx = cnt > 0u ? cnt : 1u;
}
DI void xcd_barrier(const XcdBarrier& b, int wave_s) {
    asm volatile("s_waitcnt vmcnt(0)" ::: "memory");
    __syncthreads();
    if (wave_s == 0 && lane_id_fresh() == 0) {
        unsigned* bar = b.bar;
        __builtin_amdgcn_s_waitcnt(0);
        unsigned nloc = b.st[0], nx = b.st[1];
        if (nloc == 0u) { xcd_barrier_complete(bar, b.x, nloc, nx); b.st[0] = nloc; b.st[1] = nx; }
        const unsigned old = xb_add(&bar[XB_XSUB(b.x)], 1u);
        const unsigned gen = old / nloc;
        if (old + 1u == (gen + 1u) * nloc) {
            __builtin_amdgcn_fence(__ATOMIC_RELEASE, "agent");
            asm volatile("s_waitcnt vmcnt(0)" ::: "memory");
            const unsigned og = xb_add(&bar[XB_TOP], 1u);
            const unsigned tg = og / nx;
            if (og + 1u == (tg + 1u) * nx) xb_add(&bar[XB_TOPGEN], 1u);
            else XB_SPIN(xb_ld(&bar[XB_TOPGEN]) == tg, bar);
            __builtin_amdgcn_fence(__ATOMIC_ACQUIRE, "agent");
            xb_add(&bar[XB_XGEN(b.x)], 1u);
            asm volatile("s_waitcnt vmcnt(0)" ::: "memory");
        } else {
            XB_SPIN(xb_ld(&bar[XB_XGEN(b.x)]) == gen, bar);
            __builtin_amdgcn_fence(__ATOMIC_ACQUIRE, "agent");
            asm volatile("s_waitcnt vmcnt(0)" ::: "memory");
        }
    }
    __syncthreads();
}

template <bool TILED_IN>
DI void meta_gemm(const bf16_t* am, int lda, const bf16_t* Wt, int N, bf16_t* zo, int ldzo, int nt, LAS unsigned char* lds, int bid, int G, int wave, int lane) {
    const int ntasks = N / 16, r = lane & 15, q = lane >> 4, kq = wave & 3;
    LAS f32x4* part = (LAS f32x4*)lds;
    for (int t0 = 2 * (G - 1 - bid); t0 < ntasks; t0 += 2 * G) {
        const int task = t0 + (wave >> 2), n0 = task * 16;
        const bf16_t* ap = Wt + (size_t)(n0 + r) * D + 8 * q + 512 * kq;
        const bf16_t* bp = TILED_IN ? am + zrowU(SEQ, nt) + zlaneRC(r, 512 * kq + 8 * q) : am + (size_t)r * lda + 8 * q + 512 * kq;
        f32x4 acc = {0.f, 0.f, 0.f, 0.f};
        if (task < ntasks) {
#pragma unroll
            for (int k = 0; k < 16; ++k) { const bf16x8 a = *(const bf16x8*)(ap + 32 * k);
                const bf16x8 b = *(const bf16x8*)(bp + (TILED_IN ? (((k >> 3) << 16) | (((k >> 2) & 1) << 12) | ((k & 3) << 9)) : 32 * k));
                acc = __builtin_amdgcn_mfma_f32_16x16x32_bf16(a, b, acc, 0, 0, 0); }
        }
        part[wave * 64 + lane] = acc;
        __syncthreads();
        if (kq == 0 && task < ntasks) {
            const f32x4 t = (part[wave * 64 + lane] + part[(wave + 1) * 64 + lane]) + (part[(wave + 2) * 64 + lane] + part[(wave + 3) * 64 + lane]);
            u32x2 w; w.x = pk2(t[0], t[1]); w.y = pk2(t[2], t[3]);
            if (TILED_IN) *(u32x2*)(zo + (size_t)(SEQ + r) * ldzo + n0 + 4 * q) = w;
            else *(u32x2*)(zo + zrowU(SEQ, nt) + zlaneRC(r, n0 + 4 * q)) = w;
        }
        __syncthreads();
    }
}

DI void p0_transpose_item(const float* W, int K, int N, bf16_t* WT, LAS float* scr, int item, int lane) {
    const int nblk = N / 32, kb = item / nblk, nb = item % nblk, k0 = 128 * kb, n0 = 32 * nb;
    const int n4 = lane & 7, kr = lane >> 3;
    f32x4 v[16];
#pragma unroll
    for (int i = 0; i < 16; ++i) v[i] = *(const f32x4*)(W + (size_t)(k0 + kr + 8 * i) * N + n0 + 4 * n4);
#pragma unroll
    for (int i = 0; i < 16; ++i) { LAS float* d = scr + (kr + 8 * i) * 33 + 4 * n4; d[0] = v[i][0]; d[1] = v[i][1]; d[2] = v[i][2]; d[3] = v[i][3]; }
    asm volatile("s_waitcnt lgkmcnt(0)" ::: "memory");
    const int c = lane & 15;
#pragma unroll
    for (int j = 0; j < 8; ++j) { const int n = (lane >> 4) + 4 * j; const LAS float* s = scr + (8 * c) * 33 + n;
        u32x4 o; o.x = pk2(s[0 * 33], s[1 * 33]); o.y = pk2(s[2 * 33], s[3 * 33]); o.z = pk2(s[4 * 33], s[5 * 33]); o.w = pk2(s[6 * 33], s[7 * 33]);
        *(u32x4*)(WT + (size_t)(n0 + n) * K + k0 + 8 * c) = o; }
    asm volatile("s_waitcnt lgkmcnt(0)" ::: "memory");
}

struct Params {
    const float* x; const float* meta; const float* rel_bias; const float* w_in_a; const float* sinks_a; const float* w_out_a;
    const float* w_in_b; const float* w_out_b; const float* ln_g; const float* ln_b;
    float* out; unsigned char* ws; int probe; int pad;
};


DI void phase_p0(const Params& p, LAS unsigned char* lds, int gw, int NGW, int wave, int lane) {
    LAS float* scr = (LAS float*)(lds + wave * 16896);
    constexpr int I_INA = (D / 128) * (NA / 32), I_OUT = (D / 128) * (D / 32), I_INB = (D / 128) * (NB / 32);
    constexpr int NITEMS = 2 * (I_INA + I_OUT + I_INB + I_OUT);
    for (int it = gw; it < NITEMS; it += NGW) {
        int r = it;
        if (r < 2 * I_INA) { const int j = r / I_INA; p0_transpose_item(p.w_in_a + (size_t)j * D * NA, D, NA, (bf16_t*)(p.ws + WS_W + j * WPAIR + WO_INA), scr, r % I_INA, lane); continue; } r -= 2 * I_INA;
        if (r < 2 * I_OUT) { const int j = r / I_OUT; p0_transpose_item(p.w_out_a + (size_t)j * D * D, D, D, (bf16_t*)(p.ws + WS_W + j * WPAIR + WO_OUTA), scr, r % I_OUT, lane); continue; } r -= 2 * I_OUT;
        if (r < 2 * I_INB) { const int j = r / I_INB; p0_transpose_item(p.w_in_b + (size_t)j * D * NB, D, NB, (bf16_t*)(p.ws + WS_W + j * WPAIR + WO_INB), scr, r % I_INB, lane); continue; } r -= 2 * I_INB;
        { const int j = r / I_OUT; p0_transpose_item(p.w_out_b + (size_t)j * D * D, D, D, (bf16_t*)(p.ws + WS_W + j * WPAIR + WO_OUTB), scr, r % I_OUT, lane); }
    }
    bf16_t* hb = (bf16_t*)(p.ws + WS_HB);
    { unsigned char* zb = p.ws + WS_Z;
      for (size_t i = (size_t)(gw * 64 + lane) * 16; i < (size_t)(18 + 32) << 17; i += (size_t)NGW * 64 * 16) {
          unsigned char* dst = i < ((size_t)18 << 17) ? zb + ((size_t)(64 * 18) << 17) + i : zb + ((size_t)(64 * 32) << 17) + (i - ((size_t)18 << 17));
          *(u32x4*)dst = (u32x4){0u, 0u, 0u, 0u}; } }
    for (int r0 = gw; r0 < LTOK; r0 += 2 * NGW) {
        f32x4 v[2][8];
#pragma unroll
        for (int q = 0; q < 2; ++q) { const int r = r0 + q * NGW < LTOK ? r0 + q * NGW : r0;
            const f32x4* src = (const f32x4*)(r < SEQ ? p.x + (size_t)r * D : p.meta + (size_t)(r - SEQ) * D) + 2 * lane;
#pragma unroll
            for (int j = 0; j < 4; ++j) { v[q][2 * j] = src[128 * j]; v[q][2 * j + 1] = src[128 * j + 1]; } }
#pragma unroll
        for (int q = 0; q < 2; ++q) { const int r = r0 + q * NGW; if (r >= LTOK) break;
            u32x4* ob = (u32x4*)(hb + (size_t)r * D) + lane;
#pragma unroll
            for (int j = 0; j < 4; ++j) { const f32x4 a0 = v[q][2 * j], a1 = v[q][2 * j + 1]; u32x4 w; w.x = pk2(a0[0], a0[1]); w.y = pk2(a0[2], a0[3]); w.z = pk2(a1[0], a1[1]); w.w = pk2(a1[2], a1[3]); ob[64 * j] = w; } }
    }
}

DI void phase_ln(const Params& p, int layer, int gw, int NGW, int lane) {
    const float* g = p.ln_g + (size_t)layer * D; const float* b = p.ln_b + (size_t)layer * D;
    bf16_t* hb = (bf16_t*)(p.ws + WS_HB);
    const bool last = layer == DEPTH - 1;
    const int nrows = last ? SEQ : LTOK;
    const unsigned short* h16in = layer == DEPTH - 1 ? (const unsigned short*)(p.ws + WS_W) : (const unsigned short*)p.out;
    unsigned short* h16out = layer == DEPTH - 2 ? (unsigned short*)(p.ws + WS_W) : (unsigned short*)p.out;
    constexpr int R = 2;
    for (int r0 = gw; r0 < nrows; r0 += R * NGW) {
        int rr[R]; bool ok[R];
#pragma unroll
        for (int q = 0; q < R; ++q) { ok[q] = r0 + q * NGW < nrows; rr[q] = ok[q] ? r0 + q * NGW : r0; }
        float v[R][32]; float s1[R], s2[R];
#pragma unroll
        for (int q = 0; q < R; ++q) {
            const u32x4* yb = (const u32x4*)(hb + (size_t)rr[q] * D) + lane;
            u32x4 yv[4];
#pragma unroll
            for (int j = 0; j < 4; ++j) yv[j] = __builtin_nontemporal_load(yb + 64 * j);
            if (layer == 0) {
                const f32x4* src32 = (const f32x4*)(rr[q] < SEQ ? p.x + (size_t)rr[q] * D : p.meta + (size_t)(rr[q] - SEQ) * D) + 2 * lane;
#pragma unroll
                for (int j = 0; j < 4; ++j) { const f32x4 a0 = src32[128 * j], a1 = src32[128 * j + 1];
                    v[q][8 * j + 0] = a0[0]; v[q][8 * j + 1] = a0[1]; v[q][8 * j + 2] = a0[2]; v[q][8 * j + 3] = a0[3];
                    v[q][8 * j + 4] = a1[0]; v[q][8 * j + 5] = a1[1]; v[q][8 * j + 6] = a1[2]; v[q][8 * j + 7] = a1[3]; }
            } else {
                const u32x4* src16 = (const u32x4*)(h16in + (size_t)rr[q] * D) + lane;
#pragma unroll
                for (int j = 0; j < 4; ++j) { const u32x4 hh = __builtin_nontemporal_load(src16 + 64 * j);
                    v[q][8 * j + 0] = h_lo(hh.x); v[q][8 * j + 1] = h_hi(hh.x); v[q][8 * j + 2] = h_lo(hh.y); v[q][8 * j + 3] = h_hi(hh.y);
                    v[q][8 * j + 4] = h_lo(hh.z); v[q][8 * j + 5] = h_hi(hh.z); v[q][8 * j + 6] = h_lo(hh.w); v[q][8 * j + 7] = h_hi(hh.w); }
            }
            float a1 = 0.f, a2 = 0.f;
#pragma unroll
            for (int j = 0; j < 4; ++j) { const unsigned yw[4] = {yv[j].x, yv[j].y, yv[j].z, yv[j].w};
#pragma unroll
                for (int e = 0; e < 4; ++e) { const float u0 = v[q][8 * j + 2 * e] * DN_ALPHA + bf_lo(yw[e]), u1 = v[q][8 * j + 2 * e + 1] * DN_ALPHA + bf_hi(yw[e]);
                    v[q][8 * j + 2 * e] = u0; v[q][8 * j + 2 * e + 1] = u1; a1 += u0 + u1; a2 += u0 * u0 + u1 * u1; } }
            s1[q] = a1; s2[q] = a2;
        }
#pragma unroll
        for (int o = 1; o < 64; o <<= 1)
#pragma unroll
            for (int q = 0; q < R; ++q) { s1[q] += shflx(s1[q], o, lane); s2[q] += shflx(s2[q], o, lane); }
        float mean[R], rstd[R];
#pragma unroll
        for (int q = 0; q < R; ++q) { mean[q] = s1[q] * (1.f / D); const float var = fmaxf(s2[q] * (1.f / D) - mean[q] * mean[q], 0.f); rstd[q] = 1.0f / sqrtf(var + LN_EPS); }
#pragma unroll
        for (int j = 0; j < 4; ++j) {
            const f32x4 g0 = ((const f32x4*)g)[128 * j + 2 * lane], g1 = ((const f32x4*)g)[128 * j + 2 * lane + 1], b0 = ((const f32x4*)b)[128 * j + 2 * lane], b1 = ((const f32x4*)b)[128 * j + 2 * lane + 1];
            const float gg[8] = {g0[0], g0[1], g0[2], g0[3], g1[0], g1[1], g1[2], g1[3]}, bb[8] = {b0[0], b0[1], b0[2], b0[3], b1[0], b1[1], b1[2], b1[3]};
#pragma unroll
            for (int q = 0; q < R; ++q) { if (!ok[q]) continue;
                float y[8];
#pragma unroll
                for (int e = 0; e < 8; ++e) y[e] = (v[q][8 * j + e] - mean[q]) * rstd[q] * gg[e] + bb[e];
                if (last) { f32x4* o = (f32x4*)(p.out + (size_t)rr[q] * D) + 128 * j + 2 * lane; o[0] = (f32x4){y[0], y[1], y[2], y[3]}; o[1] = (f32x4){y[4], y[5], y[6], y[7]}; }
                else { u32x4 hw; hw.x = pkh2(y[0], y[1]); hw.y = pkh2(y[2], y[3]); hw.z = pkh2(y[4], y[5]); hw.w = pkh2(y[6], y[7]);
                       ((u32x4*)(h16out + (size_t)rr[q] * D) + lane)[64 * j] = hw;
                       u32x4 w; w.x = pk2(y[0], y[1]); w.y = pk2(y[2], y[3]); w.z = pk2(y[4], y[5]); w.w = pk2(y[6], y[7]);
                       ((u32x4*)(hb + (size_t)rr[q] * D) + lane)[64 * j] = w; } }
        }
    }
}

#define MFMA32(a, b, c) __builtin_amdgcn_mfma_f32_32x32x16_bf16((a), (b), (c), 0, 0, 0)
DI float silu_mul(float o, float g) { return o * g * __builtin_amdgcn_rcpf(1.0f + __builtin_amdgcn_exp2f(g * -1.4426950408889634f)); }

typedef short s16x4 __attribute__((ext_vector_type(4)));
DI bf16x8 tr_frag(const LAS bf16_t* lo, const LAS bf16_t* hi) {
    const s16x4 a = __builtin_amdgcn_ds_read_tr16_b64_v4i16((LAS s16x4*)lo), b = __builtin_amdgcn_ds_read_tr16_b64_v4i16((LAS s16x4*)hi);
    return __builtin_shufflevector(a, b, 0, 1, 2, 3, 4, 5, 6, 7);
}
constexpr int PB = 160, PA = 96;
constexpr int VS_BYTES = 32 * PB * 2;

template <bool MASKED>
DI void attnB_tile_math(const f32x16& S, int kpos0, int kvalid, int qpos, int h, int lane, float& later, unsigned (&pw)[8]) {
    const float scale2 = 0.08838834764831845f * 1.4426950408889634f;
    float x2[16], sp[16];
#pragma unroll
    for (int r = 0; r < 16; ++r) {
        const float x = S[r] * scale2; x2[r] = x;
        const float e = __builtin_amdgcn_exp2f(-fabsf(x));
        const float v = fmaxf(x, 0.f) + __builtin_amdgcn_logf(1.0f + e);
        if (MASKED) { const int row = (r & 3) + 8 * (r >> 2) + 4 * h; const bool vis = (row < kvalid) && (kpos0 + row < qpos); sp[r] = vis ? v : 0.f; }
        else sp[r] = v;
    }
    float G[4], P[4];
#pragma unroll
    for (int g = 0; g < 4; ++g) { G[g] = (sp[4 * g] + sp[4 * g + 1]) + (sp[4 * g + 2] + sp[4 * g + 3]); P[g] = shflx(G[g], 32, lane); }
    float R[4]; R[3] = 0.f; R[2] = G[3] + P[3]; R[1] = R[2] + (G[2] + P[2]); R[0] = R[1] + (G[1] + P[1]);
    const float total = R[0] + (G[0] + P[0]);
#pragma unroll
    for (int g = 0; g < 4; ++g) {
        float sfx = later + R[g] + (h == 0 ? P[g] : 0.f); float wv[4];
#pragma unroll
        for (int i = 3; i >= 0; --i) {
            const int r = 4 * g + i;
            sfx += sp[r];
            float t = __builtin_amdgcn_exp2f(x2[r] - sfx);
            if (MASKED) { const int row = (r & 3) + 8 * (r >> 2) + 4 * h; const bool vis = (row < kvalid) && (kpos0 + row < qpos); t = vis ? t : 0.f; }
            wv[i] = t;
        }
        pw[2 * g] = pk2(wv[0], wv[1]); pw[2 * g + 1] = pk2(wv[2], wv[3]);
    }
    later += total;
}

DI void attnB_item(bf16_t* z, int hh, int qs, LAS bf16_t* vs, int lane) {
    const int c = lane & 31, h = lane >> 5;
    const bool metaq = qs < 0;
    const int qrow = metaq ? SEQ + c : 32 * qs + c;
    const int qpos = metaq ? (c < NMETA ? c : 0) : NMETA + 32 * qs + c;
    const int trb = (4 * h + ((lane & 15) >> 2)) * PB + 16 * ((lane >> 4) & 1) + 4 * (lane & 3);
    const int qrow0 = metaq ? SEQ : 32 * qs;
    LAS bf16x8* qs_lds = (LAS bf16x8*)(vs + 32 * PB) + lane;
    { const bf16_t* qp = z + zrowU(qrow0, 32) + zlaneRC(c, hh * 128 + 8 * h);
      bf16x8 qf[8];
#pragma unroll
      for (int s = 0; s < 8; ++s) qf[s] = *(const bf16x8*)(qp + (((s >> 1) << 9) | ((s & 1) << 8)));
      asm volatile("s_waitcnt lgkmcnt(0)" ::: "memory");
#pragma unroll
      for (int s = 0; s < 8; ++s) qs_lds[64 * s] = qf[s]; }
    f32x16 acc[4];
#pragma unroll
    for (int dt = 0; dt < 4; ++dt)
#pragma unroll
        for (int i = 0; i < 16; ++i) acc[dt][i] = 0.f;
    float later = 0.f;
    int t = metaq ? -1 : qs;
    const int tfirst = t;
    const bf16_t* kbase = z + zlaneRC(c, 2048 + hh * 128 + 8 * h);
    const bf16_t* vbase = z + zlaneRC(lane & 15, 4096 + hh * 128 + 8 * (lane >> 4));
    bf16x8 kf[8]; u32x4 vv[8];
    { const size_t ro = zrowU(t < 0 ? SEQ : 32 * t, 32);
#pragma unroll
      for (int s = 0; s < 8; ++s) kf[s] = *(const bf16x8*)(kbase + ro + (((s >> 1) << 9) | ((s & 1) << 8)));
#pragma unroll
      for (int i = 0; i < 8; ++i) vv[i] = *(const u32x4*)(vbase + ro + (((i >> 2) << 13) | ((i & 3) << 9))); }
    for (;;) {
        const int kpos0 = t < 0 ? 0 : NMETA + 32 * t, kvalid = t < 0 ? NMETA : 32;
        const int tn = t <= 0 ? -1 : t - 1;
        const size_t ron = zrowU(tn < 0 ? SEQ : 32 * tn, 32);
        f32x16 S; bf16x8 qf[8];
#pragma unroll
        for (int i = 0; i < 16; ++i) S[i] = 0.f;
#pragma unroll
        for (int s = 0; s < 8; ++s) qf[s] = qs_lds[64 * s];
        asm volatile("s_waitcnt lgkmcnt(0)" ::: "memory"); __builtin_amdgcn_sched_barrier(0);
        __builtin_amdgcn_s_setprio(1);
#pragma unroll
        for (int s = 0; s < 8; ++s) S = MFMA32(kf[s], qf[s], S);
        __builtin_amdgcn_s_setprio(0);
#pragma unroll
        for (int s = 0; s < 8; ++s) kf[s] = *(const bf16x8*)(kbase + ron + (((s >> 1) << 9) | ((s & 1) << 8)));
        unsigned pw[8];
        if (t == tfirst || t < 0) attnB_tile_math<true>(S, kpos0, kvalid, qpos, h, lane, later, pw); else attnB_tile_math<false>(S, kpos0, kvalid, qpos, h, lane, later, pw);
        asm volatile("s_waitcnt lgkmcnt(0)" ::: "memory");
#pragma unroll
        for (int i = 0; i < 8; ++i) *(LAS u32x4*)(vs + (16 * (i >> 2) + (lane & 15)) * PB + 32 * (i & 3) + 8 * (lane >> 4)) = vv[i];
#pragma unroll
        for (int i = 0; i < 8; ++i) vv[i] = *(const u32x4*)(vbase + ron + (((i >> 2) << 13) | ((i & 3) << 9)));
        asm volatile("s_waitcnt lgkmcnt(0)" ::: "memory");
        bf16x8 af[2][4];
#pragma unroll
        for (int s = 0; s < 2; ++s)
#pragma unroll
            for (int dt = 0; dt < 4; ++dt) { const LAS bf16_t* lo = vs + trb + 16 * s * PB + 32 * dt; af[s][dt] = tr_frag(lo, lo + 8 * PB); }
        asm volatile("s_waitcnt lgkmcnt(0)" ::: "memory"); __builtin_amdgcn_sched_barrier(0);
        __builtin_amdgcn_s_setprio(1);
#pragma unroll
        for (int s = 0; s < 2; ++s) {
            const u32x4 pwv = {pw[4 * s], pw[4 * s + 1], pw[4 * s + 2], pw[4 * s + 3]};
            const bf16x8 bfrag = __builtin_bit_cast(bf16x8, pwv);
#pragma unroll
            for (int dt = 0; dt < 4; ++dt) acc[dt] = MFMA32(af[s][dt], bfrag, acc[dt]);
        }
        __builtin_amdgcn_s_setprio(0);
        if (t < 0) break;
        if (__all(later > 150.1f)) break;
        t = tn;
    }
    if (!metaq || c < NMETA) {
        bf16_t* orow = z + zrowU(qrow0, 32) + zlaneRC(c, hh * 128 + 4 * h);
        const bf16_t* grow = z + zrowU(qrow0, 32) + zlaneRC(c, 6144 + hh * 128 + 4 * h);
#pragma unroll
        for (int dt = 0; dt < 4; ++dt)
#pragma unroll
            for (int g = 0; g < 4; ++g) {
                const int d0 = (dt << 9) | (g << 7);
                const u32x2 gv = *(const u32x2*)(grow + d0);
                u32x2 o; o.x = pk2(silu_mul(acc[dt][4 * g], bf_lo(gv.x)), silu_mul(acc[dt][4 * g + 1], bf_hi(gv.x)));
                o.y = pk2(silu_mul(acc[dt][4 * g + 2], bf_lo(gv.y)), silu_mul(acc[dt][4 * g + 3], bf_hi(gv.y)));
                *(u32x2*)(orow + d0) = o;
            }
    }
}

template <bool MASKED>
DI bool attnA_tile_math(const f32x16& Su, const LAS float* bt, int qpos, int kpos0, int kvalid, bool meta_tile, int h, int lane, float& m, float& l, float& corr, bf16x8 (&bfrag)[2]) {
    float sc[16]; float tmax = -1e30f;
#pragma unroll
    for (int r = 0; r < 16; ++r) {
        const int row = (r & 3) + 8 * (r >> 2) + 4 * h;
        const int dist = qpos - (kpos0 + row);
        if (MASKED) {
            const bool vis = (row < kvalid) && (dist >= 0) && (meta_tile || dist < 128);
            const int di = dist < 0 ? 0 : (dist > 128 ? 128 : dist);
            const float v = Su[r] * (0.125f * 1.4426950408889634f) + bt[di];
            sc[r] = vis ? v : -1e30f;
        } else sc[r] = Su[r] * (0.125f * 1.4426950408889634f) + bt[dist];
        tmax = fmaxf(tmax, sc[r]);
    }
    tmax = fmaxf(tmax, shflx(tmax, 32, lane));
    const bool resc = __any(tmax > m + 16.0f);
    float mnew = m; corr = 1.0f;
    if (resc) { mnew = fmaxf(m, tmax); corr = __builtin_amdgcn_exp2f(m - mnew); }
    float pr[16]; float psum = 0.f;
#pragma unroll
    for (int r = 0; r < 16; ++r) { pr[r] = __builtin_amdgcn_exp2f(sc[r] - mnew); psum += pr[r]; }
    psum += shflx(psum, 32, lane);
    l = l * corr + psum; m = mnew;
#pragma unroll
    for (int s = 0; s < 2; ++s) {
        u32x4 pw; pw.x = pk2(pr[8 * s], pr[8 * s + 1]); pw.y = pk2(pr[8 * s + 2], pr[8 * s + 3]); pw.z = pk2(pr[8 * s + 4], pr[8 * s + 5]); pw.w = pk2(pr[8 * s + 6], pr[8 * s + 7]);
        bfrag[s] = __builtin_bit_cast(bf16x8, pw);
    }
    return resc;
}

DI void attnA_item(bf16_t* z, const float* sinks, int hp, int qs, LAS bf16_t* vs, const LAS float* btab, int lane) {
    const int c = lane & 31, h = lane >> 5, kvh = hp >> 2;
    const bool metaq = qs < 0;
    const int qrow = metaq ? SEQ + c : 32 * qs + c;
    const int qpos = metaq ? (c < NMETA ? c : 0) : NMETA + 32 * qs + c;
    const int trb = (4 * h + ((lane & 15) >> 2)) * PA + 16 * ((lane >> 4) & 1) + 4 * (lane & 3);
    const int qrow0 = metaq ? SEQ : 32 * qs;
    LAS bf16x8* qs_lds = (LAS bf16x8*)(vs + 32 * PA) + lane;
    { bf16x8 qf[2][4];
#pragma unroll
      for (int u = 0; u < 2; ++u) { const bf16_t* qp = z + zrowU(qrow0, 18) + zlaneRC(c, (2 * hp + u) * 64 + 8 * h);
#pragma unroll
        for (int s = 0; s < 4; ++s) qf[u][s] = *(const bf16x8*)(qp + (((s >> 1) << 9) | ((s & 1) << 8))); }
      asm volatile("s_waitcnt lgkmcnt(0)" ::: "memory");
#pragma unroll
      for (int u = 0; u < 2; ++u)
#pragma unroll
        for (int s = 0; s < 4; ++s) qs_lds[64 * (4 * u + s)] = qf[u][s]; }
    f32x16 acc[2][2];
#pragma unroll
    for (int u = 0; u < 2; ++u)
#pragma unroll
        for (int dt = 0; dt < 2; ++dt)
#pragma unroll
            for (int i = 0; i < 16; ++i) acc[u][dt][i] = 0.f;
    float m[2] = {sinks[2 * hp] * 1.4426950408889634f, sinks[2 * hp + 1] * 1.4426950408889634f}, l[2] = {1.0f, 1.0f};
    const int tlo = metaq ? 0 : (qs - 4 > 0 ? qs - 4 : 0), thi = metaq ? -1 : qs;
    const bf16_t* kbase = z + zlaneRC(c, 2048 + kvh * 64 + 8 * h);
    const bf16_t* vbase = z + zlaneRC(lane & 15, 2304 + kvh * 64 + 8 * (lane >> 4));
    bf16x8 kf[4]; u32x4 vv[4];
    int t = -1;
    { const size_t ro = zrowU(SEQ, 18);
#pragma unroll
      for (int s = 0; s < 4; ++s) kf[s] = *(const bf16x8*)(kbase + ro + (((s >> 1) << 9) | ((s & 1) << 8)));
#pragma unroll
      for (int i = 0; i < 4; ++i) vv[i] = *(const u32x4*)(vbase + ro + (((i >> 1) << 13) | ((i & 1) << 9))); }
    for (;;) {
        const int kpos0 = t < 0 ? 0 : NMETA + 32 * t, kvalid = t < 0 ? NMETA : 32;
        const bool lastt = metaq || t == thi;
        const bool interior = !metaq && t >= 0 && t > qs - 4 && t < qs;
        const int tn = lastt ? t : (t < 0 ? tlo : t + 1);
        const size_t ron = zrowU(tn < 0 ? SEQ : 32 * tn, 18);
        bf16x8 bfrag[2][2];
#pragma unroll
        for (int u = 0; u < 2; ++u) {
            f32x16 Su; bf16x8 qf[4];
#pragma unroll
            for (int i = 0; i < 16; ++i) Su[i] = 0.f;
#pragma unroll
            for (int s = 0; s < 4; ++s) qf[s] = qs_lds[64 * (4 * u + s)];
            asm volatile("s_waitcnt lgkmcnt(0)" ::: "memory"); __builtin_amdgcn_sched_barrier(0);
            __builtin_amdgcn_s_setprio(1);
#pragma unroll
            for (int s = 0; s < 4; ++s) Su = MFMA32(kf[s], qf[s], Su);
            __builtin_amdgcn_s_setprio(0);
            if (u == 1) {
#pragma unroll
                for (int s = 0; s < 4; ++s) kf[s] = *(const bf16x8*)(kbase + ron + (((s >> 1) << 9) | ((s & 1) << 8)));
            }
            const LAS float* bt = btab + (2 * hp + u) * 129;
            float corr; bool resc;
            if (interior) resc = attnA_tile_math<false>(Su, bt, qpos, kpos0, kvalid, t < 0, h, lane, m[u], l[u], corr, bfrag[u]);
            else resc = attnA_tile_math<true>(Su, bt, qpos, kpos0, kvalid, t < 0, h, lane, m[u], l[u], corr, bfrag[u]);
            if (resc) {
#pragma unroll
                for (int dt = 0; dt < 2; ++dt)
#pragma unroll
                    for (int i = 0; i < 16; ++i) acc[u][dt][i] *= corr;
            }
        }
        asm volatile("s_waitcnt lgkmcnt(0)" ::: "memory");
#pragma unroll
        for (int i = 0; i < 4; ++i) *(LAS u32x4*)(vs + (16 * (i >> 1) + (lane & 15)) * PA + 32 * (i & 1) + 8 * (lane >> 4)) = vv[i];
#pragma unroll
        for (int i = 0; i < 4; ++i) vv[i] = *(const u32x4*)(vbase + ron + (((i >> 1) << 13) | ((i & 1) << 9)));
        asm volatile("s_waitcnt lgkmcnt(0)" ::: "memory");
        bf16x8 af[2][2];
#pragma unroll
        for (int s = 0; s < 2; ++s)
#pragma unroll
            for (int dt = 0; dt < 2; ++dt) { const LAS bf16_t* lo = vs + trb + 16 * s * PA + 32 * dt; af[s][dt] = tr_frag(lo, lo + 8 * PA); }
        asm volatile("s_waitcnt lgkmcnt(0)" ::: "memory"); __builtin_amdgcn_sched_barrier(0);
        __builtin_amdgcn_s_setprio(1);
#pragma unroll
        for (int s = 0; s < 2; ++s)
#pragma unroll
            for (int dt = 0; dt < 2; ++dt) {
                acc[0][dt] = MFMA32(af[s][dt], bfrag[0][s], acc[0][dt]);
                acc[1][dt] = MFMA32(af[s][dt], bfrag[1][s], acc[1][dt]);
            }
        __builtin_amdgcn_s_setprio(0);
        if (lastt) break;
        t = tn;
    }
    if (!metaq || c < NMETA) {
#pragma unroll
        for (int u = 0; u < 2; ++u) {
            const float inv = 1.0f / l[u];
            bf16_t* orow = z + zrowU(qrow0, 18) + zlaneRC(c, (2 * hp + u) * 64 + 4 * h);
            const bf16_t* grow = z + zrowU(qrow0, 18) + zlaneRC(c, 2560 + (2 * hp + u) * 64 + 4 * h);
#pragma unroll
            for (int dt = 0; dt < 2; ++dt)
#pragma unroll
                for (int g = 0; g < 4; ++g) {
                    const int d0 = (dt << 9) | (g << 7);
                    const u32x2 gv = *(const u32x2*)(grow + d0);
                    u32x2 o; o.x = pk2(silu_mul(acc[u][dt][4 * g] * inv, bf_lo(gv.x)), silu_mul(acc[u][dt][4 * g + 1] * inv, bf_hi(gv.x)));
                    o.y = pk2(silu_mul(acc[u][dt][4 * g + 2] * inv, bf_lo(gv.y)), silu_mul(acc[u][dt][4 * g + 3] * inv, bf_hi(gv.y)));
                    *(u32x2*)(orow + d0) = o;
                }
        }
    }
}

constexpr int NQS = SEQ / 32;

struct AttnQueue { unsigned* heads; int x; int cur; };
DI bool attn_next(AttnQueue& q, int lane0, int& qs, int& hd) {
    for (;;) {
        if (q.cur >= 8) return false;
        const int xq = (q.x + q.cur) & 7;
        const int nqs = NQS / 8 + (xq == 7 ? 1 : 0);
        unsigned n = 0;
        if (lane0) n = __hip_atomic_fetch_add(q.heads + 64 * xq, 1u, __ATOMIC_RELAXED, __HIP_MEMORY_SCOPE_AGENT);
        n = (unsigned)__builtin_amdgcn_readfirstlane((int)n);
        if (n < (unsigned)(nqs * 16)) { qs = (NQS / 8) * xq + (int)(n >> 4); hd = (int)(n & 15u); return true; }
        ++q.cur;
    }
}


__global__ void __launch_bounds__(NTHREADS) hybrid_fwd(Params p) {
    extern __shared__ __attribute__((aligned(16))) unsigned char lds_raw[];
    LAS unsigned char* lds = (LAS unsigned char*)lds_raw;
    cg::grid_group grid = cg::this_grid();
    bf16_t* hb = (bf16_t*)(p.ws + WS_HB);
    bf16_t* z = (bf16_t*)(p.ws + WS_Z);
    unsigned* barw = (unsigned*)(p.ws + WS_BAR);
    volatile LAS unsigned* bst = (volatile LAS unsigned*)(lds + LDS_MAIN);
    {
        const int tid = threadIdx.x, lane = tid & 63, wave = __builtin_amdgcn_readfirstlane(tid >> 6);
        const int G = gridDim.x, gw = blockIdx.x * NWAVES + wave, NGW = G * NWAVES;
        if (tid < 2) bst[tid] = 0u;
        if (blockIdx.x == 0) { for (int i = tid; i < XCD_BAR_WORDS; i += NTHREADS) barw[i] = 0u; for (int i = tid; i < 4 * 8 * 64; i += NTHREADS) ((unsigned*)(p.ws + WS_Q))[i] = 0u; }
        phase_p0(p, lds, gw, NGW, wave, lane);
    }
    grid.sync();
    const int wave_s = __builtin_amdgcn_readfirstlane(threadIdx.x >> 6);
    const XcdBarrier xb = xcd_barrier_post(barw, bst);
#define GSYNC() xcd_barrier(xb, wave_s)

#define PHASE_IDS() int lane = lane_id_fresh(); int wave = wave_s; asm volatile("" : "+s"(wave)); \
        int bid = blockIdx.x; asm volatile("" : "+s"(bid)); int G = gridDim.x; asm volatile("" : "+s"(G)); \
        const int tid = wave * 64 + lane, gw = bid * NWAVES + wave, NGW = G * NWAVES; (void)tid; (void)gw; (void)NGW
#pragma unroll 1
    for (int layer = 0; layer < DEPTH; ++layer) {
        const int j = layer >> 1;
        const bool isA = (layer & 1) == 0;
        {
            PHASE_IDS();
            const int N = isA ? NA : NB;
            const bf16_t* wt = isA ? (const bf16_t*)(p.ws + WS_W + j * WPAIR + WO_INA) : (const bf16_t*)(p.ws + WS_W + j * WPAIR + WO_INB);
            pg8::StaticOrder S; S.init(SEQ, N, G, bid);
            pg8::Gemm g{hb, wt, SEQ, N, D, D, 0};
            pg8::EpiBf16 E{z, 0, N / 256}; pg8::gemm_phase<pg8::EpiBf16>(lds, g, S, E, tid);
            meta_gemm<false>(hb + (size_t)SEQ * D, D, wt, N, z, 0, N / 256, lds, bid, G, wave, lane);
        }
        GSYNC();
        if (isA) {
            PHASE_IDS();
            LAS float* btab = (LAS float*)(lds + 8 * 14336);
            for (int idx = tid; idx < 32 * 129; idx += NTHREADS) {
                const int hd = idx / 129, d = idx % 129;
                int bucket = d;
                if (d >= 16) { bucket = 16 + (int)(logf((float)d * (1.0f / 16.0f)) / 2.0794415416798357f * 16.0f); bucket = bucket > 31 ? 31 : bucket; }
                btab[idx] = p.rel_bias[bucket * 32 + hd] * 1.4426950408889634f;
            }
            __syncthreads();
            LAS bf16_t* vs = (LAS bf16_t*)(lds + wave * 14336);
            const float* sinks = p.sinks_a + j * 32;
            AttnQueue aq{(unsigned*)(p.ws + WS_Q) + layer * 8 * 64, (int)(xb.x & 7u), 0}; int qs, hd;
            while (attn_next(aq, lane_id_fresh() == 0, qs, hd)) attnA_item(z, sinks, hd, qs == NQS ? -1 : qs, vs, btab, lane_id_fresh());
        } else {
            PHASE_IDS();
            LAS bf16_t* vs = (LAS bf16_t*)(lds + wave * (VS_BYTES + 8192));
            AttnQueue aq{(unsigned*)(p.ws + WS_Q) + layer * 8 * 64, (int)(xb.x & 7u), 0}; int qs, hd;
            while (attn_next(aq, lane_id_fresh() == 0, qs, hd)) attnB_item(z, hd, qs == NQS ? -1 : qs, vs, lane_id_fresh());
        }
        GSYNC();
        {
            PHASE_IDS();
            const int znt = isA ? NA / 256 : NB / 256;
            pg8::StaticOrder S; S.init(SEQ, D, G, bid);
            const bf16_t* wt = isA ? (const bf16_t*)(p.ws + WS_W + j * WPAIR + WO_OUTA) : (const bf16_t*)(p.ws + WS_W + j * WPAIR + WO_OUTB);
            pg8::Gemm g{z, wt, SEQ, D, D, 0, znt};
            pg8::EpiBf16 E{hb, D, 0}; pg8::gemm_phase<pg8::EpiBf16>(lds, g, S, E, tid);
            if (layer != DEPTH - 1) meta_gemm<true>(z, 0, wt, D, hb, D, znt, lds, bid, G, wave, lane);
        }
        GSYNC();
        {
            PHASE_IDS();
            phase_ln(p, layer, gw, NGW, lane);
        }
        if (layer != DEPTH - 1) GSYNC();
    }
}

extern "C" void kernel_launch(void* const* d_in, const int* in_sizes, int n_in, void* d_out, int out_size, void* d_ws, size_t ws_size, hipStream_t stream) {
    static int grid = 0;
    if (grid == 0) {
        if (n_in != 10 || out_size != SEQ * D || ws_size < WS_END) { fprintf(stderr, "kernel_launch: unexpected shapes (n_in %d out %d ws %zu, need %zu)\n", n_in, out_size, ws_size, (size_t)WS_END); grid = -1; return; }
        int dev = 0, cus = 0, per_cu = 0;
        hipGetDevice(&dev);
        hipDeviceGetAttribute(&cus, hipDeviceAttributeMultiprocessorCount, dev);
        if (hipFuncSetAttribute((const void*)hybrid_fwd, hipFuncAttributeMaxDynamicSharedMemorySize, LDS_BYTES) != hipSuccess) { fprintf(stderr, "kernel_launch: hipFuncSetAttribute failed\n"); grid = -1; return; }
        if (hipOccupancyMaxActiveBlocksPerMultiprocessor(&per_cu, (const void*)hybrid_fwd, NTHREADS, LDS_BYTES) != hipSuccess || per_cu < 1) { fprintf(stderr, "kernel_launch: occupancy query failed (%d)\n", per_cu); (void)hipGetLastError(); per_cu = 1; }
        grid = cus * 1;
    }
    if (grid < 0) return;
    Params p{};
    p.x = (const float*)d_in[0]; p.meta = (const float*)d_in[1]; p.rel_bias = (const float*)d_in[2]; p.w_in_a = (const float*)d_in[3]; p.sinks_a = (const float*)d_in[4];
    p.w_out_a = (const float*)d_in[5]; p.w_in_b = (const float*)d_in[6]; p.w_out_b = (const float*)d_in[7]; p.ln_g = (const float*)d_in[8]; p.ln_b = (const float*)d_in[9];
    p.out = (float*)d_out; p.ws = (unsigned char*)d_ws; p.probe = 1;
    void* args[] = {&p};
    hipError_t e = hipLaunchCooperativeKernel((const void*)hybrid_fwd, dim3(grid), dim3(NTHREADS), args, LDS_BYTES, stream);
    if (e != hipSuccess) fprintf(stderr, "kernel_launch: cooperative launch failed: %s (grid %d)\n", hipGetErrorString(e), grid);
}
```

```cpp
#include <hip/hip_runtime.h>
#include <hip/hip_cooperative_groups.h>
#include <cstdio>
namespace cg = cooperative_groups;

#define LAS __attribute__((address_space(3)))
#define DI __device__ __forceinline__
typedef unsigned short bf16_t;
typedef short bf16x8 __attribute__((ext_vector_type(8)));
typedef float f32x2 __attribute__((ext_vector_type(2)));
typedef float f32x4 __attribute__((ext_vector_type(4)));
typedef float f32x16 __attribute__((ext_vector_type(16)));
typedef unsigned u32x2 __attribute__((ext_vector_type(2)));
typedef unsigned u32x4 __attribute__((ext_vector_type(4)));
typedef __bf16 bf16v2 __attribute__((ext_vector_type(2)));

constexpr int D = 2048, SEQ = 16384, NMETA = 16, LTOK = SEQ + NMETA, MPAD = SEQ + 256;
constexpr int NA = 4608, NB = 8192, DEPTH = 4;
constexpr int NTHREADS = 512, NWAVES = 8;
constexpr int LDS_MAIN = 147456, LDS_BYTES = LDS_MAIN + 16;
constexpr float LN_EPS = 1e-5f;
constexpr float DN_ALPHA = 1.6817928305074290f;

constexpr size_t WS_W = 0;
constexpr size_t WPAIR = (size_t)(NA + D + NB + D) * D * 2;
constexpr size_t WO_INA = 0, WO_OUTA = (size_t)NA * D * 2, WO_INB = WO_OUTA + (size_t)D * D * 2, WO_OUTB = WO_INB + (size_t)NB * D * 2;
constexpr size_t WS_HB = WS_W + 2 * WPAIR;
constexpr size_t WS_Z = WS_HB + (size_t)MPAD * D * 2;
constexpr size_t WS_BAR = WS_Z + (size_t)MPAD * NB * 2;
static_assert((size_t)LTOK * D * 2 <= WPAIR, "the fp16 residual stream must fit in the first layer pair's weight region");
constexpr size_t WS_Q = WS_BAR + 16384;
constexpr size_t WS_END = WS_Q + 4 * 8 * 256;

DI unsigned pk2(float a, float b) { f32x2 v = {a, b}; bf16v2 r = __builtin_convertvector(v, bf16v2); return __builtin_bit_cast(unsigned, r); }
typedef _Float16 h16v2 __attribute__((ext_vector_type(2)));
DI unsigned pkh2(float a, float b) { f32x2 v = {a, b}; h16v2 r = __builtin_convertvector(v, h16v2); return __builtin_bit_cast(unsigned, r); }
DI float h_lo(unsigned u) { return (float)__builtin_bit_cast(h16v2, u)[0]; }
DI float h_hi(unsigned u) { return (float)__builtin_bit_cast(h16v2, u)[1]; }
DI float bf_lo(unsigned u) { return __uint_as_float(u << 16); }
DI float bf_hi(unsigned u) { return __uint_as_float(u & 0xffff0000u); }
DI float shflx(float v, int mask, int lane) { return __int_as_float(__builtin_amdgcn_ds_bpermute((lane ^ mask) << 2, __float_as_int(v))); }
DI int lane_id_fresh() { unsigned zero; asm volatile("v_mov_b32 %0, 0" : "=v"(zero)); return (int)__builtin_amdgcn_mbcnt_hi(~0u, __builtin_amdgcn_mbcnt_lo(~0u, zero)); }
DI float wave_sum(float v, int lane) {
#pragma unroll
    for (int o = 1; o < 64; o <<= 1) v += shflx(v, o, lane);
    return v;
}


DI size_t zrowU(int row0, int NT) { return ((size_t)((row0 >> 8) * NT) << 16) + (size_t)((((row0 >> 7) & 1) << 15) | (((row0 >> 5) & 1) << 14) | (((row0 >> 6) & 1) << 11)); }
DI unsigned zlaneRC(int r5, int col) { return (unsigned)(((col >> 8) << 16) | ((r5 >> 4) << 13) | (((col >> 7) & 1) << 12) | (((col >> 5) & 3) << 9) | (((col >> 3) & 3) << 7) | ((r5 & 15) << 3) | (col & 7)); }

namespace pg8 {
constexpr int BM = 256, BK = 64, HALF = 128, HTB = HALF * BK * 2, NXCD = 8, WGM = 8;
DI int lds_byte(int r, int c) { const int st = (r >> 4) * 2 + (c >> 5), rr = r & 15, cc = c & 31, ob = rr * 64 + cc * 2; return st * 1024 + (ob ^ (((ob >> 9) & 1) << 5)); }
DI void stage_rc(int b, int& R, int& C) { const int st = b / 1024, sb = b % 1024, swz = sb ^ (((sb >> 9) & 1) << 5); R = (st >> 1) * 16 + swz / 64; C = (st & 1) * 32 + (swz % 64) / 2; }
DI int perm32(int rho) { const int n = rho >> 4, i = rho & 15; return 8 * (i >> 2) + 4 * n + (i & 3); }

struct Unit { int pm, pn; };
struct Gemm { const bf16_t* A; const bf16_t* Bt; int M, N, K, lda; int ant; };

struct StaticOrder {
    int nM, nN, nwg, G, c;
    DI void init(int M, int N, int G_, int c_) { nM = M / BM; nN = N / BM; nwg = nM * nN; G = G_; c = c_; }
    DI bool next(int i, Unit& u) const {
        const long L = (long)i * G + c; if (L >= nwg) return false;
        int wgid = (int)L; { const int q = nwg / NXCD, r = nwg % NXCD, xcd = wgid % NXCD, off = wgid / NXCD; wgid = (xcd < r ? xcd * (q + 1) : r * (q + 1) + (xcd - r) * q) + off; }
        const int nig = WGM * nN, gid = wgid / nig, fm = gid * WGM, gsz = (nM - fm) < WGM ? (nM - fm) : WGM;
        u.pm = fm + ((wgid % nig) % gsz); u.pn = (wgid % nig) / gsz; return true;
    }
};

struct EpiBf16 {
    static constexpr bool PERM = true;
    bf16_t* O; int ldc; int nt;
    DI void operator()(const f32x4 (&acc)[2][2][4][2], const Unit& u, int wr, int wc, int fr, int fq) const {
        if (nt) {
            unsigned char* tb = (unsigned char*)O + ((size_t)(u.pm * nt + u.pn) << 17) + (wr * 4 + wc) * 1024 + (fq * 16 + fr) * 16;
#pragma unroll
            for (int ai = 0; ai < 2; ++ai)
#pragma unroll
                for (int m = 0; m < 4; ++m)
#pragma unroll
                    for (int bj = 0; bj < 2; ++bj) { const f32x4 v0 = acc[ai][bj][m][0], v1 = acc[ai][bj][m][1];
                        u32x4 w; w.x = pk2(v0[0], v0[1]); w.y = pk2(v0[2], v0[3]); w.z = pk2(v1[0], v1[1]); w.w = pk2(v1[2], v1[3]);
                        *(u32x4*)(tb + ((ai * 4 + m) * 2 + bj) * 8192) = w; }
            return;
        }
        const int row0 = u.pm * BM + wr * 64 + fr; const int col0 = u.pn * BM + wc * 32 + 8 * fq;
#pragma unroll
        for (int ai = 0; ai < 2; ++ai)
#pragma unroll
            for (int m = 0; m < 4; ++m) { bf16_t* rowp = O + (size_t)(row0 + ai * HALF + m * 16) * ldc + col0;
#pragma unroll
                for (int bj = 0; bj < 2; ++bj) { const f32x4 v0 = acc[ai][bj][m][0], v1 = acc[ai][bj][m][1];
                    u32x4 w; w.x = pk2(v0[0], v0[1]); w.y = pk2(v0[2], v0[3]); w.z = pk2(v1[0], v1[1]); w.w = pk2(v1[2], v1[3]);
                    *(u32x4*)(rowp + bj * HALF) = w; } }
    }
};

template <class Epi>
DI void gemm_phase(LAS unsigned char* lds, const Gemm g, const StaticOrder& S, const Epi& E, const int tid) {
    const int wid = __builtin_amdgcn_readfirstlane(tid >> 6), lane = tid & 63, wr = wid >> 2, wc = wid & 3, fr = lane & 15, fq = lane >> 4;
    const int K = g.K, nt = K / BK, lda = g.lda;
    unsigned voffA[2], voffB[2];
#pragma unroll
    for (int i = 0; i < 2; ++i) { int R, C; stage_rc(tid * 16 + i * 8192, R, C); const int Rb = Epi::PERM ? ((R & ~31) + perm32(R & 31)) : R;
        voffA[i] = g.ant ? (unsigned)((((R >> 4) & 3) << 14) | (((R >> 6) & 1) << 12) | (((C >> 5) & 1) << 10) | (((C >> 3) & 3) << 8) | ((R & 15) << 4)) : (unsigned)(R * lda + C) * 2u;
        voffB[i] = (unsigned)(Rb * K + C) * 2u; }
    const size_t kstep = (size_t)(BK * 2);
    const size_t hstepA = g.ant ? (size_t)65536 : (size_t)HALF * lda * 2, hstepB = (size_t)HALF * K * 2;
    const size_t tstepA = g.ant ? (size_t)g.ant * 131072 : 2 * hstepA, tstepB = 2 * hstepB;
#define PG8_KTA(t) (g.ant ? ((size_t)((t) >> 2) * 131072 + (size_t)((((t) >> 1) & 1) * 8192 + ((t) & 1) * 2048)) : (size_t)(t) * kstep)
    const unsigned ldsw = (unsigned)wid * 1024u;
    const int aoff = lds_byte(wr * 64 + fr, fq * 8), boff = lds_byte(wc * 32 + fr, fq * 8);
#define PG8_SA(b, h) (((b) * 2 + (h)) * HTB)
#define PG8_SB(b, h) ((4 + (b) * 2 + (h)) * HTB)
#define PG8_STAGE(bufoff, gbase, voff) do { _Pragma("unroll") for (int _i = 0; _i < 2; ++_i) \
        __builtin_amdgcn_global_load_lds((const unsigned*)((const char*)(gbase) + (voff)[_i]), (LAS unsigned*)(lds + (bufoff) + ldsw + _i * 8192), 16, 0, 0); } while (0)
#define PG8_LDA(dst, b, h) do { _Pragma("unroll") for (int m = 0; m < 4; ++m) _Pragma("unroll") for (int k = 0; k < 2; ++k) dst[m][k] = *(const LAS bf16x8*)(lds + PG8_SA(b, h) + aoff + m * 2048 + k * 1024); } while (0)
#define PG8_LDB(dst, b, h) do { _Pragma("unroll") for (int n = 0; n < 2; ++n) _Pragma("unroll") for (int k = 0; k < 2; ++k) dst[n][k] = *(const LAS bf16x8*)(lds + PG8_SB(b, h) + boff + n * 2048 + k * 1024); } while (0)
#define PG8_MMA(ai, bj, At, Bt) do { __builtin_amdgcn_s_setprio(1); _Pragma("unroll") for (int m = 0; m < 4; ++m) _Pragma("unroll") for (int n = 0; n < 2; ++n) _Pragma("unroll") for (int k = 0; k < 2; ++k) \
        acc[ai][bj][m][n] = __builtin_amdgcn_mfma_f32_16x16x32_bf16(Bt[n][k], At[m][k], acc[ai][bj][m][n], 0, 0, 0); __builtin_amdgcn_s_setprio(0); } while (0)
#define PG8_WAIT_V(n) asm volatile("s_waitcnt vmcnt(" #n ")" ::: "memory")
#define PG8_WAIT_L(n) asm volatile("s_waitcnt lgkmcnt(" #n ")" ::: "memory")
#define PG8_BAR __builtin_amdgcn_s_barrier()
#define PG8_SCHED __builtin_amdgcn_sched_barrier(0)
    Unit cur, nxt; int ui = 0;
    if (!S.next(0, cur)) return;
    f32x4 acc[2][2][4][2];
#pragma unroll
    for (int a = 0; a < 2; ++a)
#pragma unroll
        for (int b = 0; b < 2; ++b)
#pragma unroll
            for (int m = 0; m < 4; ++m)
#pragma unroll
                for (int n = 0; n < 2; ++n) acc[a][b][m][n] = (f32x4){0.f, 0.f, 0.f, 0.f};
    bf16x8 At[4][2], B0[2][2], B1[2][2];
    const char* cA = (const char*)g.A + (size_t)cur.pm * tstepA; const char* cB = (const char*)g.Bt + (size_t)cur.pn * tstepB;
    PG8_STAGE(PG8_SB(0, 0), cB, voffB); PG8_STAGE(PG8_SA(0, 0), cA, voffA); PG8_STAGE(PG8_SB(0, 1), cB + hstepB, voffB); PG8_STAGE(PG8_SA(0, 1), cA + hstepA, voffA);
    if (wr == 1) PG8_BAR;
    PG8_WAIT_V(4); PG8_BAR;
    PG8_STAGE(PG8_SB(1, 0), cB + kstep, voffB); PG8_STAGE(PG8_SA(1, 0), cA + PG8_KTA(1), voffA); PG8_STAGE(PG8_SB(1, 1), cB + hstepB + kstep, voffB);
    PG8_WAIT_V(6); PG8_BAR;
    for (;;) {
        const bool has_next = S.next(ui + 1, nxt);
        const char* nA = has_next ? (const char*)g.A + (size_t)nxt.pm * tstepA : cA; const char* nB = has_next ? (const char*)g.Bt + (size_t)nxt.pn * tstepB : cB;
        for (int t = 0; t < nt; t += 2) {
            const bool last = (t == nt - 2);
            const char* a1 = cA + PG8_KTA(t + 1);
            const char* a2 = last ? nA : cA + PG8_KTA(t + 2); const char* b2 = last ? nB : cB + (size_t)(t + 2) * kstep;
            const char* a3 = last ? nA + PG8_KTA(1) : cA + PG8_KTA(t + 3); const char* b3 = b2 + kstep;
            PG8_LDB(B0, 0, 0); PG8_SCHED; PG8_LDA(At, 0, 0); PG8_STAGE(PG8_SA(1, 1), a1 + hstepA, voffA);
            PG8_WAIT_L(8); PG8_BAR; PG8_WAIT_L(0); PG8_MMA(0, 0, At, B0); PG8_BAR; PG8_SCHED;
            PG8_LDB(B1, 0, 1); PG8_STAGE(PG8_SB(0, 0), b2, voffB);
            PG8_BAR; PG8_WAIT_L(0); PG8_MMA(0, 1, At, B1); PG8_BAR;
            PG8_LDA(At, 0, 1); PG8_STAGE(PG8_SA(0, 0), a2, voffA);
            PG8_BAR; PG8_WAIT_L(0); PG8_MMA(1, 0, At, B0); PG8_BAR; PG8_SCHED;
            PG8_STAGE(PG8_SB(0, 1), b2 + hstepB, voffB);
            PG8_WAIT_V(6); PG8_BAR; PG8_MMA(1, 1, At, B1); PG8_BAR;
            PG8_LDB(B0, 1, 0); PG8_SCHED; PG8_LDA(At, 1, 0); PG8_STAGE(PG8_SA(0, 1), a2 + hstepA, voffA);
            PG8_WAIT_L(8); PG8_BAR; PG8_WAIT_L(0); PG8_MMA(0, 0, At, B0); PG8_BAR; PG8_SCHED;
            PG8_LDB(B1, 1, 1); PG8_STAGE(PG8_SB(1, 0), b3, voffB);
            PG8_BAR; PG8_WAIT_L(0); PG8_MMA(0, 1, At, B1); PG8_BAR;
            PG8_LDA(At, 1, 1); PG8_STAGE(PG8_SA(1, 0), a3, voffA);
            PG8_BAR; PG8_WAIT_L(0); PG8_MMA(1, 0, At, B0); PG8_BAR; PG8_SCHED;
            PG8_STAGE(PG8_SB(1, 1), b3 + hstepB, voffB);
            PG8_WAIT_V(6); PG8_BAR; PG8_MMA(1, 1, At, B1); PG8_BAR;
        }
        E(acc, cur, wr, wc, fr, fq);
        if (!has_next) break;
#pragma unroll
        for (int a = 0; a < 2; ++a)
#pragma unroll
            for (int b = 0; b < 2; ++b)
#pragma unroll
                for (int m = 0; m < 4; ++m)
#pragma unroll
                    for (int n = 0; n < 2; ++n) acc[a][b][m][n] = (f32x4){0.f, 0.f, 0.f, 0.f};
        cur = nxt; cA = nA; cB = nB; ++ui;
    }
    PG8_WAIT_V(0);
    if (wr == 0) PG8_BAR;
    PG8_BAR;
#undef PG8_KTA
#undef PG8_SA
#undef PG8_SB
#undef PG8_STAGE
#undef PG8_LDA
#undef PG8_LDB
#undef PG8_MMA
#undef PG8_WAIT_V
#undef PG8_WAIT_L
#undef PG8_BAR
#undef PG8_SCHED
}
}


#define XB_TMO      128
#define XB_XCNT(j)  (256  + 64 * (j))
#define XB_XSUB(j)  (1280 + 64 * (j))
#define XB_XGEN(j)  (2304 + 64 * (j))
#define XB_TOP      3328
#define XB_TOPGEN   3392
#define XCD_BAR_WORDS 3456
#define XB_SPIN_CAP (1u << 22)
DI unsigned xb_ld(unsigned* p)              { return __hip_atomic_load(p, __ATOMIC_RELAXED, __HIP_MEMORY_SCOPE_AGENT); }
DI unsigned xb_add(unsigned* p, unsigned v) { return __hip_atomic_fetch_add(p, v, __ATOMIC_RELAXED, __HIP_MEMORY_SCOPE_AGENT); }
DI unsigned xb_xcc_id() { return (unsigned)__builtin_amdgcn_s_getreg((3 << 11) | 20) & 0xFu; }
#define XB_SPIN(cond, bar) do { unsigned _sp = 0; while (cond) { __builtin_amdgcn_s_sleep(1); \
    if ((++_sp & 255u) == 0u) { if (xb_ld(&(bar)[XB_TMO])) break; if (_sp > XB_SPIN_CAP) { atomicAdd(&(bar)[XB_TMO], 1u); break; } } } } while (0)
struct XcdBarrier { unsigned* bar; unsigned x; volatile LAS unsigned* st; };
DI XcdBarrier xcd_barrier_post(unsigned* bar, volatile LAS unsigned* st) {
    XcdBarrier b; b.bar = bar; b.x = xb_xcc_id(); b.st = st;
    if (threadIdx.x == 0) (void)xb_add(&bar[XB_XCNT(b.x)], 1u);
    return b;
}
DI void xcd_barrier_complete(unsigned* bar, unsigned x, unsigned& nloc, unsigned& nx) {
    const unsigned G = gridDim.x;
    unsigned sum, cnt, mine, sp = 0u;
    for (;;) {
        sum = 0u; cnt = 0u; mine = 0u;
#pragma unroll
        for (unsigned j = 0; j < 16; ++j) { const unsigned c = xb_ld(&bar[XB_XCNT(j)]); sum += c; cnt += (c > 0u) ? 1u : 0u; mine = (j == x) ? c : mine; }
        if (sum == G) break;
        __builtin_amdgcn_s_sleep(1);
        if ((++sp & 255u) == 0u) { if (xb_ld(&bar[XB_TMO])) break; if (sp > XB_SPIN_CAP) { atomicAdd(&bar[XB_TMO], 1u); break; } }
    }
    nloc = mine > 0u ? mine : 1u; nx = cnt > 0u ? cnt : 1u;
}
DI void xcd_barrier(const XcdBarrier& b, int wave_s) {
    asm volatile("s_waitcnt vmcnt(0)" ::: "memory");
    __syncthreads();
    if (wave_s == 0 && lane_id_fresh() == 0) {
        unsigned* bar = b.bar;
        __builtin_amdgcn_s_waitcnt(0);
        unsigned nloc = b.st[0], nx = b.st[1];
        if (nloc == 0u) { xcd_barrier_complete(bar, b.x, nloc, nx); b.st[0] = nloc; b.st[1] = nx; }
        const unsigned old = xb_add(&bar[XB_XSUB(b.x)], 1u);
        const unsigned gen = old / nloc;
        if (old + 1u == (gen + 1u) * nloc) {
            __builtin_amdgcn_fence(__ATOMIC_RELEASE, "agent");
            asm volatile("s_waitcnt vmcnt(0)" ::: "memory");
            const unsigned og = xb_add(&bar[XB_TOP], 1u);
            const unsigned tg = og / nx;
            if (og + 1u == (tg + 1u) * nx) xb_add(&bar[XB_TOPGEN], 1u);
            else XB_SPIN(xb_ld(&bar[XB_TOPGEN]) == tg, bar);
            __builtin_amdgcn_fence(__ATOMIC_ACQUIRE, "agent");
            xb_add(&bar[XB_XGEN(b.x)], 1u);
            asm volatile("s_waitcnt vmcnt(0)" ::: "memory");
        } else {
            XB_SPIN(xb_ld(&bar[XB_XGEN(b.x)]) == gen, bar);
            __builtin_amdgcn_fence(__ATOMIC_ACQUIRE, "agent");
            asm volatile("s_waitcnt vmcnt(0)" ::: "memory");
        }
    }
    __syncthreads();
}

template <bool TILED_IN>
DI void meta_gemm(const bf16_t* am, int lda, const bf16_t* Wt, int N, bf16_t* zo, int ldzo, int nt, LAS unsigned char* lds, int bid, int G, int wave, int lane) {
    const int ntasks = N / 16, r = lane & 15, q = lane >> 4, kq = wave & 3;
    LAS f32x4* part = (LAS f32x4*)lds;
    for (int t0 = 2 * (G - 1 - bid); t0 < ntasks; t0 += 2 * G) {
        const int task = t0 + (wave >> 2), n0 = task * 16;
        const bf16_t* ap = Wt + (size_t)(n0 + r) * D + 8 * q + 512 * kq;
        const bf16_t* bp = TILED_IN ? am + zrowU(SEQ, nt) + zlaneRC(r, 512 * kq + 8 * q) : am + (size_t)r * lda + 8 * q + 512 * kq;
        f32x4 acc = {0.f, 0.f, 0.f, 0.f};
        if (task < ntasks) {
#pragma unroll
            for (int k = 0; k < 16; ++k) { const bf16x8 a = *(const bf16x8*)(ap + 32 * k);
                const bf16x8 b = *(const bf16x8*)(bp + (TILED_IN ? (((k >> 3) << 16) | (((k >> 2) & 1) << 12) | ((k & 3) << 9)) : 32 * k));
                acc = __builtin_amdgcn_mfma_f32_16x16x32_bf16(a, b, acc, 0, 0, 0); }
        }
        part[wave * 64 + lane] = acc;
        __syncthreads();
        if (kq == 0 && task < ntasks) {
            const f32x4 t = (part[wave * 64 + lane] + part[(wave + 1) * 64 + lane]) + (part[(wave + 2) * 64 + lane] + part[(wave + 3) * 64 + lane]);
            u32x2 w; w.x = pk2(t[0], t[1]); w.y = pk2(t[2], t[3]);
            if (TILED_IN) *(u32x2*)(zo + (size_t)(SEQ + r) * ldzo + n0 + 4 * q) = w;
            else *(u32x2*)(zo + zrowU(SEQ, nt) + zlaneRC(r, n0 + 4 * q)) = w;
        }
        __syncthreads();
    }
}

DI void p0_transpose_item(const float* W, int K, int N, bf16_t* WT, LAS float* scr, int item, int lane) {
    const int nblk = N / 32, kb = item / nblk, nb = item % nblk, k0 = 128 * kb, n0 = 32 * nb;
    const int n4 = lane & 7, kr = lane >> 3;
    f32x4 v[16];
#pragma unroll
    for (int i = 0; i < 16; ++i) v[i] = *(const f32x4*)(W + (size_t)(k0 + kr + 8 * i) * N + n0 + 4 * n4);
#pragma unroll
    for (int i = 0; i < 16; ++i) { LAS float* d = scr + (kr + 8 * i) * 33 + 4 * n4; d[0] = v[i][0]; d[1] = v[i][1]; d[2] = v[i][2]; d[3] = v[i][3]; }
    asm volatile("s_waitcnt lgkmcnt(0)" ::: "memory");
    const int c = lane & 15;
#pragma unroll
    for (int j = 0; j < 8; ++j) { const int n = (lane >> 4) + 4 * j; const LAS float* s = scr + (8 * c) * 33 + n;
        u32x4 o; o.x = pk2(s[0 * 33], s[1 * 33]); o.y = pk2(s[2 * 33], s[3 * 33]); o.z = pk2(s[4 * 33], s[5 * 33]); o.w = pk2(s[6 * 33], s[7 * 33]);
        *(u32x4*)(WT + (size_t)(n0 + n) * K + k0 + 8 * c) = o; }
    asm volatile("s_waitcnt lgkmcnt(0)" ::: "memory");
}

struct Params {
    const float* x; const float* meta; const float* rel_bias; const float* w_in_a; const float* sinks_a; const float* w_out_a;
    const float* w_in_b; const float* w_out_b; const float* ln_g; const float* ln_b;
    float* out; unsigned char* ws; int probe; int pad;
};


DI void phase_p0(const Params& p, LAS unsigned char* lds, int gw, int NGW, int wave, int lane) {
    LAS float* scr = (LAS float*)(lds + wave * 16896);
    constexpr int I_INA = (D / 128) * (NA / 32), I_OUT = (D / 128) * (D / 32), I_INB = (D / 128) * (NB / 32);
    constexpr int NITEMS = 2 * (I_INA + I_OUT + I_INB + I_OUT);
    for (int it = gw; it < NITEMS; it += NGW) {
        int r = it;
        if (r < 2 * I_INA) { const int j = r / I_INA; p0_transpose_item(p.w_in_a + (size_t)j * D * NA, D, NA, (bf16_t*)(p.ws + WS_W + j * WPAIR + WO_INA), scr, r % I_INA, lane); continue; } r -= 2 * I_INA;
        if (r < 2 * I_OUT) { const int j = r / I_OUT; p0_transpose_item(p.w_out_a + (size_t)j * D * D, D, D, (bf16_t*)(p.ws + WS_W + j * WPAIR + WO_OUTA), scr, r % I_OUT, lane); continue; } r -= 2 * I_OUT;
        if (r < 2 * I_INB) { const int j = r / I_INB; p0_transpose_item(p.w_in_b + (size_t)j * D * NB, D, NB, (bf16_t*)(p.ws + WS_W + j * WPAIR + WO_INB), scr, r % I_INB, lane); continue; } r -= 2 * I_INB;
        { const int j = r / I_OUT; p0_transpose_item(p.w_out_b + (size_t)j * D * D, D, D, (bf16_t*)(p.ws + WS_W + j * WPAIR + WO_OUTB), scr, r % I_OUT, lane); }
    }
    bf16_t* hb = (bf16_t*)(p.ws + WS_HB);
    { unsigned char* zb = p.ws + WS_Z;
      for (size_t i = (size_t)(gw * 64 + lane) * 16; i < (size_t)(18 + 32) << 17; i += (size_t)NGW * 64 * 16) {
          unsigned char* dst = i < ((size_t)18 << 17) ? zb + ((size_t)(64 * 18) << 17) + i : zb + ((size_t)(64 * 32) << 17) + (i - ((size_t)18 << 17));
          *(u32x4*)dst = (u32x4){0u, 0u, 0u, 0u}; } }
    for (int r0 = gw; r0 < LTOK; r0 += 2 * NGW) {
        f32x4 v[2][8];
#pragma unroll
        for (int q = 0; q < 2; ++q) { const int r = r0 + q * NGW < LTOK ? r0 + q * NGW : r0;
            const f32x4* src = (const f32x4*)(r < SEQ ? p.x + (size_t)r * D : p.meta + (size_t)(r - SEQ) * D) + 2 * lane;
#pragma unroll
            for (int j = 0; j < 4; ++j) { v[q][2 * j] = src[128 * j]; v[q][2 * j + 1] = src[128 * j + 1]; } }
#pragma unroll
        for (int q = 0; q < 2; ++q) { const int r = r0 + q * NGW; if (r >= LTOK) break;
            u32x4* ob = (u32x4*)(hb + (size_t)r * D) + lane;
#pragma unroll
            for (int j = 0; j < 4; ++j) { const f32x4 a0 = v[q][2 * j], a1 = v[q][2 * j + 1]; u32x4 w; w.x = pk2(a0[0], a0[1]); w.y = pk2(a0[2], a0[3]); w.z = pk2(a1[0], a1[1]); w.w = pk2(a1[2], a1[3]); ob[64 * j] = w; } }
    }
}

DI void phase_ln(const Params& p, int layer, int gw, int NGW, int lane) {
    const float* g = p.ln_g + (size_t)layer * D; const float* b = p.ln_b + (size_t)layer * D;
    bf16_t* hb = (bf16_t*)(p.ws + WS_HB);
    const bool last = layer == DEPTH - 1;
    const int nrows = last ? SEQ : LTOK;
    const unsigned short* h16in = layer == DEPTH - 1 ? (const unsigned short*)(p.ws + WS_W) : (const unsigned short*)p.out;
    unsigned short* h16out = layer == DEPTH - 2 ? (unsigned short*)(p.ws + WS_W) : (unsigned short*)p.out;
    constexpr int R = 2;
    for (int r0 = gw; r0 < nrows; r0 += R * NGW) {
        int rr[R]; bool ok[R];
#pragma unroll
        for (int q = 0; q < R; ++q) { ok[q] = r0 + q * NGW < nrows; rr[q] = ok[q] ? r0 + q * NGW : r0; }
        float v[R][32]; float s1[R], s2[R];
#pragma unroll
        for (int q = 0; q < R; ++q) {
            const u32x4* yb = (const u32x4*)(hb + (size_t)rr[q] * D) + lane;
            u32x4 yv[4];
#pragma unroll
            for (int j = 0; j < 4; ++j) yv[j] = __builtin_nontemporal_load(yb + 64 * j);
            if (layer == 0) {
                const f32x4* src32 = (const f32x4*)(rr[q] < SEQ ? p.x + (size_t)rr[q] * D : p.meta + (size_t)(rr[q] - SEQ) * D) + 2 * lane;
#pragma unroll
                for (int j = 0; j < 4; ++j) { const f32x4 a0 = src32[128 * j], a1 = src32[128 * j + 1];
                    v[q][8 * j + 0] = a0[0]; v[q][8 * j + 1] = a0[1]; v[q][8 * j + 2] = a0[2]; v[q][8 * j + 3] = a0[3];
                    v[q][8 * j + 4] = a1[0]; v[q][8 * j + 5] = a1[1]; v[q][8 * j + 6] = a1[2]; v[q][8 * j + 7] = a1[3]; }
            } else {
                const u32x4* src16 = (const u32x4*)(h16in + (size_t)rr[q] * D) + lane;
#pragma unroll
                for (int j = 0; j < 4; ++j) { const u32x4 hh = __builtin_nontemporal_load(src16 + 64 * j);
                    v[q][8 * j + 0] = h_lo(hh.x); v[q][8 * j + 1] = h_hi(hh.x); v[q][8 * j + 2] = h_lo(hh.y); v[q][8 * j + 3] = h_hi(hh.y);
                    v[q][8 * j + 4] = h_lo(hh.z); v[q][8 * j + 5] = h_hi(hh.z); v[q][8 * j + 6] = h_lo(hh.w); v[q][8 * j + 7] = h_hi(hh.w); }
            }
            float a1 = 0.f, a2 = 0.f;
#pragma unroll
            for (int j = 0; j < 4; ++j) { const unsigned yw[4] = {yv[j].x, yv[j].y, yv[j].z, yv[j].w};
#pragma unroll
                for (int e = 0; e < 4; ++e) { const float u0 = v[q][8 * j + 2 * e] * DN_ALPHA + bf_lo(yw[e]), u1 = v[q][8 * j + 2 * e + 1] * DN_ALPHA + bf_hi(yw[e]);
                    v[q][8 * j + 2 * e] = u0; v[q][8 * j + 2 * e + 1] = u1; a1 += u0 + u1; a2 += u0 * u0 + u1 * u1; } }
            s1[q] = a1; s2[q] = a2;
        }
#pragma unroll
        for (int o = 1; o < 64; o <<= 1)
#pragma unroll
            for (int q = 0; q < R; ++q) { s1[q] += shflx(s1[q], o, lane); s2[q] += shflx(s2[q], o, lane); }
        float mean[R], rstd[R];
#pragma unroll
        for (int q = 0; q < R; ++q) { mean[q] = s1[q] * (1.f / D); const float var = fmaxf(s2[q] * (1.f / D) - mean[q] * mean[q], 0.f); rstd[q] = 1.0f / sqrtf(var + LN_EPS); }
#pragma unroll
        for (int j = 0; j < 4; ++j) {
            const f32x4 g0 = ((const f32x4*)g)[128 * j + 2 * lane], g1 = ((const f32x4*)g)[128 * j + 2 * lane + 1], b0 = ((const f32x4*)b)[128 * j + 2 * lane], b1 = ((const f32x4*)b)[128 * j + 2 * lane + 1];
            const float gg[8] = {g0[0], g0[1], g0[2], g0[3], g1[0], g1[1], g1[2], g1[3]}, bb[8] = {b0[0], b0[1], b0[2], b0[3], b1[0], b1[1], b1[2], b1[3]};
#pragma unroll
            for (int q = 0; q < R; ++q) { if (!ok[q]) continue;
                float y[8];
#pragma unroll
                for (int e = 0; e < 8; ++e) y[e] = (v[q][8 * j + e] - mean[q]) * rstd[q] * gg[e] + bb[e];
                if (last) { f32x4* o = (f32x4*)(p.out + (size_t)rr[q] * D) + 128 * j + 2 * lane; o[0] = (f32x4){y[0], y[1], y[2], y[3]}; o[1] = (f32x4){y[4], y[5], y[6], y[7]}; }
                else { u32x4 hw; hw.x = pkh2(y[0], y[1]); hw.y = pkh2(y[2], y[3]); hw.z = pkh2(y[4], y[5]); hw.w = pkh2(y[6], y[7]);
                       ((u32x4*)(h16out + (size_t)rr[q] * D) + lane)[64 * j] = hw;
                       u32x4 w; w.x = pk2(y[0], y[1]); w.y = pk2(y[2], y[3]); w.z = pk2(y[4], y[5]); w.w = pk2(y[6], y[7]);
                       ((u32x4*)(hb + (size_t)rr[q] * D) + lane)[64 * j] = w; } }
        }
    }
}

#define MFMA32(a, b, c) __builtin_amdgcn_mfma_f32_32x32x16_bf16((a), (b), (c), 0, 0, 0)
DI float silu_mul(float o, float g) { return o * g * __builtin_amdgcn_rcpf(1.0f + __builtin_amdgcn_exp2f(g * -1.4426950408889634f)); }

typedef short s16x4 __attribute__((ext_vector_type(4)));
DI bf16x8 tr_frag(const LAS bf16_t* lo, const LAS bf16_t* hi) {
    const s16x4 a = __builtin_amdgcn_ds_read_tr16_b64_v4i16((LAS s16x4*)lo), b = __builtin_amdgcn_ds_read_tr16_b64_v4i16((LAS s16x4*)hi);
    return __builtin_shufflevector(a, b, 0, 1, 2, 3, 4, 5, 6, 7);
}
constexpr int PB = 160, PA = 96;
constexpr int VS_BYTES = 32 * PB * 2;

template <bool MASKED>
DI void attnB_tile_math(const f32x16& S, int kpos0, int kvalid, int qpos, int h, int lane, float& later, unsigned (&pw)[8]) {
    const float scale2 = 0.08838834764831845f * 1.4426950408889634f;
    float x2[16], sp[16];
#pragma unroll
    for (int r = 0; r < 16; ++r) {
        const float x = S[r] * scale2; x2[r] = x;
        const float e = __builtin_amdgcn_exp2f(-fabsf(x));
        const float v = fmaxf(x, 0.f) + __builtin_amdgcn_logf(1.0f + e);
        if (MASKED) { const int row = (r & 3) + 8 * (r >> 2) + 4 * h; const bool vis = (row < kvalid) && (kpos0 + row < qpos); sp[r] = vis ? v : 0.f; }
        else sp[r] = v;
    }
    float G[4], P[4];
#pragma unroll
    for (int g = 0; g < 4; ++g) { G[g] = (sp[4 * g] + sp[4 * g + 1]) + (sp[4 * g + 2] + sp[4 * g + 3]); P[g] = shflx(G[g], 32, lane); }
    float R[4]; R[3] = 0.f; R[2] = G[3] + P[3]; R[1] = R[2] + (G[2] + P[2]); R[0] = R[1] + (G[1] + P[1]);
    const float total = R[0] + (G[0] + P[0]);
#pragma unroll
    for (int g = 0; g < 4; ++g) {
        float sfx = later + R[g] + (h == 0 ? P[g] : 0.f); float wv[4];
#pragma unroll
        for (int i = 3; i >= 0; --i) {
            const int r = 4 * g + i;
            sfx += sp[r];
            float t = __builtin_amdgcn_exp2f(x2[r] - sfx);
            if (MASKED) { const int row = (r & 3) + 8 * (r >> 2) + 4 * h; const bool vis = (row < kvalid) && (kpos0 + row < qpos); t = vis ? t : 0.f; }
            wv[i] = t;
        }
        pw[2 * g] = pk2(wv[0], wv[1]); pw[2 * g + 1] = pk2(wv[2], wv[3]);
    }
    later += total;
}

DI void attnB_item(bf16_t* z, int hh, int qs, LAS bf16_t* vs, int lane) {
    const int c = lane & 31, h = lane >> 5;
    const bool metaq = qs < 0;
    const int qrow = metaq ? SEQ + c : 32 * qs + c;
    const int qpos = metaq ? (c < NMETA ? c : 0) : NMETA + 32 * qs + c;
    const int trb = (4 * h + ((lane & 15) >> 2)) * PB + 16 * ((lane >> 4) & 1) + 4 * (lane & 3);
    const int qrow0 = metaq ? SEQ : 32 * qs;
    LAS bf16x8* qs_lds = (LAS bf16x8*)(vs + 32 * PB) + lane;
    { const bf16_t* qp = z + zrowU(qrow0, 32) + zlaneRC(c, hh * 128 + 8 * h);
      bf16x8 qf[8];
#pragma unroll
      for (int s = 0; s < 8; ++s) qf[s] = *(const bf16x8*)(qp + (((s >> 1) << 9) | ((s & 1) << 8)));
      asm volatile("s_waitcnt lgkmcnt(0)" ::: "memory");
#pragma unroll
      for (int s = 0; s < 8; ++s) qs_lds[64 * s] = qf[s]; }
    f32x16 acc[4];
#pragma unroll
    for (int dt = 0; dt < 4; ++dt)
#pragma unroll
        for (int i = 0; i < 16; ++i) acc[dt][i] = 0.f;
    float later = 0.f;
    int t = metaq ? -1 : qs;
    const int tfirst = t;
    const bf16_t* kbase = z + zlaneRC(c, 2048 + hh * 128 + 8 * h);
    const bf16_t* vbase = z + zlaneRC(lane & 15, 4096 + hh * 128 + 8 * (lane >> 4));
    bf16x8 kf[8]; u32x4 vv[8];
    { const size_t ro = zrowU(t < 0 ? SEQ : 32 * t, 32);
#pragma unroll
      for (int s = 0; s < 8; ++s) kf[s] = *(const bf16x8*)(kbase + ro + (((s >> 1) << 9) | ((s & 1) << 8)));
#pragma unroll
      for (int i = 0; i < 8; ++i) vv[i] = *(const u32x4*)(vbase + ro + (((i >> 2) << 13) | ((i & 3) << 9))); }
    for (;;) {
        const int kpos0 = t < 0 ? 0 : NMETA + 32 * t, kvalid = t < 0 ? NMETA : 32;
        const int tn = t <= 0 ? -1 : t - 1;
        const size_t ron = zrowU(tn < 0 ? SEQ : 32 * tn, 32);
        f32x16 S; bf16x8 qf[8];
#pragma unroll
        for (int i = 0; i < 16; ++i) S[i] = 0.f;
#pragma unroll
        for (int s = 0; s < 8; ++s) qf[s] = qs_lds[64 * s];
        asm volatile("s_waitcnt lgkmcnt(0)" ::: "memory"); __builtin_amdgcn_sched_barrier(0);
        __builtin_amdgcn_s_setprio(1);
#pragma unroll
        for (int s = 0; s < 8; ++s) S = MFMA32(kf[s], qf[s], S);
        __builtin_amdgcn_s_setprio(0);
#pragma unroll
        for (int s = 0; s < 8; ++s) kf[s] = *(const bf16x8*)(kbase + ron + (((s >> 1) << 9) | ((s & 1) << 8)));
        unsigned pw[8];
        if (t == tfirst || t < 0) attnB_tile_math<true>(S, kpos0, kvalid, qpos, h, lane, later, pw); else attnB_tile_math<false>(S, kpos0, kvalid, qpos, h, lane, later, pw);
        asm volatile("" ::: "memory");
#pragma unroll
        for (int i = 0; i < 8; ++i) *(LAS u32x4*)(vs + (16 * (i >> 2) + (lane & 15)) * PB + 32 * (i & 3) + 8 * (lane >> 4)) = vv[i];
#pragma unroll
        for (int i = 0; i < 8; ++i) vv[i] = *(const u32x4*)(vbase + ron + (((i >> 2) << 13) | ((i & 3) << 9)));
        asm volatile("" ::: "memory");
        bf16x8 af[2][4];
#pragma unroll
        for (int s = 0; s < 2; ++s)
#pragma unroll
            for (int dt = 0; dt < 4; ++dt) { const LAS bf16_t* lo = vs + trb + 16 * s * PB + 32 * dt; af[s][dt] = tr_frag(lo, lo + 8 * PB); }
        asm volatile("s_waitcnt lgkmcnt(0)" ::: "memory"); __builtin_amdgcn_sched_barrier(0);
        __builtin_amdgcn_s_setprio(1);
#pragma unroll
        for (int s = 0; s < 2; ++s) {
            const u32x4 pwv = {pw[4 * s], pw[4 * s + 1], pw[4 * s + 2], pw[4 * s + 3]};
            const bf16x8 bfrag = __builtin_bit_cast(bf16x8, pwv);
#pragma unroll
            for (int dt = 0; dt < 4; ++dt) acc[dt] = MFMA32(af[s][dt], bfrag, acc[dt]);
        }
        __builtin_amdgcn_s_setprio(0);
        if (t < 0) break;
        if (__all(later > 150.1f)) break;
        t = tn;
    }
    if (!metaq || c < NMETA) {
        bf16_t* orow = z + zrowU(qrow0, 32) + zlaneRC(c, hh * 128 + 4 * h);
        const bf16_t* grow = z + zrowU(qrow0, 32) + zlaneRC(c, 6144 + hh * 128 + 4 * h);
#pragma unroll
        for (int dt = 0; dt < 4; ++dt)
#pragma unroll
            for (int g = 0; g < 4; ++g) {
                const int d0 = (dt << 9) | (g << 7);
                const u32x2 gv = *(const u32x2*)(grow + d0);
                u32x2 o; o.x = pk2(silu_mul(acc[dt][4 * g], bf_lo(gv.x)), silu_mul(acc[dt][4 * g + 1], bf_hi(gv.x)));
                o.y = pk2(silu_mul(acc[dt][4 * g + 2], bf_lo(gv.y)), silu_mul(acc[dt][4 * g + 3], bf_hi(gv.y)));
                *(u32x2*)(orow + d0) = o;
            }
    }
}

template <bool MASKED>
DI bool attnA_tile_math(const f32x16& Su, const LAS float* bt, int qpos, int kpos0, int kvalid, bool meta_tile, int h, int lane, float& m, float& l, float& corr, bf16x8 (&bfrag)[2]) {
    float sc[16]; float tmax = -1e30f;
#pragma unroll
    for (int r = 0; r < 16; ++r) {
        const int row = (r & 3) + 8 * (r >> 2) + 4 * h;
        const int dist = qpos - (kpos0 + row);
        if (MASKED) {
            const bool vis = (row < kvalid) && (dist >= 0) && (meta_tile || dist < 128);
            const int di = dist < 0 ? 0 : (dist > 128 ? 128 : dist);
            const float v = Su[r] * (0.125f * 1.4426950408889634f) + bt[di];
            sc[r] = vis ? v : -1e30f;
        } else sc[r] = Su[r] * (0.125f * 1.4426950408889634f) + bt[dist];
        tmax = fmaxf(tmax, sc[r]);
    }
    tmax = fmaxf(tmax, shflx(tmax, 32, lane));
    const bool resc = __any(tmax > m + 16.0f);
    float mnew = m; corr = 1.0f;
    if (resc) { mnew = fmaxf(m, tmax); corr = __builtin_amdgcn_exp2f(m - mnew); }
    float pr[16]; float psum = 0.f;
#pragma unroll
    for (int r = 0; r < 16; ++r) { pr[r] = __builtin_amdgcn_exp2f(sc[r] - mnew); psum += pr[r]; }
    psum += shflx(psum, 32, lane);
    l = l * corr + psum; m = mnew;
#pragma unroll
    for (int s = 0; s < 2; ++s) {
        u32x4 pw; pw.x = pk2(pr[8 * s], pr[8 * s + 1]); pw.y = pk2(pr[8 * s + 2], pr[8 * s + 3]); pw.z = pk2(pr[8 * s + 4], pr[8 * s + 5]); pw.w = pk2(pr[8 * s + 6], pr[8 * s + 7]);
        bfrag[s] = __builtin_bit_cast(bf16x8, pw);
    }
    return resc;
}

DI void attnA_item(bf16_t* z, const float* sinks, int hp, int qs, LAS bf16_t* vs, const LAS float* btab, int lane) {
    const int c = lane & 31, h = lane >> 5, kvh = hp >> 2;
    const bool metaq = qs < 0;
    const int qrow = metaq ? SEQ + c : 32 * qs + c;
    const int qpos = metaq ? (c < NMETA ? c : 0) : NMETA + 32 * qs + c;
    const int trb = (4 * h + ((lane & 15) >> 2)) * PA + 16 * ((lane >> 4) & 1) + 4 * (lane & 3);
    const int qrow0 = metaq ? SEQ : 32 * qs;
    LAS bf16x8* qs_lds = (LAS bf16x8*)(vs + 32 * PA) + lane;
    { bf16x8 qf[2][4];
#pragma unroll
      for (int u = 0; u < 2; ++u) { const bf16_t* qp = z + zrowU(qrow0, 18) + zlaneRC(c, (2 * hp + u) * 64 + 8 * h);
#pragma unroll
        for (int s = 0; s < 4; ++s) qf[u][s] = *(const bf16x8*)(qp + (((s >> 1) << 9) | ((s & 1) << 8))); }
      asm volatile("s_waitcnt lgkmcnt(0)" ::: "memory");
#pragma unroll
      for (int u = 0; u < 2; ++u)
#pragma unroll
        for (int s = 0; s < 4; ++s) qs_lds[64 * (4 * u + s)] = qf[u][s]; }
    f32x16 acc[2][2];
#pragma unroll
    for (int u = 0; u < 2; ++u)
#pragma unroll
        for (int dt = 0; dt < 2; ++dt)
#pragma unroll
            for (int i = 0; i < 16; ++i) acc[u][dt][i] = 0.f;
    float m[2] = {sinks[2 * hp] * 1.4426950408889634f, sinks[2 * hp + 1] * 1.4426950408889634f}, l[2] = {1.0f, 1.0f};
    const int tlo = metaq ? 0 : (qs - 4 > 0 ? qs - 4 : 0), thi = metaq ? -1 : qs;
    const bf16_t* kbase = z + zlaneRC(c, 2048 + kvh * 64 + 8 * h);
    const bf16_t* vbase = z + zlaneRC(lane & 15, 2304 + kvh * 64 + 8 * (lane >> 4));
    bf16x8 kf[4]; u32x4 vv[4];
    int t = -1;
    { const size_t ro = zrowU(SEQ, 18);
#pragma unroll
      for (int s = 0; s < 4; ++s) kf[s] = *(const bf16x8*)(kbase + ro + (((s >> 1) << 9) | ((s & 1) << 8)));
#pragma unroll
      for (int i = 0; i < 4; ++i) vv[i] = *(const u32x4*)(vbase + ro + (((i >> 1) << 13) | ((i & 1) << 9))); }
    for (;;) {
        const int kpos0 = t < 0 ? 0 : NMETA + 32 * t, kvalid = t < 0 ? NMETA : 32;
        const bool lastt = metaq || t == thi;
        const bool interior = !metaq && t >= 0 && t > qs - 4 && t < qs;
        const int tn = lastt ? t : (t < 0 ? tlo : t + 1);
        const size_t ron = zrowU(tn < 0 ? SEQ : 32 * tn, 18);
        bf16x8 bfrag[2][2];
#pragma unroll
        for (int u = 0; u < 2; ++u) {
            f32x16 Su; bf16x8 qf[4];
#pragma unroll
            for (int i = 0; i < 16; ++i) Su[i] = 0.f;
#pragma unroll
            for (int s = 0; s < 4; ++s) qf[s] = qs_lds[64 * (4 * u + s)];
            asm volatile("s_waitcnt lgkmcnt(0)" ::: "memory"); __builtin_amdgcn_sched_barrier(0);
            __builtin_amdgcn_s_setprio(1);
#pragma unroll
            for (int s = 0; s < 4; ++s) Su = MFMA32(kf[s], qf[s], Su);
            __builtin_amdgcn_s_setprio(0);
            if (u == 1) {
#pragma unroll
                for (int s = 0; s < 4; ++s) kf[s] = *(const bf16x8*)(kbase + ron + (((s >> 1) << 9) | ((s & 1) << 8)));
            }
            const LAS float* bt = btab + (2 * hp + u) * 129;
            float corr; bool resc;
            if (interior) resc = attnA_tile_math<false>(Su, bt, qpos, kpos0, kvalid, t < 0, h, lane, m[u], l[u], corr, bfrag[u]);
            else resc = attnA_tile_math<true>(Su, bt, qpos, kpos0, kvalid, t < 0, h, lane, m[u], l[u], corr, bfrag[u]);
            if (resc) {
#pragma unroll
                for (int dt = 0; dt < 2; ++dt)
#pragma unroll
                    for (int i = 0; i < 16; ++i) acc[u][dt][i] *= corr;
            }
        }
        asm volatile("" ::: "memory");
#pragma unroll
        for (int i = 0; i < 4; ++i) *(LAS u32x4*)(vs + (16 * (i >> 1) + (lane & 15)) * PA + 32 * (i & 1) + 8 * (lane >> 4)) = vv[i];
#pragma unroll
        for (int i = 0; i < 4; ++i) vv[i] = *(const u32x4*)(vbase + ron + (((i >> 1) << 13) | ((i & 1) << 9)));
        asm volatile("" ::: "memory");
        bf16x8 af[2][2];
#pragma unroll
        for (int s = 0; s < 2; ++s)
#pragma unroll
            for (int dt = 0; dt < 2; ++dt) { const LAS bf16_t* lo = vs + trb + 16 * s * PA + 32 * dt; af[s][dt] = tr_frag(lo, lo + 8 * PA); }
        asm volatile("s_waitcnt lgkmcnt(0)" ::: "memory"); __builtin_amdgcn_sched_barrier(0);
        __builtin_amdgcn_s_setprio(1);
#pragma unroll
        for (int s = 0; s < 2; ++s)
#pragma unroll
            for (int dt = 0; dt < 2; ++dt) {
                acc[0][dt] = MFMA32(af[s][dt], bfrag[0][s], acc[0][dt]);
                acc[1][dt] = MFMA32(af[s][dt], bfrag[1][s], acc[1][dt]);
            }
        __builtin_amdgcn_s_setprio(0);
        if (lastt) break;
        t = tn;
    }
    if (!metaq || c < NMETA) {
#pragma unroll
        for (int u = 0; u < 2; ++u) {
            const float inv = 1.0f / l[u];
            bf16_t* orow = z + zrowU(qrow0, 18) + zlaneRC(c, (2 * hp + u) * 64 + 4 * h);
            const bf16_t* grow = z + zrowU(qrow0, 18) + zlaneRC(c, 2560 + (2 * hp + u) * 64 + 4 * h);
#pragma unroll
            for (int dt = 0; dt < 2; ++dt)
#pragma unroll
                for (int g = 0; g < 4; ++g) {
                    const int d0 = (dt << 9) | (g << 7);
                    const u32x2 gv = *(const u32x2*)(grow + d0);
                    u32x2 o; o.x = pk2(silu_mul(acc[u][dt][4 * g] * inv, bf_lo(gv.x)), silu_mul(acc[u][dt][4 * g + 1] * inv, bf_hi(gv.x)));
                    o.y = pk2(silu_mul(acc[u][dt][4 * g + 2] * inv, bf_lo(gv.y)), silu_mul(acc[u][dt][4 * g + 3] * inv, bf_hi(gv.y)));
                    *(u32x2*)(orow + d0) = o;
                }
        }
    }
}

constexpr int NQS = SEQ / 32;

struct AttnQueue { unsigned* heads; int x; int cur; };
DI bool attn_next(AttnQueue& q, int lane0, int& qs, int& hd) {
    for (;;) {
        if (q.cur >= 8) return false;
        const int xq = (q.x + q.cur) & 7;
        const int nqs = NQS / 8 + (xq == 7 ? 1 : 0);
        unsigned n = 0;
        if (lane0) n = __hip_atomic_fetch_add(q.heads + 64 * xq, 1u, __ATOMIC_RELAXED, __HIP_MEMORY_SCOPE_AGENT);
        n = (unsigned)__builtin_amdgcn_readfirstlane((int)n);
        if (n < (unsigned)(nqs * 16)) { qs = (NQS / 8) * xq + (int)(n >> 4); hd = (int)(n & 15u); return true; }
        ++q.cur;
    }
}


__global__ void __launch_bounds__(NTHREADS) hybrid_fwd(Params p) {
    extern __shared__ __attribute__((aligned(16))) unsigned char lds_raw[];
    LAS unsigned char* lds = (LAS unsigned char*)lds_raw;
    cg::grid_group grid = cg::this_grid();
    bf16_t* hb = (bf16_t*)(p.ws + WS_HB);
    bf16_t* z = (bf16_t*)(p.ws + WS_Z);
    unsigned* barw = (unsigned*)(p.ws + WS_BAR);
    volatile LAS unsigned* bst = (volatile LAS unsigned*)(lds + LDS_MAIN);
    {
        const int tid = threadIdx.x, lane = tid & 63, wave = __builtin_amdgcn_readfirstlane(tid >> 6);
        const int G = gridDim.x, gw = blockIdx.x * NWAVES + wave, NGW = G * NWAVES;
        if (tid < 2) bst[tid] = 0u;
        if (blockIdx.x == 0) { for (int i = tid; i < XCD_BAR_WORDS; i += NTHREADS) barw[i] = 0u; for (int i = tid; i < 4 * 8 * 64; i += NTHREADS) ((unsigned*)(p.ws + WS_Q))[i] = 0u; }
        phase_p0(p, lds, gw, NGW, wave, lane);
    }
    grid.sync();
    const int wave_s = __builtin_amdgcn_readfirstlane(threadIdx.x >> 6);
    const XcdBarrier xb = xcd_barrier_post(barw, bst);
#define GSYNC() xcd_barrier(xb, wave_s)

#define PHASE_IDS() int lane = lane_id_fresh(); int wave = wave_s; asm volatile("" : "+s"(wave)); \
        int bid = blockIdx.x; asm volatile("" : "+s"(bid)); int G = gridDim.x; asm volatile("" : "+s"(G)); \
        const int tid = wave * 64 + lane, gw = bid * NWAVES + wave, NGW = G * NWAVES; (void)tid; (void)gw; (void)NGW
#pragma unroll 1
    for (int layer = 0; layer < DEPTH; ++layer) {
        const int j = layer >> 1;
        const bool isA = (layer & 1) == 0;
        {
            PHASE_IDS();
            const int N = isA ? NA : NB;
            const bf16_t* wt = isA ? (const bf16_t*)(p.ws + WS_W + j * WPAIR + WO_INA) : (const bf16_t*)(p.ws + WS_W + j * WPAIR + WO_INB);
            pg8::StaticOrder S; S.init(SEQ, N, G, bid);
            pg8::Gemm g{hb, wt, SEQ, N, D, D, 0};
            pg8::EpiBf16 E{z, 0, N / 256}; pg8::gemm_phase<pg8::EpiBf16>(lds, g, S, E, tid);
            meta_gemm<false>(hb + (size_t)SEQ * D, D, wt, N, z, 0, N / 256, lds, bid, G, wave, lane);
        }
        GSYNC();
        if (isA) {
            PHASE_IDS();
            LAS float* btab = (LAS float*)(lds + 8 * 14336);
            for (int idx = tid; idx < 32 * 129; idx += NTHREADS) {
                const int hd = idx / 129, d = idx % 129;
                int bucket = d;
                if (d >= 16) { bucket = 16 + (int)(logf((float)d * (1.0f / 16.0f)) / 2.0794415416798357f * 16.0f); bucket = bucket > 31 ? 31 : bucket; }
                btab[idx] = p.rel_bias[bucket * 32 + hd] * 1.4426950408889634f;
            }
            __syncthreads();
            LAS bf16_t* vs = (LAS bf16_t*)(lds + wave * 14336);
            const float* sinks = p.sinks_a + j * 32;
            AttnQueue aq{(unsigned*)(p.ws + WS_Q) + layer * 8 * 64, (int)(xb.x & 7u), 0}; int qs, hd;
            while (attn_next(aq, lane_id_fresh() == 0, qs, hd)) attnA_item(z, sinks, hd, qs == NQS ? -1 : qs, vs, btab, lane_id_fresh());
        } else {
            PHASE_IDS();
            LAS bf16_t* vs = (LAS bf16_t*)(lds + wave * (VS_BYTES + 8192));
            AttnQueue aq{(unsigned*)(p.ws + WS_Q) + layer * 8 * 64, (int)(xb.x & 7u), 0}; int qs, hd;
            while (attn_next(aq, lane_id_fresh() == 0, qs, hd)) attnB_item(z, hd, qs == NQS ? -1 : qs, vs, lane_id_fresh());
        }
        GSYNC();
        {
            PHASE_IDS();
            const int znt = isA ? NA / 256 : NB / 256;
            pg8::StaticOrder S; S.init(SEQ, D, G, bid);
            const bf16_t* wt = isA ? (const bf16_t*)(p.ws + WS_W + j * WPAIR + WO_OUTA) : (const bf16_t*)(p.ws + WS_W + j * WPAIR + WO_OUTB);
            pg8::Gemm g{z, wt, SEQ, D, D, 0, znt};
            pg8::EpiBf16 E{hb, D, 0}; pg8::gemm_phase<pg8::EpiBf16>(lds, g, S, E, tid);
            if (layer != DEPTH - 1) meta_gemm<true>(z, 0, wt, D, hb, D, znt, lds, bid, G, wave, lane);
        }
        GSYNC();
        {
            PHASE_IDS();
            phase_ln(p, layer, gw, NGW, lane);
        }
        if (layer != DEPTH - 1) GSYNC();
    }
}

extern "C" void kernel_launch(void* const* d_in, const int* in_sizes, int n_in, void* d_out, int out_size, void* d_ws, size_t ws_size, hipStream_t stream) {
    static int grid = 0;
    if (grid == 0) {
        if (n_in != 10 || out_size != SEQ * D || ws_size < WS_END) { fprintf(stderr, "kernel_launch: unexpected shapes (n_in %d out %d ws %zu, need %zu)\n", n_in, out_size, ws_size, (size_t)WS_END); grid = -1; return; }
        int dev = 0, cus = 0, per_cu = 0;
        hipGetDevice(&dev);
        hipDeviceGetAttribute(&cus, hipDeviceAttributeMultiprocessorCount, dev);
        if (hipFuncSetAttribute((const void*)hybrid_fwd, hipFuncAttributeMaxDynamicSharedMemorySize, LDS_BYTES) != hipSuccess) { fprintf(stderr, "kernel_launch: hipFuncSetAttribute failed\n"); grid = -1; return; }
        if (hipOccupancyMaxActiveBlocksPerMultiprocessor(&per_cu, (const void*)hybrid_fwd, NTHREADS, LDS_BYTES) != hipSuccess || per_cu < 1) { fprintf(stderr, "kernel_launch: occupancy query failed (%d)\n", per_cu); (void)hipGetLastError(); per_cu = 1; }
        grid = cus * 1;
    }
    if (grid < 0) return;
    Params p{};
    p.x = (const float*)d_in[0]; p.meta = (const float*)d_in[1]; p.rel_bias = (const float*)d_in[2]; p.w_in_a = (const float*)d_in[3]; p.sinks_a = (const float*)d_in[4];
    p.w_out_a = (const float*)d_in[5]; p.w_in_b = (const float*)d_in[6]; p.w_out_b = (const float*)d_in[7]; p.ln_g = (const float*)d_in[8]; p.ln_b = (const float*)d_in[9];
    p.out = (float*)d_out; p.ws = (unsigned char*)d_ws; p.probe = 1;
    void* args[] = {&p};
    hipError_t e = hipLaunchCooperativeKernel((const void*)hybrid_fwd, dim3(grid), dim3(NTHREADS), args, LDS_BYTES, stream);
    if (e != hipSuccess) fprintf(stderr, "kernel_launch: cooperative launch failed: %s (grid %d)\n", hipGetErrorString(e), grid);
}
```
